# Optimizing an MI355X kernel written in HIP

```python
import math
import jax, jax.numpy as jnp
from jax import lax
import numpy as np


D_MODEL = 1024
BATCH = 2
SEQ = 8192
DEPTH = 2

N_A = DEPTH // 2
N_B = DEPTH - N_A
RET_HEADS = 4
RET_DK = D_MODEL // RET_HEADS
RET_DV = 2 * RET_DK
RET_CHUNK = 128
RET_ROT_BASE = 10000.0
NSA_HEADS = 16
NSA_GROUPS = 4
NSA_HD = D_MODEL // NSA_HEADS
NSA_REP = NSA_HEADS // NSA_GROUPS
L_CMP = 32
CMP_STRIDE = 16
L_SLC = 64
N_SELECT = 16
WINDOW = 512
CMP_HIDDEN = 4 * NSA_HD
Q_BLOCK = 128
ROPE_THETA = 500000.0
ROPE_DIMS = NSA_HD // 4
D_FF = -(-(8 * D_MODEL) // (3 * 256)) * 256
EPS = 1e-6
NEG = -1e30
BIG = 1e9

kernel_name = 'yoco_retnet_nsa_hybrid'


def rmsnorm(x, g):
    xf = x.astype(jnp.float32)
    y = xf * lax.rsqrt(jnp.mean(xf * xf, axis=-1, keepdims=True) + EPS)
    return (y * g.astype(jnp.float32)).astype(x.dtype)


def apply_rotary(x, freqs):
    n = freqs.shape[0]
    pos = jnp.arange(x.shape[1], dtype=jnp.float32)
    ang = pos[:, None] * freqs[None, :]
    cos = jnp.cos(ang)[None, :, None, :]
    sin = jnp.sin(ang)[None, :, None, :]
    xf = x.astype(jnp.float32)
    x1 = xf[..., :n]
    x2 = xf[..., n:2 * n]
    out = jnp.concatenate([x1 * cos - x2 * sin, x1 * sin + x2 * cos, xf[..., 2 * n:]], axis=-1)
    return out.astype(x.dtype)


def partial_rope_freqs():
    return ROPE_THETA ** (-jnp.arange(0, ROPE_DIMS, 2, dtype=jnp.float32) / ROPE_DIMS)


def swiglu(h, w_in, w_out):
    g, u = jnp.split(h @ w_in, 2, axis=-1)
    return (jax.nn.silu(g) * u) @ w_out


def retention(h, w_in, gn, w_out):
    B, T, _ = h.shape
    Hh, dk, dv, C = RET_HEADS, RET_DK, RET_DV, RET_CHUNK
    n = T // C
    q, k, v, g = jnp.split(h @ w_in, [Hh * dk, 2 * Hh * dk, 2 * Hh * dk + Hh * dv], axis=-1)
    freqs = 1.0 / (RET_ROT_BASE ** jnp.linspace(0.0, 1.0, dk // 2, dtype=jnp.float32))
    q = apply_rotary(q.reshape(B, T, Hh, dk), freqs).astype(jnp.float32)
    k = apply_rotary(k.reshape(B, T, Hh, dk), freqs).astype(jnp.float32) * (dk ** -0.5)
    v = v.reshape(B, T, Hh, dv).astype(jnp.float32)

    def chunks(a):
        return a.reshape(B, n, C, Hh, a.shape[-1]).transpose(1, 0, 3, 2, 4)

    qc, kc, vc = chunks(q), chunks(k), chunks(v)
    log_g = jnp.log1p(-jnp.exp2(-5.0 - jnp.arange(Hh, dtype=jnp.float32)))
    idx = jnp.arange(C, dtype=jnp.float32)
    diff = idx[:, None] - idx[None, :]
    decay = jnp.where(diff >= 0, jnp.exp(log_g[:, None, None] * jnp.maximum(diff, 0.0)), 0.0)
    scores = jnp.einsum('nbhid,nbhjd->nbhij', qc, kc) * decay
    inner = jnp.einsum('nbhij,nbhjv->nbhiv', scores, vc)
    q_decay = jnp.exp(log_g[:, None] * (idx + 1.0))[:, :, None]
    k_decay = jnp.exp(log_g[:, None] * (C - 1.0 - idx))[:, :, None]
    chunk_decay = jnp.exp(log_g * C)[:, None, None]

    def step(state, xs):
        qi, ki, vi = xs
        cross = jnp.einsum('bhid,bhdv->bhiv', qi, state) * q_decay
        state = state * chunk_decay + jnp.einsum('bhjd,bhjv->bhdv', ki * k_decay, vi)
        return state, cross

    _, cross = lax.scan(step, jnp.zeros((B, Hh, dk, dv), jnp.float32), (qc, kc, vc))
    o = (inner + cross).transpose(1, 0, 3, 2, 4).reshape(B, T, Hh, dv)
    mu = jnp.mean(o, axis=-1, keepdims=True)
    var = jnp.mean(jnp.square(o - mu), axis=-1, keepdims=True)
    o = ((o - mu) * lax.rsqrt(var + EPS)).reshape(B, T, Hh * dv) * gn.astype(jnp.float32)
    y = (jax.nn.silu(g.astype(jnp.float32)) * o).astype(h.dtype)
    return y @ w_out


def nsa_shared_kv(x, kv_norm, w_kv, cmp_pos_k, cmp_pos_v, cmp_w1_k, cmp_w2_k, cmp_w1_v, cmp_w2_v):
    B, T, _ = x.shape
    G, d = NSA_GROUPS, NSA_HD
    hk = rmsnorm(x, kv_norm)
    k_c, v_c, k_s, v_s, k_w, v_w = [a.reshape(B, T, G, d) for a in jnp.split(hk @ w_kv, 6, axis=-1)]
    freqs = partial_rope_freqs()
    k_c = apply_rotary(k_c, freqs)
    k_s = apply_rotary(k_s, freqs)
    k_w = apply_rotary(k_w, freqs)
    n_cmp = (T - L_CMP) // CMP_STRIDE + 1
    idx = np.arange(n_cmp)[:, None] * CMP_STRIDE + np.arange(L_CMP)[None, :]

    def compress(a, pos, w1, w2):
        blocks = a[:, idx] + pos[None, None, :, None, :]
        blocks = blocks.transpose(0, 1, 3, 2, 4).reshape(B, n_cmp, G, L_CMP * d)
        return jax.nn.gelu(blocks @ w1) @ w2

    ck = compress(k_c, cmp_pos_k, cmp_w1_k, cmp_w2_k)
    cv = compress(v_c, cmp_pos_v, cmp_w1_v, cmp_w2_v)
    pad = ((0, 0), (WINDOW, 0), (0, 0), (0, 0))
    return (ck, cv, k_s.transpose(0, 2, 1, 3), v_s.transpose(0, 2, 1, 3),
            jnp.pad(k_w, pad), jnp.pad(v_w, pad))


def nsa_attention(h, w_in, w_out, shared):
    ck, cv, ks_all, vs_all, kw_pad, vw_pad = shared
    B, T, _ = h.shape
    H, G, R, d = NSA_HEADS, NSA_GROUPS, NSA_REP, NSA_HD
    nb = T // Q_BLOCK
    n_cmp = ck.shape[1]
    n_slc = T // L_SLC
    n_sel = min(N_SELECT, n_slc)
    proj = h @ w_in
    q = apply_rotary(proj[..., :H * d].reshape(B, T, H, d), partial_rope_freqs()) * (d ** -0.5)
    gates = jax.nn.sigmoid(proj[..., H * d:].astype(jnp.float32))
    q = q.reshape(B, nb, Q_BLOCK, G, R, d).transpose(1, 0, 2, 3, 4, 5)
    gates = gates.reshape(B, nb, Q_BLOCK, G, R, 3).transpose(1, 0, 2, 3, 4, 5)
    cmp_end = jnp.arange(n_cmp) * CMP_STRIDE + L_CMP - 1
    cs = np.arange(n_cmp)[:, None] * CMP_STRIDE
    ss = np.arange(n_slc)[None, :] * L_SLC
    overlap = np.clip(np.minimum(cs + L_CMP, ss + L_SLC) - np.maximum(cs, ss), 0, None) / CMP_STRIDE
    overlap = jnp.asarray(overlap, dtype=jnp.float32)
    slc_ids = jnp.arange(n_slc)
    gather = jax.vmap(jax.vmap(lambda a, i: a[i]))

    def block(xs):
        bi, qb, gb = xs
        t = bi * Q_BLOCK + jnp.arange(Q_BLOCK)
        s = jnp.einsum('bqgrd,bngd->bgrqn', qb, ck, preferred_element_type=jnp.float32)
        valid = cmp_end[None, :] <= t[:, None]
        p_c = jax.nn.softmax(jnp.where(valid, s, NEG), axis=-1) * jnp.any(valid, axis=-1)[:, None]
        o_c = jnp.einsum('bgrqn,bngd->bqgrd', p_c.astype(cv.dtype), cv)
        imp = jnp.einsum('bgqn,ns->bgqs', jnp.sum(p_c, axis=2), overlap)
        cur = t // L_SLC
        forced = (slc_ids[None, :] == 0) | (slc_ids[None, :] == cur[:, None]) | (slc_ids[None, :] == cur[:, None] - 1)
        causal_blk = slc_ids[None, :] * L_SLC <= t[:, None]
        imp = jnp.where(forced, BIG, jnp.where(causal_blk, imp, NEG))
        _, sel = lax.top_k(imp, n_sel)
        tok = (sel[..., None] * L_SLC + jnp.arange(L_SLC)).reshape(B, G, Q_BLOCK, n_sel * L_SLC)
        ks = gather(ks_all, tok)
        vs = gather(vs_all, tok)
        s = jnp.einsum('bqgrd,bgqkd->bgrqk', qb, ks, preferred_element_type=jnp.float32)
        p_s = jax.nn.softmax(jnp.where(tok[:, :, None] <= t[None, None, None, :, None], s, NEG), axis=-1)
        o_s = jnp.einsum('bgrqk,bgqkd->bqgrd', p_s.astype(vs.dtype), vs)
        kw = lax.dynamic_slice_in_dim(kw_pad, bi * Q_BLOCK, WINDOW + Q_BLOCK, axis=1)
        vw = lax.dynamic_slice_in_dim(vw_pad, bi * Q_BLOCK, WINDOW + Q_BLOCK, axis=1)
        spos = bi * Q_BLOCK - WINDOW + jnp.arange(WINDOW + Q_BLOCK)
        dist = t[:, None] - spos[None, :]
        wmask = (dist >= 0) & (dist < WINDOW) & (spos[None, :] >= 0)
        s = jnp.einsum('bqgrd,bsgd->bgrqs', qb, kw, preferred_element_type=jnp.float32)
        p_w = jax.nn.softmax(jnp.where(wmask, s, NEG), axis=-1)
        o_w = jnp.einsum('bgrqs,bsgd->bqgrd', p_w.astype(vw.dtype), vw)
        o = gb[..., 0:1] * o_c + gb[..., 1:2] * o_s + gb[..., 2:3] * o_w
        return o.astype(h.dtype)

    o = lax.map(block, (jnp.arange(nb), q, gates))
    o = o.transpose(1, 0, 2, 3, 4, 5).reshape(B, T, H * d)
    return o @ w_out


def setup_inputs(seed: int = 0) -> dict:
    key = jax.random.key(seed)
    ks = jax.random.split(key, 20)
    f32 = jnp.float32
    ret_in = 2 * RET_HEADS * RET_DK + 2 * RET_HEADS * RET_DV
    nsa_in = NSA_HEADS * NSA_HD + 3 * NSA_HEADS

    def w(k, shape, fan_in):
        return jax.random.normal(k, shape, f32) * (fan_in ** -0.5)

    def gain(k, shape):
        return 1.0 + 0.05 * jax.random.normal(k, shape, f32)

    return {
        'x': jax.random.normal(ks[0], (BATCH, SEQ, D_MODEL), f32),
        'norms': gain(ks[1], (DEPTH, 4, D_MODEL)),
        'ret_w_in': w(ks[2], (N_A, D_MODEL, ret_in), D_MODEL),
        'ret_gn': gain(ks[3], (N_A, RET_HEADS * RET_DV)),
        'ret_w_out': w(ks[4], (N_A, RET_HEADS * RET_DV, D_MODEL), RET_HEADS * RET_DV),
        'nsa_w_in': w(ks[5], (N_B, D_MODEL, nsa_in), D_MODEL),
        'nsa_w_out': w(ks[6], (N_B, NSA_HEADS * NSA_HD, D_MODEL), NSA_HEADS * NSA_HD),
        'kv_norm': gain(ks[7], (D_MODEL,)),
        'w_kv': w(ks[8], (D_MODEL, 6 * NSA_GROUPS * NSA_HD), D_MODEL),
        'cmp_pos_k': 0.1 * jax.random.normal(ks[9], (L_CMP, NSA_HD), f32),
        'cmp_pos_v': 0.1 * jax.random.normal(ks[10], (L_CMP, NSA_HD), f32),
        'cmp_w1_k': w(ks[11], (L_CMP * NSA_HD, CMP_HIDDEN), L_CMP * NSA_HD),
        'cmp_w2_k': w(ks[12], (CMP_HIDDEN, NSA_HD), CMP_HIDDEN),
        'cmp_w1_v': w(ks[13], (L_CMP * NSA_HD, CMP_HIDDEN), L_CMP * NSA_HD),
        'cmp_w2_v': w(ks[14], (CMP_HIDDEN, NSA_HD), CMP_HIDDEN),
        'ffn_w_in': w(ks[15], (DEPTH, D_MODEL, 2 * D_FF), D_MODEL),
        'ffn_w_out': w(ks[16], (DEPTH, D_FF, D_MODEL), D_FF),
    }


def reference(x, norms, ret_w_in, ret_gn, ret_w_out, nsa_w_in, nsa_w_out, kv_norm, w_kv,
              cmp_pos_k, cmp_pos_v, cmp_w1_k, cmp_w2_k, cmp_w1_v, cmp_w2_v, ffn_w_in, ffn_w_out):
    shared = None
    for layer in range(DEPTH):
        h = rmsnorm(x, norms[layer, 0])
        if layer < N_A:
            m = retention(h, ret_w_in[layer], ret_gn[layer], ret_w_out[layer])
        else:
            m = nsa_attention(h, nsa_w_in[layer - N_A], nsa_w_out[layer - N_A], shared)
        x = x + rmsnorm(m, norms[layer, 1])
        f = swiglu(rmsnorm(x, norms[layer, 2]), ffn_w_in[layer], ffn_w_out[layer])
        x = x + rmsnorm(f, norms[layer, 3])
        if layer == N_A - 1:
            shared = nsa_shared_kv(x, kv_norm, w_kv, cmp_pos_k, cmp_pos_v,
                                   cmp_w1_k, cmp_w2_k, cmp_w1_v, cmp_w2_v)
    return x
```

```cpp
#include <hip/hip_runtime.h>
#include <cstdio>
#include <cstdint>

#ifndef MK_ONE_LAUNCH
#define MK_ONE_LAUNCH 0
#endif

typedef _Float16 h16;
typedef _Float16 h16x8 __attribute__((ext_vector_type(8)));
typedef _Float16 h16x4 __attribute__((ext_vector_type(4)));
typedef float f32x4 __attribute__((ext_vector_type(4)));

constexpr int BATCH = 2, T = 8192, D = 1024, M = BATCH * T;
constexpr int RH = 4, DK = 256, DV = 512;
constexpr int NG = 4, HD = 64, NCP = 512;
constexpr int DFF = 2816;
constexpr int SUP = 512, NSUP = T / SUP;
constexpr float EPS = 1e-6f;
constexpr int NPHASE = 18;
constexpr int NT = 512;
constexpr int LDS_BYTES = 147456;

constexpr size_t MiB = 1u << 20;
constexpr size_t WS_CTL = 0;
constexpr size_t WS_RC = 1 * MiB, WS_RS = 5 * MiB;
constexpr size_t WS_NC = 9 * MiB, WS_NS = 9 * MiB + 256 * 1024;
constexpr size_t WS_BIASK = 9 * MiB + 512 * 1024, WS_BIASV = WS_BIASK + 1024;
constexpr size_t WS_WC1K = 10 * MiB, WS_WC1V = 11 * MiB;
constexpr size_t WS_WA = 12 * MiB;
constexpr size_t WS_WKVQ = 12 * MiB, WS_WNO = 18 * MiB;
constexpr size_t WS_WRO = 24 * MiB;
constexpr size_t WS_XN = 28 * MiB;
constexpr size_t WS_SS = 28 * MiB;
constexpr size_t WS_O1 = 28 * MiB;
constexpr size_t WS_Q0 = 60 * MiB, WS_K0 = 92 * MiB, WS_V0 = 124 * MiB, WS_Y = 188 * MiB;
constexpr size_t WS_MB = 60 * MiB;
constexpr size_t WS_WFI = 124 * MiB, WS_WFO = 135 * MiB;
constexpr size_t WS_HID = 144 * MiB;
constexpr size_t WS_KC = 124 * MiB, WS_VC = 132 * MiB, WS_KS = 140 * MiB, WS_VS = 148 * MiB, WS_KW = 156 * MiB, WS_VW = 164 * MiB;
constexpr size_t WS_QN = 172 * MiB;
constexpr size_t WS_GATES = 204 * MiB;
constexpr size_t WS_HC = 208 * MiB;
constexpr size_t WS_CK = 212 * MiB, WS_CV = 212 * MiB + 512 * 1024;
constexpr size_t WS_END = 252 * MiB;

struct Args { const float* in[17]; float* out; unsigned char* ws; int ph_lo, ph_hi; };

__device__ __forceinline__ float wave_sum(float v) {
#pragma unroll
    for (int o = 1; o < 64; o <<= 1) v += __shfl_xor(v, o);
    return v;
}
__device__ __forceinline__ float wave_max(float v) {
#pragma unroll
    for (int o = 1; o < 64; o <<= 1) v = fmaxf(v, __shfl_xor(v, o));
    return v;
}
#define LDS_FENCE() asm volatile("s_waitcnt lgkmcnt(0)" ::: "memory")

__device__ __forceinline__ void sincos_acc(float ang, float& c, float& s) {
    const double x = (double)ang;
    const double k = __builtin_rint(x * 0.63661977236758134308);
    double y = __builtin_fma(-k, 1.57079632679489655800, x);
    y = __builtin_fma(-k, 6.12323399573676603587e-17, y);
    const double y2 = y * y;
    double sp = -2.5052108385441718775e-08; sp = sp * y2 + 2.7557319223985890653e-06; sp = sp * y2 - 1.9841269841269841270e-04; sp = sp * y2 + 8.3333333333333332177e-03; sp = sp * y2 - 1.6666666666666665741e-01;
    const double sy = y + y * y2 * sp;
    double cp = 2.0876756987868098979e-09; cp = cp * y2 - 2.7557319223985888e-07; cp = cp * y2 + 2.4801587301587301566e-05; cp = cp * y2 - 1.3888888888888889419e-03; cp = cp * y2 + 4.1666666666666664354e-02; cp = cp * y2 - 0.5;
    const double cy = 1.0 + y2 * cp;
    const int q = ((int)k) & 3;
    const double sr = (q == 0) ? sy : (q == 1) ? cy : (q == 2) ? -sy : -cy;
    const double cr = (q == 0) ? cy : (q == 1) ? -sy : (q == 2) ? -cy : sy;
    c = (float)cr; s = (float)sr;
}
__device__ __forceinline__ float silu_f(float x) { return x / (1.f + __expf(-x)); }
__device__ __forceinline__ float sigmoid_f(float x) { return 1.f / (1.f + __expf(-x)); }
__device__ __forceinline__ float gelu_tanh_f(float x) { const float u = 0.7978845608028654f * (x + 0.044715f * x * x * x); return 0.5f * x * (1.f + tanhf(u)); }
__device__ __forceinline__ float ret_lg(int h) { return log1pf(-exp2f(-5.0f - (float)h)); }

__device__ __forceinline__ void wt_item(const float* W, int K, int N, h16* WT, const float* gain, int kind, int rowoff, float* scr, int item, int lane) {
    const int nblk = (N + 31) / 32, kb = item / nblk, nb = item % nblk, k0 = 64 * kb, n0 = 32 * nb;
    const int ncol = n0 + (lane & 31);
#pragma unroll 8
    for (int i = 0; i < 32; ++i) { const int kk = 2 * i + (lane >> 5); float v = 0.f; if (ncol < N) v = W[(size_t)(k0 + kk) * N + ncol]; if (gain) v *= gain[k0 + kk]; scr[kk * 33 + (lane & 31)] = v; }
    LDS_FENCE();
    const int c = lane & 7;
#pragma unroll
    for (int j = 0; j < 4; ++j) {
        const int nl = (lane >> 3) + 8 * j, n = n0 + nl; const float* s = scr + (8 * c) * 33 + nl;
        h16x8 o;
#pragma unroll
        for (int e = 0; e < 8; ++e) o[e] = (h16)s[e * 33];
        int row;
        if (kind == 0) row = rowoff + n;
        else { row = (n < DFF) ? (256 * (n >> 7) + (n & 127)) : (256 * ((n - DFF) >> 7) + 128 + ((n - DFF) & 127)); }
        if (n < N || kind == 2) *(h16x8*)(WT + (size_t)row * K + k0 + 8 * c) = o;
    }
    LDS_FENCE();
}
#define WT_JOB(r, W, K, N, WT, gain, kind, rowoff) { const int _ni = ((K) / 64) * (((N) + 31) / 32); if ((r) >= 0 && (r) < _ni) wt_item(W, K, N, WT, gain, kind, rowoff, scr, r, lane); (r) -= _ni; }

__device__ __forceinline__ void xn_row(const float* xrow, h16* orow, int lane) {
    f32x4 v[4]; float s = 0.f;
#pragma unroll
    for (int j = 0; j < 4; ++j) { v[j] = *(const f32x4*)(xrow + 4 * lane + 256 * j); s += v[j].x * v[j].x + v[j].y * v[j].y + v[j].z * v[j].z + v[j].w * v[j].w; }
    const float rstd = rsqrtf(wave_sum(s) * (1.f / D) + EPS);
#pragma unroll
    for (int j = 0; j < 4; ++j) { h16x4 o; o[0] = (h16)(v[j].x * rstd); o[1] = (h16)(v[j].y * rstd); o[2] = (h16)(v[j].z * rstd); o[3] = (h16)(v[j].w * rstd); *(h16x4*)(orow + 4 * lane + 256 * j) = o; }
}
__device__ __forceinline__ void res_norm_row(const float* xi, const float* mb, const float* gain, float* xo, h16* xn, int lane) {
    f32x4 a[4], r[4]; float s = 0.f;
#pragma unroll
    for (int j = 0; j < 4; ++j) { a[j] = *(const f32x4*)(mb + 4 * lane + 256 * j); r[j] = *(const f32x4*)(xi + 4 * lane + 256 * j); s += a[j].x * a[j].x + a[j].y * a[j].y + a[j].z * a[j].z + a[j].w * a[j].w; }
    const float rstd = rsqrtf(wave_sum(s) * (1.f / D) + EPS); float s2 = 0.f;
#pragma unroll
    for (int j = 0; j < 4; ++j) { const f32x4 g = *(const f32x4*)(gain + 4 * lane + 256 * j); r[j] = r[j] + a[j] * rstd * g; *(f32x4*)(xo + 4 * lane + 256 * j) = r[j]; s2 += r[j].x * r[j].x + r[j].y * r[j].y + r[j].z * r[j].z + r[j].w * r[j].w; }
    if (xn) {
        const float rs2 = rsqrtf(wave_sum(s2) * (1.f / D) + EPS);
#pragma unroll
        for (int j = 0; j < 4; ++j) { h16x4 o; o[0] = (h16)(r[j].x * rs2); o[1] = (h16)(r[j].y * rs2); o[2] = (h16)(r[j].z * rs2); o[3] = (h16)(r[j].w * rs2); *(h16x4*)(xn + 4 * lane + 256 * j) = o; }
    }
}

constexpr int CT_LD = 260;
template <class Epi>
__device__ __forceinline__ void ngemm(const h16* A, int lda, const h16* Bt, int K, int Mrows, int Ntiles, float* lds, const Epi& E) {
    float* As = lds; float* Bs = lds + 64 * 33; float* Ct = lds + 64 * 33 + 256 * 33;
    const int tid = threadIdx.x, ty = tid >> 5, tx = tid & 31;
    const int nunits = (Mrows / 64) * Ntiles;
    for (int u = blockIdx.x; u < nunits; u += gridDim.x) {
        const int um = u / Ntiles, un = u % Ntiles;
        float acc[4][8];
#pragma unroll
        for (int i = 0; i < 4; ++i)
#pragma unroll
            for (int j = 0; j < 8; ++j) acc[i][j] = 0.f;
        for (int k0 = 0; k0 < K; k0 += 32) {
            { const h16x4 v = *(const h16x4*)(A + (size_t)(um * 64 + (tid >> 3)) * lda + k0 + (tid & 7) * 4);
#pragma unroll
              for (int j = 0; j < 4; ++j) As[(tid >> 3) * 33 + (tid & 7) * 4 + j] = (float)v[j]; }
            { const h16* p = Bt + (size_t)(un * 256 + (tid >> 1)) * K + k0 + (tid & 1) * 16; const h16x8 v0 = *(const h16x8*)p, v1 = *(const h16x8*)(p + 8);
#pragma unroll
              for (int j = 0; j < 8; ++j) { Bs[(tid >> 1) * 33 + (tid & 1) * 16 + j] = (float)v0[j]; Bs[(tid >> 1) * 33 + (tid & 1) * 16 + 8 + j] = (float)v1[j]; } }
            __syncthreads();
#pragma unroll 4
            for (int kk = 0; kk < 32; ++kk) {
                float a[4], b[8];
#pragma unroll
                for (int i = 0; i < 4; ++i) a[i] = As[(ty * 4 + i) * 33 + kk];
#pragma unroll
                for (int j = 0; j < 8; ++j) b[j] = Bs[(tx + 32 * j) * 33 + kk];
#pragma unroll
                for (int i = 0; i < 4; ++i)
#pragma unroll
                    for (int j = 0; j < 8; ++j) acc[i][j] += a[i] * b[j];
            }
            __syncthreads();
        }
#pragma unroll
        for (int i = 0; i < 4; ++i)
#pragma unroll
            for (int j = 0; j < 8; ++j) Ct[(ty * 4 + i) * CT_LD + tx + 32 * j] = acc[i][j];
        __syncthreads();
        E(um, un, Ct);
        __syncthreads();
    }
}

struct EpiRetIn {
    h16 *Q0, *K0, *V0, *G0; const float *RC, *RS;
    __device__ __forceinline__ void operator()(int um, int un, const float* Ct) const {
        const int tid = threadIdx.x;
        if (un < 8) {
            const bool isk = un >= 4; const int h = un & 3; h16* dst = isk ? K0 : Q0; const float sc = isk ? 0.0625f : 1.f;
            for (int idx = tid; idx < 64 * 128; idx += NT) { const int r = idx >> 7, c = idx & 127, m = um * 64 + r, t = m & (T - 1);
                const float x1 = Ct[r * CT_LD + c], x2 = Ct[r * CT_LD + c + 128], cs = RC[t * 128 + c], sn = RS[t * 128 + c];
                dst[(size_t)m * 1024 + h * 256 + c] = (h16)((x1 * cs - x2 * sn) * sc); dst[(size_t)m * 1024 + h * 256 + c + 128] = (h16)((x1 * sn + x2 * cs) * sc); }
        } else {
            h16* dst = (un < 16) ? V0 : G0; const int cb = ((un - 8) & 7) * 256;
            for (int idx = tid; idx < 64 * 256; idx += NT) { const int r = idx >> 8, c = idx & 255, m = um * 64 + r; dst[(size_t)m * 2048 + cb + c] = (h16)Ct[r * CT_LD + c]; }
        }
    }
};
struct EpiF32 { float* O; int ldc;
    __device__ __forceinline__ void operator()(int um, int un, const float* Ct) const {
        for (int idx = threadIdx.x; idx < 64 * 256; idx += NT) { const int r = idx >> 8, c = idx & 255; O[(size_t)(um * 64 + r) * ldc + un * 256 + c] = Ct[r * CT_LD + c]; } }
};
struct EpiSwiglu { h16* H;
    __device__ __forceinline__ void operator()(int um, int un, const float* Ct) const {
        for (int idx = threadIdx.x; idx < 64 * 128; idx += NT) { const int r = idx >> 7, c = idx & 127; H[(size_t)(um * 64 + r) * DFF + un * 128 + c] = (h16)(silu_f(Ct[r * CT_LD + c]) * Ct[r * CT_LD + c + 128]); } }
};
struct EpiKvq {
    h16* KV6; h16* QN; float* GATES; const float *NC, *NS;
    __device__ __forceinline__ void operator()(int um, int un, const float* Ct) const {
        const int tid = threadIdx.x;
        if (un < 6) {
            h16* dst = KV6 + (size_t)un * (8u * T * 64); const bool rot = (un & 1) == 0;
            for (int idx = tid; idx < 64 * 256; idx += NT) { const int r = idx >> 8, c = idx & 255, m = um * 64 + r, b = m >> 13, t = m & (T - 1), g = c >> 6, d = c & 63;
                float v = Ct[r * CT_LD + c];
                if (rot && d < 16) { const int i = d & 7; const float cs = NC[t * 8 + i], sn = NS[t * 8 + i]; const float x1 = Ct[r * CT_LD + (c & ~15) + i], x2 = Ct[r * CT_LD + (c & ~15) + i + 8]; v = (d < 8) ? (x1 * cs - x2 * sn) : (x1 * sn + x2 * cs); }
                dst[((size_t)(b * 4 + g) * T + t) * 64 + d] = (h16)v; }
        } else if (un < 10) {
            for (int idx = tid; idx < 64 * 256; idx += NT) { const int r = idx >> 8, c = idx & 255, m = um * 64 + r, t = m & (T - 1), d = c & 63;
                float v = Ct[r * CT_LD + c];
                if (d < 16) { const int i = d & 7; const float cs = NC[t * 8 + i], sn = NS[t * 8 + i]; const float x1 = Ct[r * CT_LD + (c & ~15) + i], x2 = Ct[r * CT_LD + (c & ~15) + i + 8]; v = (d < 8) ? (x1 * cs - x2 * sn) : (x1 * sn + x2 * cs); }
                QN[(size_t)m * 1024 + (un - 6) * 256 + c] = (h16)(v * 0.125f); }
        } else {
            for (int idx = tid; idx < 64 * 48; idx += NT) { const int r = idx / 48, c = idx % 48; GATES[(size_t)(um * 64 + r) * 48 + c] = sigmoid_f(Ct[r * CT_LD + c]); }
        }
    }
};
struct EpiCmp { h16* HC; const float* bias;
    __device__ __forceinline__ void operator()(int um, int un, const float* Ct) const {
        for (int idx = threadIdx.x; idx < 64 * 256; idx += NT) { const int r = idx >> 8, c = idx & 255; HC[(size_t)(um * 64 + r) * 256 + c] = (h16)gelu_tanh_f(Ct[r * CT_LD + c] + bias[c]); } }
};

__device__ __forceinline__ void n_ret_state(const h16* K0, const h16* V0, h16* SS) {
    const int tid = threadIdx.x, d = tid & 255, half = tid >> 8;
    for (int it = blockIdx.x; it < 8 * 128; it += gridDim.x) {
        const int bh = it >> 7, vq = it & 127, b = bh >> 2, h = bh & 3, c0 = vq * 4 + half * 2;
        const float gam = 1.f - exp2f(-5.f - (float)h);
        const h16* kp = K0 + (size_t)(b * T) * 1024 + h * 256 + d; const h16* vp = V0 + (size_t)(b * T) * 2048 + h * 512 + c0;
        float s0 = 0.f, s1 = 0.f;
        for (int jb = 0; jb < (NSUP - 1) * SUP; jb += 8) {
            float kv[8], v0[8], v1[8];
#pragma unroll
            for (int e = 0; e < 8; ++e) { kv[e] = (float)kp[(size_t)(jb + e) * 1024]; v0[e] = (float)vp[(size_t)(jb + e) * 2048]; v1[e] = (float)vp[(size_t)(jb + e) * 2048 + 1]; }
#pragma unroll
            for (int e = 0; e < 8; ++e) { s0 = gam * s0 + kv[e] * v0[e]; s1 = gam * s1 + kv[e] * v1[e]; }
            if (((jb + 8) & (SUP - 1)) == 0) { const int ms = (jb + 8) / SUP - 1; h16* sp = SS + (((size_t)bh * (NSUP - 1) + ms) * 512 + c0) * 256 + d; sp[0] = (h16)s0; sp[256] = (h16)s1; }
        }
    }
}
__device__ __forceinline__ void n_ret_out(const h16* Q0, const h16* K0, const h16* V0, const h16* G0, const h16* SS, const float* gn, h16* Y, float* lds) {
    const int tid = threadIdx.x, lane = tid & 63, wave = tid >> 6;
    float* qs = lds + wave * 768; float* sc = qs + 256;
    const int gw = blockIdx.x * 8 + wave, NGW = gridDim.x * 8;
    for (int it = gw; it < M * 4; it += NGW) {
        const int m = ((it >> 5) << 3) | (it & 7), h = (it >> 3) & 3, b = m >> 13, t = m & (T - 1), tl = t & (SUP - 1), s0 = t - tl, ms = t / SUP, bh = b * 4 + h;
        const float lgh = ret_lg(h);
        for (int i = lane; i < 256; i += 64) qs[i] = (float)Q0[(size_t)m * 1024 + h * 256 + i];
        LDS_FENCE();
        for (int jj = lane; jj <= tl; jj += 64) {
            const h16* kr = K0 + (size_t)(b * T + s0 + jj) * 1024 + h * 256; float dot = 0.f;
#pragma unroll 2
            for (int d = 0; d < 256; d += 8) { const h16x8 kv = *(const h16x8*)(kr + d);
#pragma unroll
                for (int e = 0; e < 8; ++e) dot += (float)kv[e] * qs[d + e]; }
            sc[jj] = dot * __expf(lgh * (float)(tl - jj));
        }
        LDS_FENCE();
        float o[8];
#pragma unroll
        for (int e = 0; e < 8; ++e) o[e] = 0.f;
        const h16* vb = V0 + (size_t)(b * T + s0) * 2048 + h * 512 + lane * 8;
        for (int jj = 0; jj <= tl; ++jj) { const float s = sc[jj]; const h16x8 vv = *(const h16x8*)(vb + (size_t)jj * 2048);
#pragma unroll
            for (int e = 0; e < 8; ++e) o[e] += s * (float)vv[e]; }
        if (ms > 0) {
            const h16* sp = SS + (((size_t)bh * (NSUP - 1) + ms - 1) * 512 + lane * 8) * 256; const float qd = __expf(lgh * (float)(tl + 1));
            float cr[8];
#pragma unroll
            for (int e = 0; e < 8; ++e) cr[e] = 0.f;
#pragma unroll 1
            for (int d = 0; d < 256; d += 8) {
#pragma unroll
                for (int e = 0; e < 8; ++e) { const h16x8 sv = *(const h16x8*)(sp + e * 256 + d);
#pragma unroll
                    for (int f = 0; f < 8; ++f) cr[e] += (float)sv[f] * qs[d + f]; } }
#pragma unroll
            for (int e = 0; e < 8; ++e) o[e] += qd * cr[e];
        }
        float s1 = 0.f;
#pragma unroll
        for (int e = 0; e < 8; ++e) s1 += o[e];
        const float mu = wave_sum(s1) * (1.f / DV); float s2 = 0.f;
#pragma unroll
        for (int e = 0; e < 8; ++e) { o[e] -= mu; s2 += o[e] * o[e]; }
        const float rstd = rsqrtf(wave_sum(s2) * (1.f / DV) + EPS);
        const h16x8 gv = *(const h16x8*)(G0 + (size_t)m * 2048 + h * 512 + lane * 8); h16x8 yo;
#pragma unroll
        for (int e = 0; e < 8; ++e) yo[e] = (h16)(silu_f((float)gv[e]) * o[e] * rstd * gn[h * 512 + lane * 8 + e]);
        *(h16x8*)(Y + (size_t)m * 2048 + h * 512 + lane * 8) = yo;
        LDS_FENCE();
    }
}

__device__ __forceinline__ void dots4(const h16* krow, const float* qs, float (&dt)[4]) {
#pragma unroll
    for (int r = 0; r < 4; ++r) dt[r] = 0.f;
#pragma unroll
    for (int c = 0; c < 8; ++c) { const h16x8 kv = *(const h16x8*)(krow + 8 * c);
#pragma unroll
        for (int r = 0; r < 4; ++r)
#pragma unroll
            for (int e = 0; e < 8; ++e) dt[r] += (float)kv[e] * qs[r * 64 + 8 * c + e]; }
}
__device__ __forceinline__ void softmax4(float* sc, int n, int lane) {
    for (int r = 0; r < 4; ++r) {
        float mx = -INFINITY; for (int i = lane; i < n; i += 64) mx = fmaxf(mx, sc[r * 1024 + i]);
        mx = wave_max(mx); float sum = 0.f;
        for (int i = lane; i < n; i += 64) { const float e = __expf(sc[r * 1024 + i] - mx); sc[r * 1024 + i] = e; sum += e; }
        sum = wave_sum(sum); const float inv = 1.f / sum;
        for (int i = lane; i < n; i += 64) sc[r * 1024 + i] *= inv;
    }
    LDS_FENCE();
}
__device__ __forceinline__ int select_blocks(float imp0, float imp1, int cur, int* sel, int lane) {
    int nsel = 0;
    if (lane == 0) { sel[0] = 0; }
    nsel = 1;
    if (cur >= 1) { if (lane == 0) sel[nsel] = cur; ++nsel; }
    if (cur >= 2) { if (lane == 0) sel[nsel] = cur - 1; ++nsel; }
    const int sA = lane, sB = lane + 64;
    float v0 = (sA <= cur && sA != 0 && sA != cur && sA != cur - 1) ? imp0 : -INFINITY;
    float v1 = (sB <= cur && sB != 0 && sB != cur && sB != cur - 1) ? imp1 : -INFINITY;
    while (nsel < 16) {
        const float mx = wave_max(fmaxf(v0, v1));
        if (mx == -INFINITY) break;
        const unsigned long long b0 = __ballot(v0 == mx);
        int s;
        if (b0) { const int l = __ffsll((long long)b0) - 1; s = l; if (lane == l) v0 = -INFINITY; }
        else { const unsigned long long b1 = __ballot(v1 == mx); const int l = __ffsll((long long)b1) - 1; s = l + 64; if (lane == l) v1 = -INFINITY; }
        if (lane == 0) sel[nsel] = s;
        ++nsel;
    }
    LDS_FENCE();
    return nsel;
}
__device__ __forceinline__ void n_nsa_attn(const h16* QN, const h16* KV6, const h16* CK, const h16* CV, const float* GATES, h16* O1, float* lds) {
    const int tid = threadIdx.x, lane = tid & 63, wave = tid >> 6;
    float* qs = lds + wave * 4480; float* sc = qs + 256; int* sel = (int*)(sc + 4096);
    const h16 *KS = KV6 + 2 * (size_t)(8 * T * 64), *VS = KV6 + 3 * (size_t)(8 * T * 64), *KW = KV6 + 4 * (size_t)(8 * T * 64), *VW = KV6 + 5 * (size_t)(8 * T * 64);
    const int gw = blockIdx.x * 8 + wave, NGW = gridDim.x * 8;
    for (int it = gw; it < M * 4; it += NGW) {
        const int m = it >> 2, g = it & 3, b = m >> 13, t = m & (T - 1), bg = b * 4 + g;
        for (int i = lane; i < 256; i += 64) qs[i] = (float)QN[(size_t)m * 1024 + g * 256 + i];
        LDS_FENCE();
        const int nv = (t >= 31) ? ((t - 31) >> 4) + 1 : 0;
        float oc[4] = {0.f, 0.f, 0.f, 0.f};
        if (nv > 0) {
            for (int n = lane; n < nv; n += 64) { float dt[4]; dots4(CK + ((size_t)bg * NCP + n) * 64, qs, dt);
#pragma unroll
                for (int r = 0; r < 4; ++r) sc[r * 1024 + n] = dt[r]; }
            LDS_FENCE();
            softmax4(sc, nv, lane);
            for (int n = 0; n < nv; ++n) { const float vv = (float)CV[((size_t)bg * NCP + n) * 64 + lane];
#pragma unroll
                for (int r = 0; r < 4; ++r) oc[r] += sc[r * 1024 + n] * vv; }
        }
        float imp[2];
#pragma unroll
        for (int q = 0; q < 2; ++q) { const int s = lane + 64 * q; float a = 0.f;
#pragma unroll
            for (int e = -1; e < 4; ++e) { const int n = 4 * s + e; if (n >= 0 && n < nv) { const float p = sc[n] + sc[1024 + n] + sc[2048 + n] + sc[3072 + n]; a += (e == -1 || e == 3) ? p : 2.f * p; } }
            imp[q] = a; }
        LDS_FENCE();
        const int cur = t >> 6;
        const int nsel = select_blocks(imp[0], imp[1], cur, sel, lane);
        float os[4] = {0.f, 0.f, 0.f, 0.f};
        for (int i2 = 0; i2 < nsel; ++i2) { const int tok = sel[i2] * 64 + lane; float dt[4]; dots4(KS + ((size_t)bg * T + tok) * 64, qs, dt);
#pragma unroll
            for (int r = 0; r < 4; ++r) sc[r * 1024 + i2 * 64 + lane] = (tok <= t) ? dt[r] : -INFINITY; }
        LDS_FENCE();
        softmax4(sc, nsel * 64, lane);
        for (int kk = 0; kk < nsel * 64; ++kk) { const int tok = sel[kk >> 6] * 64 + (kk & 63); const float vv = (float)VS[((size_t)bg * T + tok) * 64 + lane];
#pragma unroll
            for (int r = 0; r < 4; ++r) os[r] += sc[r * 1024 + kk] * vv; }
        LDS_FENCE();
        float ow[4] = {0.f, 0.f, 0.f, 0.f};
        const int nw = (t + 1 < 512) ? t + 1 : 512, t0 = t - nw + 1;
        for (int i = lane; i < nw; i += 64) { float dt[4]; dots4(KW + ((size_t)bg * T + t0 + i) * 64, qs, dt);
#pragma unroll
            for (int r = 0; r < 4; ++r) sc[r * 1024 + i] = dt[r]; }
        LDS_FENCE();
        softmax4(sc, nw, lane);
        for (int i = 0; i < nw; ++i) { const float vv = (float)VW[((size_t)bg * T + t0 + i) * 64 + lane];
#pragma unroll
            for (int r = 0; r < 4; ++r) ow[r] += sc[r * 1024 + i] * vv; }
        LDS_FENCE();
#pragma unroll
        for (int r = 0; r < 4; ++r) { const float* gp = GATES + (size_t)m * 48 + (g * 4 + r) * 3;
            O1[(size_t)m * 1024 + (g * 4 + r) * 64 + lane] = (h16)(gp[0] * oc[r] + gp[1] * os[r] + gp[2] * ow[r]); }
    }
}

template <int PH> __global__ void __launch_bounds__(NT, 2) mk(Args args) {
    extern __shared__ __attribute__((aligned(16))) unsigned char lds_raw[];
    float* lds = (float*)lds_raw;
    const int tid = threadIdx.x, lane = tid & 63, wave = tid >> 6;
    const int gw = blockIdx.x * 8 + wave, NGW = gridDim.x * 8, gt = blockIdx.x * NT + tid, NGT = gridDim.x * NT;
    unsigned char* ws = args.ws;
    const float* x = args.in[0]; const float* norms = args.in[1];
    float* RC = (float*)(ws + WS_RC); float* RS = (float*)(ws + WS_RS); float* NC = (float*)(ws + WS_NC); float* NS = (float*)(ws + WS_NS);
    float* BIASK = (float*)(ws + WS_BIASK); float* BIASV = (float*)(ws + WS_BIASV);
    h16* XN = (h16*)(ws + WS_XN); float* MB = (float*)(ws + WS_MB); h16* HID = (h16*)(ws + WS_HID);
    h16* WFI = (h16*)(ws + WS_WFI); h16* WFO = (h16*)(ws + WS_WFO);
    h16* Q0 = (h16*)(ws + WS_Q0); h16* K0 = (h16*)(ws + WS_K0); h16* V0 = (h16*)(ws + WS_V0); h16* G0 = (h16*)args.out; h16* SS = (h16*)(ws + WS_SS); h16* Y = (h16*)(ws + WS_Y);
    h16* KV6 = (h16*)(ws + WS_KC); h16* QN = (h16*)(ws + WS_QN); float* GATES = (float*)(ws + WS_GATES); h16* HC = (h16*)(ws + WS_HC); h16* CK = (h16*)(ws + WS_CK); h16* CV = (h16*)(ws + WS_CV); h16* O1 = (h16*)(ws + WS_O1);
    float* XR = args.out;
    float* scr = lds + wave * (64 * 33);
    const int lo = args.ph_lo, hi = args.ph_hi;
#define IN(k) (PH < 0 ? (lo <= (k) && (k) < hi) : (PH == (k)))

    if (IN(0)) {
        const int NI = 16 * 192 + 32 * 32;
        for (int it = gw; it < NI; it += NGW) { int r = it;
            WT_JOB(r, args.in[2], 1024, 6144, (h16*)(ws + WS_WA), norms + 0 * 1024, 0, 0);
            WT_JOB(r, args.in[4], 2048, 1024, (h16*)(ws + WS_WRO), nullptr, 0, 0); }
        for (int i = gt; i < T * 128; i += NGT) { const int t = i >> 7, j = i & 127; const float fr = (float)(1.0 / pow(10000.0, (double)((float)j / 127.0f))); float c, s; sincos_acc((float)t * fr, c, s); RC[i] = c; RS[i] = s; }
        for (int i = gt; i < T * 8; i += NGT) { const int t = i >> 3, j = i & 7; const float fr = (float)pow(500000.0, -(double)(2 * j) / 16.0); float c, s; sincos_acc((float)t * fr, c, s); NC[i] = c; NS[i] = s; }
        for (int m = gw; m < M; m += NGW) xn_row(x + (size_t)m * D, XN + (size_t)m * D, lane);
    }
    if (IN(1)) { EpiRetIn E{Q0, K0, V0, G0, RC, RS}; ngemm(XN, 1024, (const h16*)(ws + WS_WA), 1024, M, 24, lds, E); }
    if (IN(2)) n_ret_state(K0, V0, SS);
    if (IN(3)) n_ret_out(Q0, K0, V0, G0, SS, args.in[3], Y, lds);
    if (IN(4)) { EpiF32 E{MB, 1024}; ngemm(Y, 2048, (const h16*)(ws + WS_WRO), 2048, M, 4, lds, E); }
#define PH_NORM_A(L, xin) {     \
            for (int m = gw; m < M; m += NGW) res_norm_row((xin) + (size_t)m * D, MB + (size_t)m * D, norms + ((L) * 4 + 1) * 1024, XR + (size_t)m * D, XN + (size_t)m * D, lane); \
            const int NI = 16 * 176 + 44 * 32; \
            for (int it = gw; it < NI; it += NGW) { int r = it; \
                WT_JOB(r, args.in[15] + (size_t)(L) * 1024 * 5632, 1024, 5632, WFI, norms + ((L) * 4 + 2) * 1024, 1, 0); \
                WT_JOB(r, args.in[16] + (size_t)(L) * 2816 * 1024, 2816, 1024, WFO, nullptr, 0, 0); } }
#define PH_FFN_IN() { EpiSwiglu E{HID}; ngemm(XN, 1024, WFI, 1024, M, 22, lds, E); }
#define PH_FFN_OUT() { EpiF32 E{MB, 1024}; ngemm(HID, DFF, WFO, DFF, M, 4, lds, E); }
    if (IN(5)) PH_NORM_A(0, x)
    if (IN(6)) PH_FFN_IN()
    if (IN(7)) PH_FFN_OUT()
    if (IN(8)) {
        for (int m = gw; m < M; m += NGW) res_norm_row(XR + (size_t)m * D, MB + (size_t)m * D, norms + 3 * 1024, XR + (size_t)m * D, XN + (size_t)m * D, lane);
        const int NI = 16 * 48 + 16 * 34 + 16 * 32 + 2 * 32 * 8;
        for (int it = gw; it < NI; it += NGW) { int r = it;
            WT_JOB(r, args.in[8], 1024, 1536, (h16*)(ws + WS_WKVQ), args.in[7], 0, 0);
            WT_JOB(r, args.in[5], 1024, 1072, (h16*)(ws + WS_WKVQ), norms + 4 * 1024, 0, 1536);
            WT_JOB(r, args.in[6], 1024, 1024, (h16*)(ws + WS_WNO), nullptr, 0, 0);
            WT_JOB(r, args.in[11], 2048, 256, (h16*)(ws + WS_WC1K), nullptr, 0, 0);
            WT_JOB(r, args.in[13], 2048, 256, (h16*)(ws + WS_WC1V), nullptr, 0, 0); }
        { h16* z = (h16*)(ws + WS_WKVQ) + (size_t)2608 * 1024; for (int i = gt; i < 208 * 1024; i += NGT) z[i] = (h16)0.f; }
        for (int o = gw; o < 512; o += NGW) {
            const int which = o >> 8, c = o & 255; const float* pos = args.in[which ? 10 : 9]; const float* w1 = args.in[which ? 13 : 11]; float a = 0.f;
            for (int k = lane; k < 2048; k += 64) a += pos[k] * w1[(size_t)k * 256 + c];
            a = wave_sum(a); if (lane == 0) (which ? BIASV : BIASK)[c] = a; }
    }
    if (IN(9)) { EpiKvq E{KV6, QN, GATES, NC, NS}; ngemm(XN, 1024, (const h16*)(ws + WS_WKVQ), 1024, M, 11, lds, E); }
    if (IN(10)) {
        { EpiCmp E{HC, BIASK}; ngemm(KV6, 1024, (const h16*)(ws + WS_WC1K), 2048, 4096, 1, lds, E); }
        { EpiCmp E{HC + (size_t)4096 * 256, BIASV}; ngemm(KV6 + (size_t)8 * T * 64, 1024, (const h16*)(ws + WS_WC1V), 2048, 4096, 1, lds, E); }
    }
    if (IN(11)) {
        for (int i = gt; i < 2 * 4096 * 64; i += NGT) { const int which = i >> 18, r = (i >> 6) & 4095, d = i & 63; const float* w2 = args.in[which ? 14 : 12]; const h16* hr = HC + ((size_t)which * 4096 + r) * 256; float a = 0.f;
            for (int c = 0; c < 256; ++c) a += (float)hr[c] * w2[c * 64 + d];
            if ((r & 511) == 511) a = 0.f;
            (which ? CV : CK)[(size_t)r * 64 + d] = (h16)a; }
    }
    if (IN(12)) n_nsa_attn(QN, KV6, CK, CV, GATES, O1, lds);
    if (IN(13)) { EpiF32 E{MB, 1024}; ngemm(O1, 1024, (const h16*)(ws + WS_WNO), 1024, M, 4, lds, E); }
    if (IN(14)) PH_NORM_A(1, XR)
    if (IN(15)) PH_FFN_IN()
    if (IN(16)) PH_FFN_OUT()
    if (IN(17)) { for (int m = gw; m < M; m += NGW) res_norm_row(XR + (size_t)m * D, MB + (size_t)m * D, norms + 7 * 1024, XR + (size_t)m * D, nullptr, lane); }
#undef IN
}

extern "C" void kernel_launch(void* const* d_in, const int* in_sizes, int n_in, void* d_out, int out_size, void* d_ws, size_t ws_size, hipStream_t stream) {
    static int grid = 0;
    if (grid == 0) {
        if (n_in != 17 || out_size != M * D || ws_size < WS_END) { fprintf(stderr, "kernel_launch: unexpected problem (n_in %d out %d ws %zu)\n", n_in, out_size, ws_size); grid = -1; return; }
        int dev = 0, cus = 0;
        (void)hipGetDevice(&dev); (void)hipDeviceGetAttribute(&cus, hipDeviceAttributeMultiprocessorCount, dev);
#define SETATTR(p) if (hipFuncSetAttribute((const void*)mk<p>, hipFuncAttributeMaxDynamicSharedMemorySize, LDS_BYTES) != hipSuccess) { fprintf(stderr, "kernel_launch: hipFuncSetAttribute failed\n"); grid = -1; return; }
        SETATTR(0) SETATTR(1) SETATTR(2) SETATTR(3) SETATTR(4) SETATTR(5) SETATTR(6) SETATTR(7) SETATTR(8) SETATTR(9)
        SETATTR(10) SETATTR(11) SETATTR(12) SETATTR(13) SETATTR(14) SETATTR(15) SETATTR(16) SETATTR(17)
        (void)hipGetLastError();
        grid = cus > 0 ? cus : 256;
    }
    if (grid < 0) return;
    Args a{};
    for (int i = 0; i < 17; ++i) a.in[i] = (const float*)d_in[i];
    a.out = (float*)d_out; a.ws = (unsigned char*)d_ws;
#define LAUNCH_PH(p) { a.ph_lo = p; a.ph_hi = p + 1; hipLaunchKernelGGL(mk<p>, dim3(grid), dim3(NT), LDS_BYTES, stream, a); }
    LAUNCH_PH(0) LAUNCH_PH(1) LAUNCH_PH(2) LAUNCH_PH(3) LAUNCH_PH(4) LAUNCH_PH(5) LAUNCH_PH(6) LAUNCH_PH(7) LAUNCH_PH(8) LAUNCH_PH(9)
    LAUNCH_PH(10) LAUNCH_PH(11) LAUNCH_PH(12) LAUNCH_PH(13) LAUNCH_PH(14) LAUNCH_PH(15) LAUNCH_PH(16) LAUNCH_PH(17)
}
```

```cpp
#include <hip/hip_runtime.h>
#include <cstdio>
#include <cstdint>

#ifndef MK_ONE_LAUNCH
#define MK_ONE_LAUNCH 1
#endif

typedef _Float16 h16;
typedef _Float16 h16x8 __attribute__((ext_vector_type(8)));
typedef _Float16 h16x4 __attribute__((ext_vector_type(4)));
typedef float f32x4 __attribute__((ext_vector_type(4)));

constexpr int BATCH = 2, T = 8192, D = 1024, M = BATCH * T;
constexpr int RH = 4, DK = 256, DV = 512;
constexpr int NG = 4, HD = 64, NCP = 512;
constexpr int DFF = 2816;
constexpr int SUP = 512, NSUP = T / SUP;
constexpr float EPS = 1e-6f;
constexpr int NPHASE = 18;
constexpr int NT = 512;
constexpr int LDS_BYTES = 147456;

constexpr size_t MiB = 1u << 20;
constexpr size_t WS_CTL = 0;
constexpr size_t WS_RC = 1 * MiB, WS_RS = 5 * MiB;
constexpr size_t WS_NC = 9 * MiB, WS_NS = 9 * MiB + 256 * 1024;
constexpr size_t WS_BIASK = 9 * MiB + 512 * 1024, WS_BIASV = WS_BIASK + 1024;
constexpr size_t WS_WC1K = 10 * MiB, WS_WC1V = 11 * MiB;
constexpr size_t WS_WA = 12 * MiB;
constexpr size_t WS_WKVQ = 12 * MiB, WS_WNO = 18 * MiB;
constexpr size_t WS_WRO = 24 * MiB;
constexpr size_t WS_XN = 28 * MiB;
constexpr size_t WS_SS = 28 * MiB;
constexpr size_t WS_O1 = 28 * MiB;
constexpr size_t WS_Q0 = 60 * MiB, WS_K0 = 92 * MiB, WS_V0 = 124 * MiB, WS_Y = 188 * MiB;
constexpr size_t WS_MB = 60 * MiB;
constexpr size_t WS_WFI = 124 * MiB, WS_WFO = 135 * MiB;
constexpr size_t WS_HID = 144 * MiB;
constexpr size_t WS_KC = 124 * MiB, WS_VC = 132 * MiB, WS_KS = 140 * MiB, WS_VS = 148 * MiB, WS_KW = 156 * MiB, WS_VW = 164 * MiB;
constexpr size_t WS_QN = 172 * MiB;
constexpr size_t WS_GATES = 204 * MiB;
constexpr size_t WS_HC = 208 * MiB;
constexpr size_t WS_CK = 212 * MiB, WS_CV = 212 * MiB + 512 * 1024;
constexpr size_t WS_END = 252 * MiB;

struct Args { const float* in[17]; float* out; unsigned char* ws; int ph_lo, ph_hi; };

__device__ __forceinline__ float wave_sum(float v) {
#pragma unroll
    for (int o = 1; o < 64; o <<= 1) v += __shfl_xor(v, o);
    return v;
}
__device__ __forceinline__ float wave_max(float v) {
#pragma unroll
    for (int o = 1; o < 64; o <<= 1) v = fmaxf(v, __shfl_xor(v, o));
    return v;
}
#define LDS_FENCE() asm volatile("s_waitcnt lgkmcnt(0)" ::: "memory")

__device__ __forceinline__ void sincos_acc(float ang, float& c, float& s) {
    const double x = (double)ang;
    const double k = __builtin_rint(x * 0.63661977236758134308);
    double y = __builtin_fma(-k, 1.57079632679489655800, x);
    y = __builtin_fma(-k, 6.12323399573676603587e-17, y);
    const double y2 = y * y;
    double sp = -2.5052108385441718775e-08; sp = sp * y2 + 2.7557319223985890653e-06; sp = sp * y2 - 1.9841269841269841270e-04; sp = sp * y2 + 8.3333333333333332177e-03; sp = sp * y2 - 1.6666666666666665741e-01;
    const double sy = y + y * y2 * sp;
    double cp = 2.0876756987868098979e-09; cp = cp * y2 - 2.7557319223985888e-07; cp = cp * y2 + 2.4801587301587301566e-05; cp = cp * y2 - 1.3888888888888889419e-03; cp = cp * y2 + 4.1666666666666664354e-02; cp = cp * y2 - 0.5;
    const double cy = 1.0 + y2 * cp;
    const int q = ((int)k) & 3;
    const double sr = (q == 0) ? sy : (q == 1) ? cy : (q == 2) ? -sy : -cy;
    const double cr = (q == 0) ? cy : (q == 1) ? -sy : (q == 2) ? -cy : sy;
    c = (float)cr; s = (float)sr;
}
__device__ __forceinline__ float silu_f(float x) { return x / (1.f + __expf(-x)); }
__device__ __forceinline__ float sigmoid_f(float x) { return 1.f / (1.f + __expf(-x)); }
__device__ __forceinline__ float gelu_tanh_f(float x) { const float u = 0.7978845608028654f * (x + 0.044715f * x * x * x); return 0.5f * x * (1.f + tanhf(u)); }
__device__ __forceinline__ float ret_lg(int h) { return log1pf(-exp2f(-5.0f - (float)h)); }

__device__ __forceinline__ void wt_item(const float* W, int K, int N, h16* WT, const float* gain, int kind, int rowoff, float* scr, int item, int lane) {
    const int nblk = (N + 31) / 32, kb = item / nblk, nb = item % nblk, k0 = 64 * kb, n0 = 32 * nb;
    const int ncol = n0 + (lane & 31);
#pragma unroll 8
    for (int i = 0; i < 32; ++i) { const int kk = 2 * i + (lane >> 5); float v = 0.f; if (ncol < N) v = W[(size_t)(k0 + kk) * N + ncol]; if (gain) v *= gain[k0 + kk]; scr[kk * 33 + (lane & 31)] = v; }
    LDS_FENCE();
    const int c = lane & 7;
#pragma unroll
    for (int j = 0; j < 4; ++j) {
        const int nl = (lane >> 3) + 8 * j, n = n0 + nl; const float* s = scr + (8 * c) * 33 + nl;
        h16x8 o;
#pragma unroll
        for (int e = 0; e < 8; ++e) o[e] = (h16)s[e * 33];
        int row;
        if (kind == 0) row = rowoff + n;
        else { row = (n < DFF) ? (256 * (n >> 7) + (n & 127)) : (256 * ((n - DFF) >> 7) + 128 + ((n - DFF) & 127)); }
        if (n < N || kind == 2) *(h16x8*)(WT + (size_t)row * K + k0 + 8 * c) = o;
    }
    LDS_FENCE();
}
#define WT_JOB(r, W, K, N, WT, gain, kind, rowoff) { const int _ni = ((K) / 64) * (((N) + 31) / 32); if ((r) >= 0 && (r) < _ni) wt_item(W, K, N, WT, gain, kind, rowoff, scr, r, lane); (r) -= _ni; }

__device__ __forceinline__ void xn_row(const float* xrow, h16* orow, int lane) {
    f32x4 v[4]; float s = 0.f;
#pragma unroll
    for (int j = 0; j < 4; ++j) { v[j] = *(const f32x4*)(xrow + 4 * lane + 256 * j); s += v[j].x * v[j].x + v[j].y * v[j].y + v[j].z * v[j].z + v[j].w * v[j].w; }
    const float rstd = rsqrtf(wave_sum(s) * (1.f / D) + EPS);
#pragma unroll
    for (int j = 0; j < 4; ++j) { h16x4 o; o[0] = (h16)(v[j].x * rstd); o[1] = (h16)(v[j].y * rstd); o[2] = (h16)(v[j].z * rstd); o[3] = (h16)(v[j].w * rstd); *(h16x4*)(orow + 4 * lane + 256 * j) = o; }
}
__device__ __forceinline__ void res_norm_row(const float* xi, const float* mb, const float* gain, float* xo, h16* xn, int lane) {
    f32x4 a[4], r[4]; float s = 0.f;
#pragma unroll
    for (int j = 0; j < 4; ++j) { a[j] = *(const f32x4*)(mb + 4 * lane + 256 * j); r[j] = *(const f32x4*)(xi + 4 * lane + 256 * j); s += a[j].x * a[j].x + a[j].y * a[j].y + a[j].z * a[j].z + a[j].w * a[j].w; }
    const float rstd = rsqrtf(wave_sum(s) * (1.f / D) + EPS); float s2 = 0.f;
#pragma unroll
    for (int j = 0; j < 4; ++j) { const f32x4 g = *(const f32x4*)(gain + 4 * lane + 256 * j); r[j] = r[j] + a[j] * rstd * g; *(f32x4*)(xo + 4 * lane + 256 * j) = r[j]; s2 += r[j].x * r[j].x + r[j].y * r[j].y + r[j].z * r[j].z + r[j].w * r[j].w; }
    if (xn) {
        const float rs2 = rsqrtf(wave_sum(s2) * (1.f / D) + EPS);
#pragma unroll
        for (int j = 0; j < 4; ++j) { h16x4 o; o[0] = (h16)(r[j].x * rs2); o[1] = (h16)(r[j].y * rs2); o[2] = (h16)(r[j].z * rs2); o[3] = (h16)(r[j].w * rs2); *(h16x4*)(xn + 4 * lane + 256 * j) = o; }
    }
}

constexpr int CT_LD = 260;
template <class Epi>
__device__ __forceinline__ void ngemm(const h16* A, int lda, const h16* Bt, int K, int Mrows, int Ntiles, float* lds, const Epi& E) {
    float* As = lds; float* Bs = lds + 64 * 33; float* Ct = lds + 64 * 33 + 256 * 33;
    const int tid = threadIdx.x, ty = tid >> 5, tx = tid & 31;
    const int nunits = (Mrows / 64) * Ntiles;
    for (int u = blockIdx.x; u < nunits; u += gridDim.x) {
        const int um = u / Ntiles, un = u % Ntiles;
        float acc[4][8];
#pragma unroll
        for (int i = 0; i < 4; ++i)
#pragma unroll
            for (int j = 0; j < 8; ++j) acc[i][j] = 0.f;
        for (int k0 = 0; k0 < K; k0 += 32) {
            { const h16x4 v = *(const h16x4*)(A + (size_t)(um * 64 + (tid >> 3)) * lda + k0 + (tid & 7) * 4);
#pragma unroll
              for (int j = 0; j < 4; ++j) As[(tid >> 3) * 33 + (tid & 7) * 4 + j] = (float)v[j]; }
            { const h16* p = Bt + (size_t)(un * 256 + (tid >> 1)) * K + k0 + (tid & 1) * 16; const h16x8 v0 = *(const h16x8*)p, v1 = *(const h16x8*)(p + 8);
#pragma unroll
              for (int j = 0; j < 8; ++j) { Bs[(tid >> 1) * 33 + (tid & 1) * 16 + j] = (float)v0[j]; Bs[(tid >> 1) * 33 + (tid & 1) * 16 + 8 + j] = (float)v1[j]; } }
            __syncthreads();
#pragma unroll 4
            for (int kk = 0; kk < 32; ++kk) {
                float a[4], b[8];
#pragma unroll
                for (int i = 0; i < 4; ++i) a[i] = As[(ty * 4 + i) * 33 + kk];
#pragma unroll
                for (int j = 0; j < 8; ++j) b[j] = Bs[(tx + 32 * j) * 33 + kk];
#pragma unroll
                for (int i = 0; i < 4; ++i)
#pragma unroll
                    for (int j = 0; j < 8; ++j) acc[i][j] += a[i] * b[j];
            }
            __syncthreads();
        }
#pragma unroll
        for (int i = 0; i < 4; ++i)
#pragma unroll
            for (int j = 0; j < 8; ++j) Ct[(ty * 4 + i) * CT_LD + tx + 32 * j] = acc[i][j];
        __syncthreads();
        E(um, un, Ct);
        __syncthreads();
    }
}

struct EpiRetIn {
    h16 *Q0, *K0, *V0, *G0; const float *RC, *RS;
    __device__ __forceinline__ void operator()(int um, int un, const float* Ct) const {
        const int tid = threadIdx.x;
        if (un < 8) {
            const bool isk = un >= 4; const int h = un & 3; h16* dst = isk ? K0 : Q0; const float sc = isk ? 0.0625f : 1.f;
            for (int idx = tid; idx < 64 * 128; idx += NT) { const int r = idx >> 7, c = idx & 127, m = um * 64 + r, t = m & (T - 1);
                const float x1 = Ct[r * CT_LD + c], x2 = Ct[r * CT_LD + c + 128], cs = RC[t * 128 + c], sn = RS[t * 128 + c];
                dst[(size_t)m * 1024 + h * 256 + c] = (h16)((x1 * cs - x2 * sn) * sc); dst[(size_t)m * 1024 + h * 256 + c + 128] = (h16)((x1 * sn + x2 * cs) * sc); }
        } else {
            h16* dst = (un < 16) ? V0 : G0; const int cb = ((un - 8) & 7) * 256;
            for (int idx = tid; idx < 64 * 256; idx += NT) { const int r = idx >> 8, c = idx & 255, m = um * 64 + r; dst[(size_t)m * 2048 + cb + c] = (h16)Ct[r * CT_LD + c]; }
        }
    }
};
struct EpiF32 { float* O; int ldc;
    __device__ __forceinline__ void operator()(int um, int un, const float* Ct) const {
        for (int idx = threadIdx.x; idx < 64 * 256; idx += NT) { const int r = idx >> 8, c = idx & 255; O[(size_t)(um * 64 + r) * ldc + un * 256 + c] = Ct[r * CT_LD + c]; } }
};
struct EpiSwiglu { h16* H;
    __device__ __forceinline__ void operator()(int um, int un, const float* Ct) const {
        for (int idx = threadIdx.x; idx < 64 * 128; idx += NT) { const int r = idx >> 7, c = idx & 127; H[(size_t)(um * 64 + r) * DFF + un * 128 + c] = (h16)(silu_f(Ct[r * CT_LD + c]) * Ct[r * CT_LD + c + 128]); } }
};
struct EpiKvq {
    h16* KV6; h16* QN; float* GATES; const float *NC, *NS;
    __device__ __forceinline__ void operator()(int um, int un, const float* Ct) const {
        const int tid = threadIdx.x;
        if (un < 6) {
            h16* dst = KV6 + (size_t)un * (8u * T * 64); const bool rot = (un & 1) == 0;
            for (int idx = tid; idx < 64 * 256; idx += NT) { const int r = idx >> 8, c = idx & 255, m = um * 64 + r, b = m >> 13, t = m & (T - 1), g = c >> 6, d = c & 63;
                float v = Ct[r * CT_LD + c];
                if (rot && d < 16) { const int i = d & 7; const float cs = NC[t * 8 + i], sn = NS[t * 8 + i]; const float x1 = Ct[r * CT_LD + (c & ~15) + i], x2 = Ct[r * CT_LD + (c & ~15) + i + 8]; v = (d < 8) ? (x1 * cs - x2 * sn) : (x1 * sn + x2 * cs); }
                dst[((size_t)(b * 4 + g) * T + t) * 64 + d] = (h16)v; }
        } else if (un < 10) {
            for (int idx = tid; idx < 64 * 256; idx += NT) { const int r = idx >> 8, c = idx & 255, m = um * 64 + r, t = m & (T - 1), d = c & 63;
                float v = Ct[r * CT_LD + c];
                if (d < 16) { const int i = d & 7; const float cs = NC[t * 8 + i], sn = NS[t * 8 + i]; const float x1 = Ct[r * CT_LD + (c & ~15) + i], x2 = Ct[r * CT_LD + (c & ~15) + i + 8]; v = (d < 8) ? (x1 * cs - x2 * sn) : (x1 * sn + x2 * cs); }
                QN[(size_t)m * 1024 + (un - 6) * 256 + c] = (h16)(v * 0.125f); }
        } else {
            for (int idx = tid; idx < 64 * 48; idx += NT) { const int r = idx / 48, c = idx % 48; GATES[(size_t)(um * 64 + r) * 48 + c] = sigmoid_f(Ct[r * CT_LD + c]); }
        }
    }
};
struct EpiCmp { h16* HC; const float* bias;
    __device__ __forceinline__ void operator()(int um, int un, const float* Ct) const {
        for (int idx = threadIdx.x; idx < 64 * 256; idx += NT) { const int r = idx >> 8, c = idx & 255; HC[(size_t)(um * 64 + r) * 256 + c] = (h16)gelu_tanh_f(Ct[r * CT_LD + c] + bias[c]); } }
};

__device__ __forceinline__ void n_ret_state(const h16* K0, const h16* V0, h16* SS) {
    const int tid = threadIdx.x, d = tid & 255, half = tid >> 8;
    for (int it = blockIdx.x; it < 8 * 128; it += gridDim.x) {
        const int bh = it >> 7, vq = it & 127, b = bh >> 2, h = bh & 3, c0 = vq * 4 + half * 2;
        const float gam = 1.f - exp2f(-5.f - (float)h);
        const h16* kp = K0 + (size_t)(b * T) * 1024 + h * 256 + d; const h16* vp = V0 + (size_t)(b * T) * 2048 + h * 512 + c0;
        float s0 = 0.f, s1 = 0.f;
        for (int jb = 0; jb < (NSUP - 1) * SUP; jb += 8) {
            float kv[8], v0[8], v1[8];
#pragma unroll
            for (int e = 0; e < 8; ++e) { kv[e] = (float)kp[(size_t)(jb + e) * 1024]; v0[e] = (float)vp[(size_t)(jb + e) * 2048]; v1[e] = (float)vp[(size_t)(jb + e) * 2048 + 1]; }
#pragma unroll
            for (int e = 0; e < 8; ++e) { s0 = gam * s0 + kv[e] * v0[e]; s1 = gam * s1 + kv[e] * v1[e]; }
            if (((jb + 8) & (SUP - 1)) == 0) { const int ms = (jb + 8) / SUP - 1; h16* sp = SS + (((size_t)bh * (NSUP - 1) + ms) * 512 + c0) * 256 + d; sp[0] = (h16)s0; sp[256] = (h16)s1; }
        }
    }
}
__device__ __forceinline__ void n_ret_out(const h16* Q0, const h16* K0, const h16* V0, const h16* G0, const h16* SS, const float* gn, h16* Y, float* lds) {
    const int tid = threadIdx.x, lane = tid & 63, wave = tid >> 6;
    float* qs = lds + wave * 768; float* sc = qs + 256;
    const int gw = blockIdx.x * 8 + wave, NGW = gridDim.x * 8;
    for (int it = gw; it < M * 4; it += NGW) {
        const int m = ((it >> 5) << 3) | (it & 7), h = (it >> 3) & 3, b = m >> 13, t = m & (T - 1), tl = t & (SUP - 1), s0 = t - tl, ms = t / SUP, bh = b * 4 + h;
        const float lgh = ret_lg(h);
        for (int i = lane; i < 256; i += 64) qs[i] = (float)Q0[(size_t)m * 1024 + h * 256 + i];
        LDS_FENCE();
        for (int jj = lane; jj <= tl; jj += 64) {
            const h16* kr = K0 + (size_t)(b * T + s0 + jj) * 1024 + h * 256; float dot = 0.f;
#pragma unroll 2
            for (int d = 0; d < 256; d += 8) { const h16x8 kv = *(const h16x8*)(kr + d);
#pragma unroll
                for (int e = 0; e < 8; ++e) dot += (float)kv[e] * qs[d + e]; }
            sc[jj] = dot * __expf(lgh * (float)(tl - jj));
        }
        LDS_FENCE();
        float o[8];
#pragma unroll
        for (int e = 0; e < 8; ++e) o[e] = 0.f;
        const h16* vb = V0 + (size_t)(b * T + s0) * 2048 + h * 512 + lane * 8;
        for (int jj = 0; jj <= tl; ++jj) { const float s = sc[jj]; const h16x8 vv = *(const h16x8*)(vb + (size_t)jj * 2048);
#pragma unroll
            for (int e = 0; e < 8; ++e) o[e] += s * (float)vv[e]; }
        if (ms > 0) {
            const h16* sp = SS + (((size_t)bh * (NSUP - 1) + ms - 1) * 512 + lane * 8) * 256; const float qd = __expf(lgh * (float)(tl + 1));
            float cr[8];
#pragma unroll
            for (int e = 0; e < 8; ++e) cr[e] = 0.f;
#pragma unroll 1
            for (int d = 0; d < 256; d += 8) {
#pragma unroll
                for (int e = 0; e < 8; ++e) { const h16x8 sv = *(const h16x8*)(sp + e * 256 + d);
#pragma unroll
                    for (int f = 0; f < 8; ++f) cr[e] += (float)sv[f] * qs[d + f]; } }
#pragma unroll
            for (int e = 0; e < 8; ++e) o[e] += qd * cr[e];
        }
        float s1 = 0.f;
#pragma unroll
        for (int e = 0; e < 8; ++e) s1 += o[e];
        const float mu = wave_sum(s1) * (1.f / DV); float s2 = 0.f;
#pragma unroll
        for (int e = 0; e < 8; ++e) { o[e] -= mu; s2 += o[e] * o[e]; }
        const float rstd = rsqrtf(wave_sum(s2) * (1.f / DV) + EPS);
        const h16x8 gv = *(const h16x8*)(G0 + (size_t)m * 2048 + h * 512 + lane * 8); h16x8 yo;
#pragma unroll
        for (int e = 0; e < 8; ++e) yo[e] = (h16)(silu_f((float)gv[e]) * o[e] * rstd * gn[h * 512 + lane * 8 + e]);
        *(h16x8*)(Y + (size_t)m * 2048 + h * 512 + lane * 8) = yo;
        LDS_FENCE();
    }
}

__device__ __forceinline__ void dots4(const h16* krow, const float* qs, float (&dt)[4]) {
#pragma unroll
    for (int r = 0; r < 4; ++r) dt[r] = 0.f;
#pragma unroll
    for (int c = 0; c < 8; ++c) { const h16x8 kv = *(const h16x8*)(krow + 8 * c);
#pragma unroll
        for (int r = 0; r < 4; ++r)
#pragma unroll
            for (int e = 0; e < 8; ++e) dt[r] += (float)kv[e] * qs[r * 64 + 8 * c + e]; }
}
__device__ __forceinline__ void softmax4(float* sc, int n, int lane) {
    for (int r = 0; r < 4; ++r) {
        float mx = -INFINITY; for (int i = lane; i < n; i += 64) mx = fmaxf(mx, sc[r * 1024 + i]);
        mx = wave_max(mx); float sum = 0.f;
        for (int i = lane; i < n; i += 64) { const float e = __expf(sc[r * 1024 + i] - mx); sc[r * 1024 + i] = e; sum += e; }
        sum = wave_sum(sum); const float inv = 1.f / sum;
        for (int i = lane; i < n; i += 64) sc[r * 1024 + i] *= inv;
    }
    LDS_FENCE();
}
__device__ __forceinline__ int select_blocks(float imp0, float imp1, int cur, int* sel, int lane) {
    int nsel = 0;
    if (lane == 0) { sel[0] = 0; }
    nsel = 1;
    if (cur >= 1) { if (lane == 0) sel[nsel] = cur; ++nsel; }
    if (cur >= 2) { if (lane == 0) sel[nsel] = cur - 1; ++nsel; }
    const int sA = lane, sB = lane + 64;
    float v0 = (sA <= cur && sA != 0 && sA != cur && sA != cur - 1) ? imp0 : -INFINITY;
    float v1 = (sB <= cur && sB != 0 && sB != cur && sB != cur - 1) ? imp1 : -INFINITY;
    while (nsel < 16) {
        const float mx = wave_max(fmaxf(v0, v1));
        if (mx == -INFINITY) break;
        const unsigned long long b0 = __ballot(v0 == mx);
        int s;
        if (b0) { const int l = __ffsll((long long)b0) - 1; s = l; if (lane == l) v0 = -INFINITY; }
        else { const unsigned long long b1 = __ballot(v1 == mx); const int l = __ffsll((long long)b1) - 1; s = l + 64; if (lane == l) v1 = -INFINITY; }
        if (lane == 0) sel[nsel] = s;
        ++nsel;
    }
    LDS_FENCE();
    return nsel;
}
__device__ __forceinline__ void n_nsa_attn(const h16* QN, const h16* KV6, const h16* CK, const h16* CV, const float* GATES, h16* O1, float* lds) {
    const int tid = threadIdx.x, lane = tid & 63, wave = tid >> 6;
    float* qs = lds + wave * 4480; float* sc = qs + 256; int* sel = (int*)(sc + 4096);
    const h16 *KS = KV6 + 2 * (size_t)(8 * T * 64), *VS = KV6 + 3 * (size_t)(8 * T * 64), *KW = KV6 + 4 * (size_t)(8 * T * 64), *VW = KV6 + 5 * (size_t)(8 * T * 64);
    const int gw = blockIdx.x * 8 + wave, NGW = gridDim.x * 8;
    for (int it = gw; it < M * 4; it += NGW) {
        const int m = it >> 2, g = it & 3, b = m >> 13, t = m & (T - 1), bg = b * 4 + g;
        for (int i = lane; i < 256; i += 64) qs[i] = (float)QN[(size_t)m * 1024 + g * 256 + i];
        LDS_FENCE();
        const int nv = (t >= 31) ? ((t - 31) >> 4) + 1 : 0;
        float oc[4] = {0.f, 0.f, 0.f, 0.f};
        if (nv > 0) {
            for (int n = lane; n < nv; n += 64) { float dt[4]; dots4(CK + ((size_t)bg * NCP + n) * 64, qs, dt);
#pragma unroll
                for (int r = 0; r < 4; ++r) sc[r * 1024 + n] = dt[r]; }
            LDS_FENCE();
            softmax4(sc, nv, lane);
            for (int n = 0; n < nv; ++n) { const float vv = (float)CV[((size_t)bg * NCP + n) * 64 + lane];
#pragma unroll
                for (int r = 0; r < 4; ++r) oc[r] += sc[r * 1024 + n] * vv; }
        }
        float imp[2];
#pragma unroll
        for (int q = 0; q < 2; ++q) { const int s = lane + 64 * q; float a = 0.f;
#pragma unroll
            for (int e = -1; e < 4; ++e) { const int n = 4 * s + e; if (n >= 0 && n < nv) { const float p = sc[n] + sc[1024 + n] + sc[2048 + n] + sc[3072 + n]; a += (e == -1 || e == 3) ? p : 2.f * p; } }
            imp[q] = a; }
        LDS_FENCE();
        const int cur = t >> 6;
        const int nsel = select_blocks(imp[0], imp[1], cur, sel, lane);
        float os[4] = {0.f, 0.f, 0.f, 0.f};
        for (int i2 = 0; i2 < nsel; ++i2) { const int tok = sel[i2] * 64 + lane; float dt[4]; dots4(KS + ((size_t)bg * T + tok) * 64, qs, dt);
#pragma unroll
            for (int r = 0; r < 4; ++r) sc[r * 1024 + i2 * 64 + lane] = (tok <= t) ? dt[r] : -INFINITY; }
        LDS_FENCE();
        softmax4(sc, nsel * 64, lane);
        for (int kk = 0; kk < nsel * 64; ++kk) { const int tok = sel[kk >> 6] * 64 + (kk & 63); const float vv = (float)VS[((size_t)bg * T + tok) * 64 + lane];
#pragma unroll
            for (int r = 0; r < 4; ++r) os[r] += sc[r * 1024 + kk] * vv; }
        LDS_FENCE();
        float ow[4] = {0.f, 0.f, 0.f, 0.f};
        const int nw = (t + 1 < 512) ? t + 1 : 512, t0 = t - nw + 1;
        for (int i = lane; i < nw; i += 64) { float dt[4]; dots4(KW + ((size_t)bg * T + t0 + i) * 64, qs, dt);
#pragma unroll
            for (int r = 0; r < 4; ++r) sc[r * 1024 + i] = dt[r]; }
        LDS_FENCE();
        softmax4(sc, nw, lane);
        for (int i = 0; i < nw; ++i) { const float vv = (float)VW[((size_t)bg * T + t0 + i) * 64 + lane];
#pragma unroll
            for (int r = 0; r < 4; ++r) ow[r] += sc[r * 1024 + i] * vv; }
        LDS_FENCE();
#pragma unroll
        for (int r = 0; r < 4; ++r) { const float* gp = GATES + (size_t)m * 48 + (g * 4 + r) * 3;
            O1[(size_t)m * 1024 + (g * 4 + r) * 64 + lane] = (h16)(gp[0] * oc[r] + gp[1] * os[r] + gp[2] * ow[r]); }
    }
}

#define LAS __attribute__((address_space(3)))
#define XB_TMO      128
#define XB_XCNT(j)  (256  + 64 * (j))
#define XB_XSUB(j)  (1280 + 64 * (j))
#define XB_XGEN(j)  (2304 + 64 * (j))
#define XB_TOP      3328
#define XB_TOPGEN   3392
#define XCD_BAR_WORDS 3456
#define XB_SPIN_CAP (1u << 18)
__device__ __forceinline__ unsigned xb_ld(unsigned* p)              { return __hip_atomic_load(p, __ATOMIC_RELAXED, __HIP_MEMORY_SCOPE_AGENT); }
__device__ __forceinline__ unsigned xb_add(unsigned* p, unsigned v) { return __hip_atomic_fetch_add(p, v, __ATOMIC_RELAXED, __HIP_MEMORY_SCOPE_AGENT); }
__device__ __forceinline__ unsigned xb_xcc_id() { return (unsigned)__builtin_amdgcn_s_getreg((3 << 11) | 20) & 0xFu; }
#define XB_SPIN(cond, bar) do { unsigned _sp = 0; while (cond) { __builtin_amdgcn_s_sleep(1); \
    if ((++_sp & 255u) == 0u) { if (xb_ld(&(bar)[XB_TMO])) break; if (_sp > XB_SPIN_CAP) { atomicAdd(&(bar)[XB_TMO], 1u); break; } } } } while (0)
struct XcdBarrier { unsigned* bar; unsigned x; volatile LAS unsigned* st; };
__device__ __forceinline__ XcdBarrier xcd_barrier_post(unsigned* bar, volatile LAS unsigned* st) {
    XcdBarrier b; b.bar = bar; b.x = xb_xcc_id(); b.st = st;
    if (threadIdx.x == 0) (void)xb_add(&bar[XB_XCNT(b.x)], 1u);
    return b;
}
__device__ __forceinline__ void xcd_barrier_complete(unsigned* bar, unsigned x, unsigned& nloc, unsigned& nx) {
    const unsigned G = gridDim.x * gridDim.y * gridDim.z;
    unsigned sum, cnt, mine, sp = 0u;
    for (;;) {
        sum = 0u; cnt = 0u; mine = 0u;
#pragma unroll
        for (unsigned j = 0; j < 16; ++j) { const unsigned c = xb_ld(&bar[XB_XCNT(j)]); sum += c; cnt += (c > 0u) ? 1u : 0u; mine = (j == x) ? c : mine; }
        if (sum == G) break;
        __builtin_amdgcn_s_sleep(1);
        if ((++sp & 255u) == 0u) { if (xb_ld(&bar[XB_TMO])) break; if (sp > XB_SPIN_CAP) { atomicAdd(&bar[XB_TMO], 1u); break; } }
    }
    nloc = mine > 0u ? mine : 1u; nx = cnt > 0u ? cnt : 1u;
}
__device__ __forceinline__ void xcd_barrier(const XcdBarrier& b) {
    asm volatile("s_waitcnt vmcnt(0)" ::: "memory");
    __syncthreads();
    if (threadIdx.x == 0) {
        unsigned* bar = b.bar;
        __builtin_amdgcn_s_waitcnt(0);
        unsigned nloc = b.st[0], nx = b.st[1];
        if (nloc == 0u) { xcd_barrier_complete(bar, b.x, nloc, nx); b.st[0] = nloc; b.st[1] = nx; }
        const unsigned old = xb_add(&bar[XB_XSUB(b.x)], 1u);
        const unsigned gen = old / nloc;
        if (old + 1u == (gen + 1u) * nloc) {
            __builtin_amdgcn_fence(__ATOMIC_RELEASE, "agent");
            asm volatile("s_waitcnt vmcnt(0)" ::: "memory");
            const unsigned og = xb_add(&bar[XB_TOP], 1u);
            const unsigned tg = og / nx;
            if (og + 1u == (tg + 1u) * nx) xb_add(&bar[XB_TOPGEN], 1u);
            else XB_SPIN(xb_ld(&bar[XB_TOPGEN]) == tg, bar);
            __builtin_amdgcn_fence(__ATOMIC_ACQUIRE, "agent");
            xb_add(&bar[XB_XGEN(b.x)], 1u);
            asm volatile("s_waitcnt vmcnt(0)" ::: "memory");
        } else {
            XB_SPIN(xb_ld(&bar[XB_XGEN(b.x)]) == gen, bar);
            __builtin_amdgcn_fence(__ATOMIC_ACQUIRE, "agent");
            asm volatile("s_waitcnt vmcnt(0)" ::: "memory");
        }
    }
    __syncthreads();
}
constexpr int MISC_OFF = LDS_BYTES - 64;
constexpr int CW_BAR = 4096;
constexpr size_t CTL_ZERO_BYTES = 64 * 1024;

template <int PH> __global__ void __launch_bounds__(NT, 2) mk(Args args) {
    extern __shared__ __attribute__((aligned(16))) unsigned char lds_raw[];
    float* lds = (float*)lds_raw;
    const int tid = threadIdx.x, lane = tid & 63, wave = tid >> 6;
    const int gw = blockIdx.x * 8 + wave, NGW = gridDim.x * 8, gt = blockIdx.x * NT + tid, NGT = gridDim.x * NT;
    unsigned char* ws = args.ws;
    const float* x = args.in[0]; const float* norms = args.in[1];
    float* RC = (float*)(ws + WS_RC); float* RS = (float*)(ws + WS_RS); float* NC = (float*)(ws + WS_NC); float* NS = (float*)(ws + WS_NS);
    float* BIASK = (float*)(ws + WS_BIASK); float* BIASV = (float*)(ws + WS_BIASV);
    h16* XN = (h16*)(ws + WS_XN); float* MB = (float*)(ws + WS_MB); h16* HID = (h16*)(ws + WS_HID);
    h16* WFI = (h16*)(ws + WS_WFI); h16* WFO = (h16*)(ws + WS_WFO);
    h16* Q0 = (h16*)(ws + WS_Q0); h16* K0 = (h16*)(ws + WS_K0); h16* V0 = (h16*)(ws + WS_V0); h16* G0 = (h16*)args.out; h16* SS = (h16*)(ws + WS_SS); h16* Y = (h16*)(ws + WS_Y);
    h16* KV6 = (h16*)(ws + WS_KC); h16* QN = (h16*)(ws + WS_QN); float* GATES = (float*)(ws + WS_GATES); h16* HC = (h16*)(ws + WS_HC); h16* CK = (h16*)(ws + WS_CK); h16* CV = (h16*)(ws + WS_CV); h16* O1 = (h16*)(ws + WS_O1);
    float* XR = args.out;
    float* scr = lds + wave * (64 * 33);
    const int lo = args.ph_lo, hi = args.ph_hi;
    XcdBarrier bar; bar.bar = nullptr; bar.x = 0; bar.st = nullptr;
    if (PH < 0) {
        volatile LAS unsigned* misc = (volatile LAS unsigned*)((LAS unsigned char*)lds_raw + MISC_OFF);
        if (tid < 2) misc[tid] = 0u;
        __syncthreads();
        bar = xcd_barrier_post((unsigned*)(ws + WS_CTL) + CW_BAR, misc);
    }
#define SEAM(k) { if (PH < 0 && IN(k) && IN((k) + 1)) xcd_barrier(bar); }
#define IN(k) (PH < 0 ? (lo <= (k) && (k) < hi) : (PH == (k)))

    if (IN(0)) {
        const int NI = 16 * 192 + 32 * 32;
        for (int it = gw; it < NI; it += NGW) { int r = it;
            WT_JOB(r, args.in[2], 1024, 6144, (h16*)(ws + WS_WA), norms + 0 * 1024, 0, 0);
            WT_JOB(r, args.in[4], 2048, 1024, (h16*)(ws + WS_WRO), nullptr, 0, 0); }
        for (int i = gt; i < T * 128; i += NGT) { const int t = i >> 7, j = i & 127; const float fr = (float)(1.0 / pow(10000.0, (double)((float)j / 127.0f))); float c, s; sincos_acc((float)t * fr, c, s); RC[i] = c; RS[i] = s; }
        for (int i = gt; i < T * 8; i += NGT) { const int t = i >> 3, j = i & 7; const float fr = (float)pow(500000.0, -(double)(2 * j) / 16.0); float c, s; sincos_acc((float)t * fr, c, s); NC[i] = c; NS[i] = s; }
        for (int m = gw; m < M; m += NGW) xn_row(x + (size_t)m * D, XN + (size_t)m * D, lane);
    }
    SEAM(0)
    if (IN(1)) { EpiRetIn E{Q0, K0, V0, G0, RC, RS}; ngemm(XN, 1024, (const h16*)(ws + WS_WA), 1024, M, 24, lds, E); }
    SEAM(1)
    if (IN(2)) n_ret_state(K0, V0, SS);
    SEAM(2)
    if (IN(3)) n_ret_out(Q0, K0, V0, G0, SS, args.in[3], Y, lds);
    SEAM(3)
    if (IN(4)) { EpiF32 E{MB, 1024}; ngemm(Y, 2048, (const h16*)(ws + WS_WRO), 2048, M, 4, lds, E); }
#define PH_NORM_A(L, xin) {     \
            for (int m = gw; m < M; m += NGW) res_norm_row((xin) + (size_t)m * D, MB + (size_t)m * D, norms + ((L) * 4 + 1) * 1024, XR + (size_t)m * D, XN + (size_t)m * D, lane); \
            const int NI = 16 * 176 + 44 * 32; \
            for (int it = gw; it < NI; it += NGW) { int r = it; \
                WT_JOB(r, args.in[15] + (size_t)(L) * 1024 * 5632, 1024, 5632, WFI, norms + ((L) * 4 + 2) * 1024, 1, 0); \
                WT_JOB(r, args.in[16] + (size_t)(L) * 2816 * 1024, 2816, 1024, WFO, nullptr, 0, 0); } }
#define PH_FFN_IN() { EpiSwiglu E{HID}; ngemm(XN, 1024, WFI, 1024, M, 22, lds, E); }
#define PH_FFN_OUT() { EpiF32 E{MB, 1024}; ngemm(HID, DFF, WFO, DFF, M, 4, lds, E); }
    SEAM(4)
    if (IN(5)) PH_NORM_A(0, x)
    SEAM(5)
    if (IN(6)) PH_FFN_IN()
    SEAM(6)
    if (IN(7)) PH_FFN_OUT()
    SEAM(7)
    if (IN(8)) {
        for (int m = gw; m < M; m += NGW) res_norm_row(XR + (size_t)m * D, MB + (size_t)m * D, norms + 3 * 1024, XR + (size_t)m * D, XN + (size_t)m * D, lane);
        const int NI = 16 * 48 + 16 * 34 + 16 * 32 + 2 * 32 * 8;
        for (int it = gw; it < NI; it += NGW) { int r = it;
            WT_JOB(r, args.in[8], 1024, 1536, (h16*)(ws + WS_WKVQ), args.in[7], 0, 0);
            WT_JOB(r, args.in[5], 1024, 1072, (h16*)(ws + WS_WKVQ), norms + 4 * 1024, 0, 1536);
            WT_JOB(r, args.in[6], 1024, 1024, (h16*)(ws + WS_WNO), nullptr, 0, 0);
            WT_JOB(r, args.in[11], 2048, 256, (h16*)(ws + WS_WC1K), nullptr, 0, 0);
            WT_JOB(r, args.in[13], 2048, 256, (h16*)(ws + WS_WC1V), nullptr, 0, 0); }
        { h16* z = (h16*)(ws + WS_WKVQ) + (size_t)2608 * 1024; for (int i = gt; i < 208 * 1024; i += NGT) z[i] = (h16)0.f; }
        for (int o = gw; o < 512; o += NGW) {
            const int which = o >> 8, c = o & 255; const float* pos = args.in[which ? 10 : 9]; const float* w1 = args.in[which ? 13 : 11]; float a = 0.f;
            for (int k = lane; k < 2048; k += 64) a += pos[k] * w1[(size_t)k * 256 + c];
            a = wave_sum(a); if (lane == 0) (which ? BIASV : BIASK)[c] = a; }
    }
    SEAM(8)
    if (IN(9)) { EpiKvq E{KV6, QN, GATES, NC, NS}; ngemm(XN, 1024, (const h16*)(ws + WS_WKVQ), 1024, M, 11, lds, E); }
    SEAM(9)
    if (IN(10)) {
        { EpiCmp E{HC, BIASK}; ngemm(KV6, 1024, (const h16*)(ws + WS_WC1K), 2048, 4096, 1, lds, E); }
        { EpiCmp E{HC + (size_t)4096 * 256, BIASV}; ngemm(KV6 + (size_t)8 * T * 64, 1024, (const h16*)(ws + WS_WC1V), 2048, 4096, 1, lds, E); }
    }
    SEAM(10)
    if (IN(11)) {
        for (int i = gt; i < 2 * 4096 * 64; i += NGT) { const int which = i >> 18, r = (i >> 6) & 4095, d = i & 63; const float* w2 = args.in[which ? 14 : 12]; const h16* hr = HC + ((size_t)which * 4096 + r) * 256; float a = 0.f;
            for (int c = 0; c < 256; ++c) a += (float)hr[c] * w2[c * 64 + d];
            if ((r & 511) == 511) a = 0.f;
            (which ? CV : CK)[(size_t)r * 64 + d] = (h16)a; }
    }
    SEAM(11)
    if (IN(12)) n_nsa_attn(QN, KV6, CK, CV, GATES, O1, lds);
    SEAM(12)
    if (IN(13)) { EpiF32 E{MB, 1024}; ngemm(O1, 1024, (const h16*)(ws + WS_WNO), 1024, M, 4, lds, E); }
    SEAM(13)
    if (IN(14)) PH_NORM_A(1, XR)
    SEAM(14)
    if (IN(15)) PH_FFN_IN()
    SEAM(15)
    if (IN(16)) PH_FFN_OUT()
    SEAM(16)
    if (IN(17)) { for (int m = gw; m < M; m += NGW) res_norm_row(XR + (size_t)m * D, MB + (size_t)m * D, norms + 7 * 1024, XR + (size_t)m * D, nullptr, lane); }
#undef IN
}

extern "C" void kernel_launch(void* const* d_in, const int* in_sizes, int n_in, void* d_out, int out_size, void* d_ws, size_t ws_size, hipStream_t stream) {
    static int grid = 0;
    if (grid == 0) {
        if (n_in != 17 || out_size != M * D || ws_size < WS_END) { fprintf(stderr, "kernel_launch: unexpected problem (n_in %d out %d ws %zu)\n", n_in, out_size, ws_size); grid = -1; return; }
        int dev = 0, cus = 0;
        (void)hipGetDevice(&dev); (void)hipDeviceGetAttribute(&cus, hipDeviceAttributeMultiprocessorCount, dev);
#define SETATTR(p) if (hipFuncSetAttribute((const void*)mk<p>, hipFuncAttributeMaxDynamicSharedMemorySize, LDS_BYTES) != hipSuccess) { fprintf(stderr, "kernel_launch: hipFuncSetAttribute failed\n"); grid = -1; return; }
        SETATTR(-1) SETATTR(0) SETATTR(1) SETATTR(2) SETATTR(3) SETATTR(4) SETATTR(5) SETATTR(6) SETATTR(7) SETATTR(8) SETATTR(9)
        SETATTR(10) SETATTR(11) SETATTR(12) SETATTR(13) SETATTR(14) SETATTR(15) SETATTR(16) SETATTR(17)
        (void)hipGetLastError();
        grid = cus > 0 ? cus : 256;
    }
    if (grid < 0) return;
    Args a{};
    for (int i = 0; i < 17; ++i) a.in[i] = (const float*)d_in[i];
    a.out = (float*)d_out; a.ws = (unsigned char*)d_ws;
#if MK_ONE_LAUNCH
    if (hipMemsetAsync((char*)d_ws + WS_CTL, 0, CTL_ZERO_BYTES, stream) != hipSuccess) { fprintf(stderr, "kernel_launch: memset failed\n"); return; }
    a.ph_lo = 0; a.ph_hi = NPHASE; hipLaunchKernelGGL(mk<-1>, dim3(grid), dim3(NT), LDS_BYTES, stream, a);
    return;
#endif
#define LAUNCH_PH(p) { a.ph_lo = p; a.ph_hi = p + 1; hipLaunchKernelGGL(mk<p>, dim3(grid), dim3(NT), LDS_BYTES, stream, a); }
    LAUNCH_PH(0) LAUNCH_PH(1) LAUNCH_PH(2) LAUNCH_PH(3) LAUNCH_PH(4) LAUNCH_PH(5) LAUNCH_PH(6) LAUNCH_PH(7) LAUNCH_PH(8) LAUNCH_PH(9)
    LAUNCH_PH(10) LAUNCH_PH(11) LAUNCH_PH(12) LAUNCH_PH(13) LAUNCH_PH(14) LAUNCH_PH(15) LAUNCH_PH(16) LAUNCH_PH(17)
}
```

```cpp
#include <hip/hip_runtime.h>
#include <cstdio>
#include <cstdint>

#ifndef MK_ONE_LAUNCH
#define MK_ONE_LAUNCH 1
#endif

typedef _Float16 h16;
typedef _Float16 h16x8 __attribute__((ext_vector_type(8)));
typedef _Float16 h16x4 __attribute__((ext_vector_type(4)));
typedef float f32x4 __attribute__((ext_vector_type(4)));

constexpr int BATCH = 2, T = 8192, D = 1024, M = BATCH * T;
constexpr int RH = 4, DK = 256, DV = 512;
constexpr int NG = 4, HD = 64, NCP = 512;
constexpr int DFF = 2816;
constexpr int SUP = 512, NSUP = T / SUP;
constexpr float EPS = 1e-6f;
constexpr int NPHASE = 18;
constexpr int NT = 512;
constexpr int LDS_BYTES = 147456;

constexpr size_t MiB = 1u << 20;
constexpr size_t WS_CTL = 0;
constexpr size_t WS_RC = 1 * MiB, WS_RS = 5 * MiB;
constexpr size_t WS_NC = 9 * MiB, WS_NS = 9 * MiB + 256 * 1024;
constexpr size_t WS_BIASK = 9 * MiB + 512 * 1024, WS_BIASV = WS_BIASK + 1024;
constexpr size_t WS_WC1K = 10 * MiB, WS_WC1V = 11 * MiB;
constexpr size_t WS_WA = 12 * MiB;
constexpr size_t WS_WKVQ = 12 * MiB, WS_WNO = 18 * MiB;
constexpr size_t WS_WRO = 24 * MiB;
constexpr size_t WS_XN = 28 * MiB;
constexpr size_t WS_SS = 28 * MiB;
constexpr size_t WS_O1 = 28 * MiB;
constexpr size_t WS_Q0 = 60 * MiB, WS_K0 = 92 * MiB, WS_V0 = 124 * MiB, WS_Y = 188 * MiB;
constexpr size_t WS_MB = 60 * MiB;
constexpr size_t WS_WFI = 124 * MiB, WS_WFO = 135 * MiB;
constexpr size_t WS_HID = 144 * MiB;
constexpr size_t WS_KC = 124 * MiB, WS_VC = 132 * MiB, WS_KS = 140 * MiB, WS_VS = 148 * MiB, WS_KW = 156 * MiB, WS_VW = 164 * MiB;
constexpr size_t WS_QN = 172 * MiB;
constexpr size_t WS_GATES = 204 * MiB;
constexpr size_t WS_HC = 208 * MiB;
constexpr size_t WS_CK = 212 * MiB, WS_CV = 212 * MiB + 512 * 1024;
constexpr size_t WS_END = 252 * MiB;

struct Args { const float* in[17]; float* out; unsigned char* ws; int ph_lo, ph_hi; };

__device__ __forceinline__ float wave_sum(float v) {
#pragma unroll
    for (int o = 1; o < 64; o <<= 1) v += __shfl_xor(v, o);
    return v;
}
__device__ __forceinline__ float wave_max(float v) {
#pragma unroll
    for (int o = 1; o < 64; o <<= 1) v = fmaxf(v, __shfl_xor(v, o));
    return v;
}
#define LDS_FENCE() asm volatile("s_waitcnt lgkmcnt(0)" ::: "memory")

__device__ __forceinline__ void sincos_acc(float ang, float& c, float& s) {
    const double x = (double)ang;
    const double k = __builtin_rint(x * 0.63661977236758134308);
    double y = __builtin_fma(-k, 1.57079632679489655800, x);
    y = __builtin_fma(-k, 6.12323399573676603587e-17, y);
    const double y2 = y * y;
    double sp = -2.5052108385441718775e-08; sp = sp * y2 + 2.7557319223985890653e-06; sp = sp * y2 - 1.9841269841269841270e-04; sp = sp * y2 + 8.3333333333333332177e-03; sp = sp * y2 - 1.6666666666666665741e-01;
    const double sy = y + y * y2 * sp;
    double cp = 2.0876756987868098979e-09; cp = cp * y2 - 2.7557319223985888e-07; cp = cp * y2 + 2.4801587301587301566e-05; cp = cp * y2 - 1.3888888888888889419e-03; cp = cp * y2 + 4.1666666666666664354e-02; cp = cp * y2 - 0.5;
    const double cy = 1.0 + y2 * cp;
    const int q = ((int)k) & 3;
    const double sr = (q == 0) ? sy : (q == 1) ? cy : (q == 2) ? -sy : -cy;
    const double cr = (q == 0) ? cy : (q == 1) ? -sy : (q == 2) ? -cy : sy;
    c = (float)cr; s = (float)sr;
}
__device__ __forceinline__ float silu_f(float x) { return x / (1.f + __expf(-x)); }
__device__ __forceinline__ float sigmoid_f(float x) { return 1.f / (1.f + __expf(-x)); }
__device__ __forceinline__ float gelu_tanh_f(float x) { const float u = 0.7978845608028654f * (x + 0.044715f * x * x * x); return 0.5f * x * (1.f + tanhf(u)); }
__device__ __forceinline__ float ret_lg(int h) { return log1pf(-exp2f(-5.0f - (float)h)); }

__device__ __forceinline__ void wt_item(const float* W, int K, int N, h16* WT, const float* gain, int kind, int rowoff, float* scr, int item, int lane) {
    const int nblk = (N + 31) / 32, kb = item / nblk, nb = item % nblk, k0 = 64 * kb, n0 = 32 * nb;
    const int ncol = n0 + (lane & 31);
#pragma unroll 8
    for (int i = 0; i < 32; ++i) { const int kk = 2 * i + (lane >> 5); float v = 0.f; if (ncol < N) v = W[(size_t)(k0 + kk) * N + ncol]; if (gain) v *= gain[k0 + kk]; scr[kk * 33 + (lane & 31)] = v; }
    LDS_FENCE();
    const int c = lane & 7;
#pragma unroll
    for (int j = 0; j < 4; ++j) {
        const int nl = (lane >> 3) + 8 * j, n = n0 + nl; const float* s = scr + (8 * c) * 33 + nl;
        h16x8 o;
#pragma unroll
        for (int e = 0; e < 8; ++e) o[e] = (h16)s[e * 33];
        int row;
        if (kind == 0) row = rowoff + n;
        else { row = (n < DFF) ? (256 * (n >> 7) + (n & 127)) : (256 * ((n - DFF) >> 7) + 128 + ((n - DFF) & 127)); }
        if (n < N || kind == 2) *(h16x8*)(WT + (size_t)row * K + k0 + 8 * c) = o;
    }
    LDS_FENCE();
}
#define WT_JOB(r, W, K, N, WT, gain, kind, rowoff) { const int _ni = ((K) / 64) * (((N) + 31) / 32); if ((r) >= 0 && (r) < _ni) wt_item(W, K, N, WT, gain, kind, rowoff, scr, r, lane); (r) -= _ni; }

__device__ __forceinline__ void xn_row(const float* xrow, h16* orow, int lane) {
    f32x4 v[4]; float s = 0.f;
#pragma unroll
    for (int j = 0; j < 4; ++j) { v[j] = *(const f32x4*)(xrow + 4 * lane + 256 * j); s += v[j].x * v[j].x + v[j].y * v[j].y + v[j].z * v[j].z + v[j].w * v[j].w; }
    const float rstd = rsqrtf(wave_sum(s) * (1.f / D) + EPS);
#pragma unroll
    for (int j = 0; j < 4; ++j) { h16x4 o; o[0] = (h16)(v[j].x * rstd); o[1] = (h16)(v[j].y * rstd); o[2] = (h16)(v[j].z * rstd); o[3] = (h16)(v[j].w * rstd); *(h16x4*)(orow + 4 * lane + 256 * j) = o; }
}
__device__ __forceinline__ void res_norm_row(const float* xi, const float* mb, const float* gain, float* xo, h16* xn, int lane) {
    f32x4 a[4], r[4]; float s = 0.f;
#pragma unroll
    for (int j = 0; j < 4; ++j) { a[j] = *(const f32x4*)(mb + 4 * lane + 256 * j); r[j] = *(const f32x4*)(xi + 4 * lane + 256 * j); s += a[j].x * a[j].x + a[j].y * a[j].y + a[j].z * a[j].z + a[j].w * a[j].w; }
    const float rstd = rsqrtf(wave_sum(s) * (1.f / D) + EPS); float s2 = 0.f;
#pragma unroll
    for (int j = 0; j < 4; ++j) { const f32x4 g = *(const f32x4*)(gain + 4 * lane + 256 * j); r[j] = r[j] + a[j] * rstd * g; *(f32x4*)(xo + 4 * lane + 256 * j) = r[j]; s2 += r[j].x * r[j].x + r[j].y * r[j].y + r[j].z * r[j].z + r[j].w * r[j].w; }
    if (xn) {
        const float rs2 = rsqrtf(wave_sum(s2) * (1.f / D) + EPS);
#pragma unroll
        for (int j = 0; j < 4; ++j) { h16x4 o; o[0] = (h16)(r[j].x * rs2); o[1] = (h16)(r[j].y * rs2); o[2] = (h16)(r[j].z * rs2); o[3] = (h16)(r[j].w * rs2); *(h16x4*)(xn + 4 * lane + 256 * j) = o; }
    }
}

constexpr int CT_LD = 260;
template <class Epi>
__device__ __forceinline__ void ngemm(const h16* A, int lda, const h16* Bt, int K, int Mrows, int Ntiles, float* lds, const Epi& E) {
    float* As = lds; float* Bs = lds + 64 * 33; float* Ct = lds + 64 * 33 + 256 * 33;
    const int tid = threadIdx.x, ty = tid >> 5, tx = tid & 31;
    const int nunits = (Mrows / 64) * Ntiles;
    for (int u = blockIdx.x; u < nunits; u += gridDim.x) {
        const int um = u / Ntiles, un = u % Ntiles;
        float acc[4][8];
#pragma unroll
        for (int i = 0; i < 4; ++i)
#pragma unroll
            for (int j = 0; j < 8; ++j) acc[i][j] = 0.f;
        for (int k0 = 0; k0 < K; k0 += 32) {
            { const h16x4 v = *(const h16x4*)(A + (size_t)(um * 64 + (tid >> 3)) * lda + k0 + (tid & 7) * 4);
#pragma unroll
              for (int j = 0; j < 4; ++j) As[(tid >> 3) * 33 + (tid & 7) * 4 + j] = (float)v[j]; }
            { const h16* p = Bt + (size_t)(un * 256 + (tid >> 1)) * K + k0 + (tid & 1) * 16; const h16x8 v0 = *(const h16x8*)p, v1 = *(const h16x8*)(p + 8);
#pragma unroll
              for (int j = 0; j < 8; ++j) { Bs[(tid >> 1) * 33 + (tid & 1) * 16 + j] = (float)v0[j]; Bs[(tid >> 1) * 33 + (tid & 1) * 16 + 8 + j] = (float)v1[j]; } }
            __syncthreads();
#pragma unroll 4
            for (int kk = 0; kk < 32; ++kk) {
                float a[4], b[8];
#pragma unroll
                for (int i = 0; i < 4; ++i) a[i] = As[(ty * 4 + i) * 33 + kk];
#pragma unroll
                for (int j = 0; j < 8; ++j) b[j] = Bs[(tx + 32 * j) * 33 + kk];
#pragma unroll
                for (int i = 0; i < 4; ++i)
#pragma unroll
                    for (int j = 0; j < 8; ++j) acc[i][j] += a[i] * b[j];
            }
            __syncthreads();
        }
#pragma unroll
        for (int i = 0; i < 4; ++i)
#pragma unroll
            for (int j = 0; j < 8; ++j) Ct[(ty * 4 + i) * CT_LD + tx + 32 * j] = acc[i][j];
        __syncthreads();
        E(um, un, Ct);
        __syncthreads();
    }
}

struct EpiRetIn {
    h16 *Q0, *K0, *V0, *G0; const float *RC, *RS;
    __device__ __forceinline__ void operator()(int um, int un, const float* Ct) const {
        const int tid = threadIdx.x;
        if (un < 8) {
            const bool isk = un >= 4; const int h = un & 3; h16* dst = isk ? K0 : Q0; const float sc = isk ? 0.0625f : 1.f;
            for (int idx = tid; idx < 64 * 128; idx += NT) { const int r = idx >> 7, c = idx & 127, m = um * 64 + r, t = m & (T - 1);
                const float x1 = Ct[r * CT_LD + c], x2 = Ct[r * CT_LD + c + 128], cs = RC[t * 128 + c], sn = RS[t * 128 + c];
                dst[(size_t)m * 1024 + h * 256 + c] = (h16)((x1 * cs - x2 * sn) * sc); dst[(size_t)m * 1024 + h * 256 + c + 128] = (h16)((x1 * sn + x2 * cs) * sc); }
        } else {
            h16* dst = (un < 16) ? V0 : G0; const int cb = ((un - 8) & 7) * 256;
            for (int idx = tid; idx < 64 * 256; idx += NT) { const int r = idx >> 8, c = idx & 255, m = um * 64 + r; dst[(size_t)m * 2048 + cb + c] = (h16)Ct[r * CT_LD + c]; }
        }
    }
};
struct EpiF32 { float* O; int ldc;
    __device__ __forceinline__ void operator()(int um, int un, const float* Ct) const {
        for (int idx = threadIdx.x; idx < 64 * 256; idx += NT) { const int r = idx >> 8, c = idx & 255; O[(size_t)(um * 64 + r) * ldc + un * 256 + c] = Ct[r * CT_LD + c]; } }
};
struct EpiSwiglu { h16* H;
    __device__ __forceinline__ void operator()(int um, int un, const float* Ct) const {
        for (int idx = threadIdx.x; idx < 64 * 128; idx += NT) { const int r = idx >> 7, c = idx & 127; H[(size_t)(um * 64 + r) * DFF + un * 128 + c] = (h16)(silu_f(Ct[r * CT_LD + c]) * Ct[r * CT_LD + c + 128]); } }
};
struct EpiKvq {
    h16* KV6; h16* QN; float* GATES; const float *NC, *NS;
    __device__ __forceinline__ void operator()(int um, int un, const float* Ct) const {
        const int tid = threadIdx.x;
        if (un < 6) {
            h16* dst = KV6 + (size_t)un * (8u * T * 64); const bool rot = (un & 1) == 0;
            for (int idx = tid; idx < 64 * 256; idx += NT) { const int r = idx >> 8, c = idx & 255, m = um * 64 + r, b = m >> 13, t = m & (T - 1), g = c >> 6, d = c & 63;
                float v = Ct[r * CT_LD + c];
                if (rot && d < 16) { const int i = d & 7; const float cs = NC[t * 8 + i], sn = NS[t * 8 + i]; const float x1 = Ct[r * CT_LD + (c & ~15) + i], x2 = Ct[r * CT_LD + (c & ~15) + i + 8]; v = (d < 8) ? (x1 * cs - x2 * sn) : (x1 * sn + x2 * cs); }
                dst[((size_t)(b * 4 + g) * T + t) * 64 + d] = (h16)v; }
        } else if (un < 10) {
            for (int idx = tid; idx < 64 * 256; idx += NT) { const int r = idx >> 8, c = idx & 255, m = um * 64 + r, t = m & (T - 1), d = c & 63;
                float v = Ct[r * CT_LD + c];
                if (d < 16) { const int i = d & 7; const float cs = NC[t * 8 + i], sn = NS[t * 8 + i]; const float x1 = Ct[r * CT_LD + (c & ~15) + i], x2 = Ct[r * CT_LD + (c & ~15) + i + 8]; v = (d < 8) ? (x1 * cs - x2 * sn) : (x1 * sn + x2 * cs); }
                QN[(size_t)m * 1024 + (un - 6) * 256 + c] = (h16)(v * 0.125f); }
        } else {
            for (int idx = tid; idx < 64 * 48; idx += NT) { const int r = idx / 48, c = idx % 48; GATES[(size_t)(um * 64 + r) * 48 + c] = sigmoid_f(Ct[r * CT_LD + c]); }
        }
    }
};
struct EpiCmp { h16* HC; const float* bias;
    __device__ __forceinline__ void operator()(int um, int un, const float* Ct) const {
        for (int idx = threadIdx.x; idx < 64 * 256; idx += NT) { const int r = idx >> 8, c = idx & 255; HC[(size_t)(um * 64 + r) * 256 + c] = (h16)gelu_tanh_f(Ct[r * CT_LD + c] + bias[c]); } }
};

__device__ __forceinline__ void n_ret_state(const h16* K0, const h16* V0, h16* SS) {
    const int tid = threadIdx.x, d = tid & 255, half = tid >> 8;
    for (int it = blockIdx.x; it < 8 * 128; it += gridDim.x) {
        const int bh = it >> 7, vq = it & 127, b = bh >> 2, h = bh & 3, c0 = vq * 4 + half * 2;
        const float gam = 1.f - exp2f(-5.f - (float)h);
        const h16* kp = K0 + (size_t)(b * T) * 1024 + h * 256 + d; const h16* vp = V0 + (size_t)(b * T) * 2048 + h * 512 + c0;
        float s0 = 0.f, s1 = 0.f;
        for (int jb = 0; jb < (NSUP - 1) * SUP; jb += 8) {
            float kv[8], v0[8], v1[8];
#pragma unroll
            for (int e = 0; e < 8; ++e) { kv[e] = (float)kp[(size_t)(jb + e) * 1024]; v0[e] = (float)vp[(size_t)(jb + e) * 2048]; v1[e] = (float)vp[(size_t)(jb + e) * 2048 + 1]; }
#pragma unroll
            for (int e = 0; e < 8; ++e) { s0 = gam * s0 + kv[e] * v0[e]; s1 = gam * s1 + kv[e] * v1[e]; }
            if (((jb + 8) & (SUP - 1)) == 0) { const int ms = (jb + 8) / SUP - 1; h16* sp = SS + (((size_t)bh * (NSUP - 1) + ms) * 512 + c0) * 256 + d; sp[0] = (h16)s0; sp[256] = (h16)s1; }
        }
    }
}
__device__ __forceinline__ void n_ret_out(const h16* Q0, const h16* K0, const h16* V0, const h16* G0, const h16* SS, const float* gn, h16* Y, float* lds) {
    const int tid = threadIdx.x, lane = tid & 63, wave = tid >> 6;
    float* qs = lds + wave * 768; float* sc = qs + 256;
    const int gw = blockIdx.x * 8 + wave, NGW = gridDim.x * 8;
    for (int it = gw; it < M * 4; it += NGW) {
        const int m = ((it >> 5) << 3) | (it & 7), h = (it >> 3) & 3, b = m >> 13, t = m & (T - 1), tl = t & (SUP - 1), s0 = t - tl, ms = t / SUP, bh = b * 4 + h;
        const float lgh = ret_lg(h);
        for (int i = lane; i < 256; i += 64) qs[i] = (float)Q0[(size_t)m * 1024 + h * 256 + i];
        LDS_FENCE();
        for (int jj = lane; jj <= tl; jj += 64) {
            const h16* kr = K0 + (size_t)(b * T + s0 + jj) * 1024 + h * 256; float dot = 0.f;
#pragma unroll 2
            for (int d = 0; d < 256; d += 8) { const h16x8 kv = *(const h16x8*)(kr + d);
#pragma unroll
                for (int e = 0; e < 8; ++e) dot += (float)kv[e] * qs[d + e]; }
            sc[jj] = dot * __expf(lgh * (float)(tl - jj));
        }
        LDS_FENCE();
        float o[8];
#pragma unroll
        for (int e = 0; e < 8; ++e) o[e] = 0.f;
        const h16* vb = V0 + (size_t)(b * T + s0) * 2048 + h * 512 + lane * 8;
        for (int jj = 0; jj <= tl; ++jj) { const float s = sc[jj]; const h16x8 vv = *(const h16x8*)(vb + (size_t)jj * 2048);
#pragma unroll
            for (int e = 0; e < 8; ++e) o[e] += s * (float)vv[e]; }
        if (ms > 0) {
            const h16* sp = SS + (((size_t)bh * (NSUP - 1) + ms - 1) * 512 + lane * 8) * 256; const float qd = __expf(lgh * (float)(tl + 1));
            float cr[8];
#pragma unroll
            for (int e = 0; e < 8; ++e) cr[e] = 0.f;
#pragma unroll 1
            for (int d = 0; d < 256; d += 8) {
#pragma unroll
                for (int e = 0; e < 8; ++e) { const h16x8 sv = *(const h16x8*)(sp + e * 256 + d);
#pragma unroll
                    for (int f = 0; f < 8; ++f) cr[e] += (float)sv[f] * qs[d + f]; } }
#pragma unroll
            for (int e = 0; e < 8; ++e) o[e] += qd * cr[e];
        }
        float s1 = 0.f;
#pragma unroll
        for (int e = 0; e < 8; ++e) s1 += o[e];
        const float mu = wave_sum(s1) * (1.f / DV); float s2 = 0.f;
#pragma unroll
        for (int e = 0; e < 8; ++e) { o[e] -= mu; s2 += o[e] * o[e]; }
        const float rstd = rsqrtf(wave_sum(s2) * (1.f / DV) + EPS);
        const h16x8 gv = *(const h16x8*)(G0 + (size_t)m * 2048 + h * 512 + lane * 8); h16x8 yo;
#pragma unroll
        for (int e = 0; e < 8; ++e) yo[e] = (h16)(silu_f((float)gv[e]) * o[e] * rstd * gn[h * 512 + lane * 8 + e]);
        *(h16x8*)(Y + (size_t)m * 2048 + h * 512 + lane * 8) = yo;
        LDS_FENCE();
    }
}

__device__ __forceinline__ void dots4(const h16* krow, const float* qs, float (&dt)[4]) {
#pragma unroll
    for (int r = 0; r < 4; ++r) dt[r] = 0.f;
#pragma unroll
    for (int c = 0; c < 8; ++c) { const h16x8 kv = *(const h16x8*)(krow + 8 * c);
#pragma unroll
        for (int r = 0; r < 4; ++r)
#pragma unroll
            for (int e = 0; e < 8; ++e) dt[r] += (float)kv[e] * qs[r * 64 + 8 * c + e]; }
}
__device__ __forceinline__ void softmax4(float* sc, int n, int lane) {
    for (int r = 0; r < 4; ++r) {
        float mx = -INFINITY; for (int i = lane; i < n; i += 64) mx = fmaxf(mx, sc[r * 1024 + i]);
        mx = wave_max(mx); float sum = 0.f;
        for (int i = lane; i < n; i += 64) { const float e = __expf(sc[r * 1024 + i] - mx); sc[r * 1024 + i] = e; sum += e; }
        sum = wave_sum(sum); const float inv = 1.f / sum;
        for (int i = lane; i < n; i += 64) sc[r * 1024 + i] *= inv;
    }
    LDS_FENCE();
}
__device__ __forceinline__ int select_blocks(float imp0, float imp1, int cur, int* sel, int lane) {
    int nsel = 0;
    if (lane == 0) { sel[0] = 0; }
    nsel = 1;
    if (cur >= 1) { if (lane == 0) sel[nsel] = cur; ++nsel; }
    if (cur >= 2) { if (lane == 0) sel[nsel] = cur - 1; ++nsel; }
    const int sA = lane, sB = lane + 64;
    float v0 = (sA <= cur && sA != 0 && sA != cur && sA != cur - 1) ? imp0 : -INFINITY;
    float v1 = (sB <= cur && sB != 0 && sB != cur && sB != cur - 1) ? imp1 : -INFINITY;
    while (nsel < 16) {
        const float mx = wave_max(fmaxf(v0, v1));
        if (mx == -INFINITY) break;
        const unsigned long long b0 = __ballot(v0 == mx);
        int s;
        if (b0) { const int l = __ffsll((long long)b0) - 1; s = l; if (lane == l) v0 = -INFINITY; }
        else { const unsigned long long b1 = __ballot(v1 == mx); const int l = __ffsll((long long)b1) - 1; s = l + 64; if (lane == l) v1 = -INFINITY; }
        if (lane == 0) sel[nsel] = s;
        ++nsel;
    }
    LDS_FENCE();
    return nsel;
}
__device__ __forceinline__ void n_nsa_attn(const h16* QN, const h16* KV6, const h16* CK, const h16* CV, const float* GATES, h16* O1, float* lds) {
    const int tid = threadIdx.x, lane = tid & 63, wave = tid >> 6;
    float* qs = lds + wave * 4480; float* sc = qs + 256; int* sel = (int*)(sc + 4096);
    const h16 *KS = KV6 + 2 * (size_t)(8 * T * 64), *VS = KV6 + 3 * (size_t)(8 * T * 64), *KW = KV6 + 4 * (size_t)(8 * T * 64), *VW = KV6 + 5 * (size_t)(8 * T * 64);
    const int gw = blockIdx.x * 8 + wave, NGW = gridDim.x * 8;
    for (int it = gw; it < M * 4; it += NGW) {
        const int m = it >> 2, g = it & 3, b = m >> 13, t = m & (T - 1), bg = b * 4 + g;
        for (int i = lane; i < 256; i += 64) qs[i] = (float)QN[(size_t)m * 1024 + g * 256 + i];
        LDS_FENCE();
        const int nv = (t >= 31) ? ((t - 31) >> 4) + 1 : 0;
        float oc[4] = {0.f, 0.f, 0.f, 0.f};
        if (nv > 0) {
            for (int n = lane; n < nv; n += 64) { float dt[4]; dots4(CK + ((size_t)bg * NCP + n) * 64, qs, dt);
#pragma unroll
                for (int r = 0; r < 4; ++r) sc[r * 1024 + n] = dt[r]; }
            LDS_FENCE();
            softmax4(sc, nv, lane);
            for (int n = 0; n < nv; ++n) { const float vv = (float)CV[((size_t)bg * NCP + n) * 64 + lane];
#pragma unroll
                for (int r = 0; r < 4; ++r) oc[r] += sc[r * 1024 + n] * vv; }
        }
        float imp[2];
#pragma unroll
        for (int q = 0; q < 2; ++q) { const int s = lane + 64 * q; float a = 0.f;
#pragma unroll
            for (int e = -1; e < 4; ++e) { const int n = 4 * s + e; if (n >= 0 && n < nv) { const float p = sc[n] + sc[1024 + n] + sc[2048 + n] + sc[3072 + n]; a += (e == -1 || e == 3) ? p : 2.f * p; } }
            imp[q] = a; }
        LDS_FENCE();
        const int cur = t >> 6;
        const int nsel = select_blocks(imp[0], imp[1], cur, sel, lane);
        float os[4] = {0.f, 0.f, 0.f, 0.f};
        for (int i2 = 0; i2 < nsel; ++i2) { const int tok = sel[i2] * 64 + lane; float dt[4]; dots4(KS + ((size_t)bg * T + tok) * 64, qs, dt);
#pragma unroll
            for (int r = 0; r < 4; ++r) sc[r * 1024 + i2 * 64 + lane] = (tok <= t) ? dt[r] : -INFINITY; }
        LDS_FENCE();
        softmax4(sc, nsel * 64, lane);
        for (int kk = 0; kk < nsel * 64; ++kk) { const int tok = sel[kk >> 6] * 64 + (kk & 63); const float vv = (float)VS[((size_t)bg * T + tok) * 64 + lane];
#pragma unroll
            for (int r = 0; r < 4; ++r) os[r] += sc[r * 1024 + kk] * vv; }
        LDS_FENCE();
        float ow[4] = {0.f, 0.f, 0.f, 0.f};
        const int nw = (t + 1 < 512) ? t + 1 : 512, t0 = t - nw + 1;
        for (int i = lane; i < nw; i += 64) { float dt[4]; dots4(KW + ((size_t)bg * T + t0 + i) * 64, qs, dt);
#pragma unroll
            for (int r = 0; r < 4; ++r) sc[r * 1024 + i] = dt[r]; }
        LDS_FENCE();
        softmax4(sc, nw, lane);
        for (int i = 0; i < nw; ++i) { const float vv = (float)VW[((size_t)bg * T + t0 + i) * 64 + lane];
#pragma unroll
            for (int r = 0; r < 4; ++r) ow[r] += sc[r * 1024 + i] * vv; }
        LDS_FENCE();
#pragma unroll
        for (int r = 0; r < 4; ++r) { const float* gp = GATES + (size_t)m * 48 + (g * 4 + r) * 3;
            O1[(size_t)m * 1024 + (g * 4 + r) * 64 + lane] = (h16)(gp[0] * oc[r] + gp[1] * os[r] + gp[2] * ow[r]); }
    }
}

#define LAS __attribute__((address_space(3)))
#define XB_TMO      128
#define XB_XCNT(j)  (256  + 64 * (j))
#define XB_XSUB(j)  (1280 + 64 * (j))
#define XB_XGEN(j)  (2304 + 64 * (j))
#define XB_TOP      3328
#define XB_TOPGEN   3392
#define XCD_BAR_WORDS 3456
#define XB_SPIN_CAP (1u << 18)
__device__ __forceinline__ unsigned xb_ld(unsigned* p)              { return __hip_atomic_load(p, __ATOMIC_RELAXED, __HIP_MEMORY_SCOPE_AGENT); }
__device__ __forceinline__ unsigned xb_add(unsigned* p, unsigned v) { return __hip_atomic_fetch_add(p, v, __ATOMIC_RELAXED, __HIP_MEMORY_SCOPE_AGENT); }
__device__ __forceinline__ unsigned xb_xcc_id() { return (unsigned)__builtin_amdgcn_s_getreg((3 << 11) | 20) & 0xFu; }
#define XB_SPIN(cond, bar) do { unsigned _sp = 0; while (cond) { __builtin_amdgcn_s_sleep(1); \
    if ((++_sp & 255u) == 0u) { if (xb_ld(&(bar)[XB_TMO])) break; if (_sp > XB_SPIN_CAP) { atomicAdd(&(bar)[XB_TMO], 1u); break; } } } } while (0)
struct XcdBarrier { unsigned* bar; unsigned x; volatile LAS unsigned* st; };
__device__ __forceinline__ XcdBarrier xcd_barrier_post(unsigned* bar, volatile LAS unsigned* st) {
    XcdBarrier b; b.bar = bar; b.x = xb_xcc_id(); b.st = st;
    if (threadIdx.x == 0) (void)xb_add(&bar[XB_XCNT(b.x)], 1u);
    return b;
}
__device__ __forceinline__ void xcd_barrier_complete(unsigned* bar, unsigned x, unsigned& nloc, unsigned& nx) {
    const unsigned G = gridDim.x * gridDim.y * gridDim.z;
    unsigned sum, cnt, mine, sp = 0u;
    for (;;) {
        sum = 0u; cnt = 0u; mine = 0u;
#pragma unroll
        for (unsigned j = 0; j < 16; ++j) { const unsigned c = xb_ld(&bar[XB_XCNT(j)]); sum += c; cnt += (c > 0u) ? 1u : 0u; mine = (j == x) ? c : mine; }
        if (sum == G) break;
        __builtin_amdgcn_s_sleep(1);
        if ((++sp & 255u) == 0u) { if (xb_ld(&bar[XB_TMO])) break; if (sp > XB_SPIN_CAP) { atomicAdd(&bar[XB_TMO], 1u); break; } }
    }
    nloc = mine > 0u ? mine : 1u; nx = cnt > 0u ? cnt : 1u;
}
__device__ __forceinline__ void xcd_barrier(const XcdBarrier& b) {
    asm volatile("s_waitcnt vmcnt(0)" ::: "memory");
    __syncthreads();
    if (threadIdx.x == 0) {
        unsigned* bar = b.bar;
        __builtin_amdgcn_s_waitcnt(0);
        unsigned nloc = b.st[0], nx = b.st[1];
        if (nloc == 0u) { xcd_barrier_complete(bar, b.x, nloc, nx); b.st[0] = nloc; b.st[1] = nx; }
        const unsigned old = xb_add(&bar[XB_XSUB(b.x)], 1u);
        const unsigned gen = old / nloc;
        if (old + 1u == (gen + 1u) * nloc) {
            __builtin_amdgcn_fence(__ATOMIC_RELEASE, "agent");
            asm volatile("s_waitcnt vmcnt(0)" ::: "memory");
            const unsigned og = xb_add(&bar[XB_TOP], 1u);
            const unsigned tg = og / nx;
            if (og + 1u == (tg + 1u) * nx) xb_add(&bar[XB_TOPGEN], 1u);
            else XB_SPIN(xb_ld(&bar[XB_TOPGEN]) == tg, bar);
            __builtin_amdgcn_fence(__ATOMIC_ACQUIRE, "agent");
            xb_add(&bar[XB_XGEN(b.x)], 1u);
            asm volatile("s_waitcnt vmcnt(0)" ::: "memory");
        } else {
            XB_SPIN(xb_ld(&bar[XB_XGEN(b.x)]) == gen, bar);
            __builtin_amdgcn_fence(__ATOMIC_ACQUIRE, "agent");
            asm volatile("s_waitcnt vmcnt(0)" ::: "memory");
        }
    }
    __syncthreads();
}

namespace pg8 {
typedef float f32x4 __attribute__((ext_vector_type(4)));
typedef unsigned u32x4 __attribute__((ext_vector_type(4)));
constexpr int BM = 256, BK = 64, HALF = 128, HTB = HALF * BK * 2, STAGE_BYTES = 8 * HTB, NXCD = 8, WGM = 8;
__host__ __device__ __forceinline__ int lds_byte(int r, int c) { const int st = (r >> 4) * 2 + (c >> 5), rr = r & 15, cc = c & 31, ob = rr * 64 + cc * 2; return st * 1024 + (ob ^ (((ob >> 9) & 1) << 5)); }
__host__ __device__ __forceinline__ void stage_rc(int b, int& R, int& C) { const int st = b / 1024, sb = b % 1024, swz = sb ^ (((sb >> 9) & 1) << 5); R = (st >> 1) * 16 + swz / 64; C = (st & 1) * 32 + (swz % 64) / 2; }
__host__ __device__ __forceinline__ int perm32(int rho) { const int n = rho >> 4, i = rho & 15; return 8 * (i >> 2) + 4 * n + (i & 3); }
struct Unit { int pm, pn; };
struct Gemm { const h16* A; const h16* Bt; int M, N, K, lda; };
struct StaticOrder {
    int nM, nN, nwg, G, c;
    __host__ __device__ void init(int M, int N, int G_, int c_) { nM = M / BM; nN = N / BM; nwg = nM * nN; G = G_; c = c_; }
    __host__ __device__ bool next(int i, Unit& u) const {
        const long L = (long)i * G + c; if (L >= nwg) return false;
        int wgid = (int)L; { const int q = nwg / NXCD, r = nwg % NXCD, xcd = wgid % NXCD, off = wgid / NXCD; wgid = (xcd < r ? xcd * (q + 1) : r * (q + 1) + (xcd - r) * q) + off; }
        const int nig = WGM * nN, gid = wgid / nig, fm = gid * WGM, gsz = (nM - fm) < WGM ? (nM - fm) : WGM;
        u.pm = fm + ((wgid % nig) % gsz); u.pn = (wgid % nig) / gsz; return true;
    }
};
template <class Epi, class Sched, bool ALIGN_EPI, bool SP2>
__device__ __forceinline__ void gemm_phase(LAS unsigned char* lds, const Gemm g, const Sched& S, const Epi& E) {
    const int tid = threadIdx.x, wid = __builtin_amdgcn_readfirstlane(tid >> 6), lane = tid & 63, wr = wid >> 2, wc = wid & 3, fr = lane & 15, fq = lane >> 4;
    const int K = g.K, nt = K / BK, lda = g.lda;
    unsigned voffA[2], voffB[2];
#pragma unroll
    for (int i = 0; i < 2; ++i) { int R, C; stage_rc(tid * 16 + i * 8192, R, C); const int Rb = Epi::PERM ? ((R & ~31) + perm32(R & 31)) : R;
        voffA[i] = (unsigned)(R * lda + C) * 2u; voffB[i] = (unsigned)(Rb * K + C) * 2u; }
    const size_t kstep = (size_t)(BK * 2);
    const size_t hstepA = (size_t)HALF * lda * 2, hstepB = (size_t)HALF * K * 2;
    const size_t tstepA = 2 * hstepA, tstepB = 2 * hstepB;
    const unsigned ldsw = (unsigned)wid * 1024u;
    const int aoff = lds_byte(wr * 64 + fr, fq * 8), boff = lds_byte(wc * 32 + fr, fq * 8);
#define PG8_SA(b, h) (((b) * 2 + (h)) * HTB)
#define PG8_SB(b, h) ((4 + (b) * 2 + (h)) * HTB)
#define PG8_STAGE(bufoff, gbase, voff) do { _Pragma("unroll") for (int _i = 0; _i < 2; ++_i) \
        __builtin_amdgcn_global_load_lds((const unsigned*)((const char*)(gbase) + (voff)[_i]), (LAS unsigned*)(lds + (bufoff) + ldsw + _i * 8192), 16, 0, 0); } while (0)
#define PG8_LDA(dst, b, h) do { _Pragma("unroll") for (int m = 0; m < 4; ++m) _Pragma("unroll") for (int k = 0; k < 2; ++k) dst[m][k] = *(const LAS h16x8*)(lds + PG8_SA(b, h) + aoff + m * 2048 + k * 1024); } while (0)
#define PG8_LDB(dst, b, h) do { _Pragma("unroll") for (int n = 0; n < 2; ++n) _Pragma("unroll") for (int k = 0; k < 2; ++k) dst[n][k] = *(const LAS h16x8*)(lds + PG8_SB(b, h) + boff + n * 2048 + k * 1024); } while (0)
#define PG8_MMA(ai, bj, At, Bt) do { __builtin_amdgcn_s_setprio(1); _Pragma("unroll") for (int m = 0; m < 4; ++m) _Pragma("unroll") for (int n = 0; n < 2; ++n) _Pragma("unroll") for (int k = 0; k < 2; ++k) \
        acc[ai][bj][m][n] = __builtin_amdgcn_mfma_f32_16x16x32_f16(Bt[n][k], At[m][k], acc[ai][bj][m][n], 0, 0, 0); __builtin_amdgcn_s_setprio(0); } while (0)
#define PG8_WAIT_V(n) asm volatile("s_waitcnt vmcnt(" #n ")" ::: "memory")
#define PG8_WAIT_L(n) asm volatile("s_waitcnt lgkmcnt(" #n ")" ::: "memory")
#define PG8_BAR __builtin_amdgcn_s_barrier()
#define PG8_SCHED __builtin_amdgcn_sched_barrier(0)
    Unit cur, nxt; int ui = 0;
    if (!S.next(0, cur)) return;
    f32x4 acc[2][2][4][2];
#pragma unroll
    for (int a = 0; a < 2; ++a)
#pragma unroll
        for (int b = 0; b < 2; ++b)
#pragma unroll
            for (int m = 0; m < 4; ++m)
#pragma unroll
                for (int n = 0; n < 2; ++n) acc[a][b][m][n] = (f32x4){0.f, 0.f, 0.f, 0.f};
    h16x8 At[4][2], B0[2][2], B1[2][2];
    const char* cA = (const char*)g.A + (size_t)cur.pm * tstepA; const char* cB = (const char*)g.Bt + (size_t)cur.pn * tstepB;
    if constexpr (SP2) {
        PG8_STAGE(PG8_SB(0, 0), cB, voffB); PG8_STAGE(PG8_SB(0, 1), cB + hstepB, voffB); PG8_STAGE(PG8_SA(0, 0), cA, voffA); PG8_STAGE(PG8_SA(0, 1), cA + hstepA, voffA);
        if (wr == 1) PG8_BAR;
        PG8_WAIT_V(2); PG8_BAR;
        PG8_STAGE(PG8_SB(1, 0), cB + kstep, voffB); PG8_STAGE(PG8_SA(1, 0), cA + kstep, voffA); PG8_STAGE(PG8_SB(1, 1), cB + hstepB + kstep, voffB);
        PG8_WAIT_V(6); PG8_BAR;
    } else {
        PG8_STAGE(PG8_SB(0, 0), cB, voffB); PG8_STAGE(PG8_SA(0, 0), cA, voffA); PG8_STAGE(PG8_SB(0, 1), cB + hstepB, voffB); PG8_STAGE(PG8_SA(0, 1), cA + hstepA, voffA);
        if (wr == 1) PG8_BAR;
        PG8_WAIT_V(4); PG8_BAR;
        PG8_STAGE(PG8_SB(1, 0), cB + kstep, voffB); PG8_STAGE(PG8_SA(1, 0), cA + kstep, voffA); PG8_STAGE(PG8_SB(1, 1), cB + hstepB + kstep, voffB);
        PG8_WAIT_V(6); PG8_BAR;
    }
    for (;;) {
        const bool has_next = S.next(ui + 1, nxt);
        const char* nA = has_next ? (const char*)g.A + (size_t)nxt.pm * tstepA : cA; const char* nB = has_next ? (const char*)g.Bt + (size_t)nxt.pn * tstepB : cB;
        for (int t = 0; t < nt; t += 2) {
            const bool last = (t == nt - 2);
            const char* a1 = cA + (size_t)(t + 1) * kstep;
            const char* a2 = last ? nA : cA + (size_t)(t + 2) * kstep; const char* b2 = last ? nB : cB + (size_t)(t + 2) * kstep;
            const char* a3 = a2 + kstep; const char* b3 = b2 + kstep;
            if constexpr (SP2) {
            PG8_LDB(B0, 0, 0); PG8_LDB(B1, 0, 1); PG8_SCHED; PG8_LDA(At, 0, 0); PG8_STAGE(PG8_SA(1, 1), a1 + hstepA, voffA);
            PG8_WAIT_V(8); PG8_WAIT_L(0); PG8_BAR; PG8_MMA(0, 0, At, B0); PG8_MMA(0, 1, At, B1); PG8_BAR; PG8_SCHED;
            PG8_LDA(At, 0, 1); PG8_STAGE(PG8_SB(0, 0), b2, voffB); PG8_STAGE(PG8_SB(0, 1), b2 + hstepB, voffB); PG8_STAGE(PG8_SA(0, 0), a2, voffA);
            PG8_WAIT_V(8); PG8_WAIT_L(0); PG8_BAR; PG8_MMA(1, 0, At, B0); PG8_MMA(1, 1, At, B1); PG8_BAR; PG8_SCHED;
            PG8_LDB(B0, 1, 0); PG8_LDB(B1, 1, 1); PG8_SCHED; PG8_LDA(At, 1, 0); PG8_STAGE(PG8_SA(0, 1), a2 + hstepA, voffA);
            PG8_WAIT_V(8); PG8_WAIT_L(0); PG8_BAR; PG8_MMA(0, 0, At, B0); PG8_MMA(0, 1, At, B1); PG8_BAR; PG8_SCHED;
            PG8_LDA(At, 1, 1); PG8_STAGE(PG8_SB(1, 0), b3, voffB); PG8_STAGE(PG8_SB(1, 1), b3 + hstepB, voffB); PG8_STAGE(PG8_SA(1, 0), a3, voffA);
            PG8_WAIT_V(8); PG8_WAIT_L(0); PG8_BAR; PG8_MMA(1, 0, At, B0); PG8_MMA(1, 1, At, B1); PG8_BAR; PG8_SCHED;
            } else {
            PG8_LDB(B0, 0, 0); PG8_SCHED; PG8_LDA(At, 0, 0); PG8_STAGE(PG8_SA(1, 1), a1 + hstepA, voffA);
            PG8_WAIT_L(8); PG8_BAR; PG8_WAIT_L(0); PG8_MMA(0, 0, At, B0); PG8_BAR; PG8_SCHED;
            PG8_LDB(B1, 0, 1); PG8_STAGE(PG8_SB(0, 0), b2, voffB);
            PG8_BAR; PG8_WAIT_L(0); PG8_MMA(0, 1, At, B1); PG8_BAR;
            PG8_LDA(At, 0, 1); PG8_STAGE(PG8_SA(0, 0), a2, voffA);
            PG8_BAR; PG8_WAIT_L(0); PG8_MMA(1, 0, At, B0); PG8_BAR; PG8_SCHED;
            PG8_STAGE(PG8_SB(0, 1), b2 + hstepB, voffB);
            PG8_WAIT_V(6); PG8_BAR; PG8_MMA(1, 1, At, B1); PG8_BAR;
            PG8_LDB(B0, 1, 0); PG8_SCHED; PG8_LDA(At, 1, 0); PG8_STAGE(PG8_SA(0, 1), a2 + hstepA, voffA);
            PG8_WAIT_L(8); PG8_BAR; PG8_WAIT_L(0); PG8_MMA(0, 0, At, B0); PG8_BAR; PG8_SCHED;
            PG8_LDB(B1, 1, 1); PG8_STAGE(PG8_SB(1, 0), b3, voffB);
            PG8_BAR; PG8_WAIT_L(0); PG8_MMA(0, 1, At, B1); PG8_BAR;
            PG8_LDA(At, 1, 1); PG8_STAGE(PG8_SA(1, 0), a3, voffA);
            PG8_BAR; PG8_WAIT_L(0); PG8_MMA(1, 0, At, B0); PG8_BAR; PG8_SCHED;
            PG8_STAGE(PG8_SB(1, 1), b3 + hstepB, voffB);
            PG8_WAIT_V(6); PG8_BAR; PG8_MMA(1, 1, At, B1); PG8_BAR;
            }
        }
        if constexpr (ALIGN_EPI) { if (wr == 0) PG8_BAR; }
        E(acc, cur, wr, wc, fr, fq);
        if (!has_next) break;
#pragma unroll
        for (int a = 0; a < 2; ++a)
#pragma unroll
            for (int b = 0; b < 2; ++b)
#pragma unroll
                for (int m = 0; m < 4; ++m)
#pragma unroll
                    for (int n = 0; n < 2; ++n) acc[a][b][m][n] = (f32x4){0.f, 0.f, 0.f, 0.f};
        cur = nxt; cA = nA; cB = nB; ++ui;
        if constexpr (ALIGN_EPI) { if (wr == 1) PG8_BAR; }
    }
    PG8_WAIT_V(0);
    if constexpr (!ALIGN_EPI) { if (wr == 0) PG8_BAR; }
    PG8_BAR;
#undef PG8_SA
#undef PG8_SB
#undef PG8_STAGE
#undef PG8_LDA
#undef PG8_LDB
#undef PG8_MMA
#undef PG8_WAIT_V
#undef PG8_WAIT_L
#undef PG8_BAR
#undef PG8_SCHED
}
__device__ __forceinline__ u32x4 pack8(const f32x4& a, const f32x4& b) {
    h16x8 o; o[0] = (h16)a[0]; o[1] = (h16)a[1]; o[2] = (h16)a[2]; o[3] = (h16)a[3]; o[4] = (h16)b[0]; o[5] = (h16)b[1]; o[6] = (h16)b[2]; o[7] = (h16)b[3];
    return __builtin_bit_cast(u32x4, o);
}
typedef f32x4 AccT[2][2][4][2];

struct EpiRetInF {
    static constexpr bool PERM = true;
    h16 *Q0, *K0, *V0, *G0; const float *RC, *RS;
    __device__ __forceinline__ void operator()(const AccT& acc, const Unit& u, int wr, int wc, int fr, int fq) const {
        const int row0 = u.pm * BM + wr * 64 + fr, c0 = wc * 32 + 8 * fq;
        if (u.pn < 8) {
            const bool isk = u.pn >= 4; h16* dst = (isk ? K0 : Q0) + (u.pn & 3) * 256; const float sc = isk ? 0.0625f : 1.f;
#pragma unroll
            for (int ai = 0; ai < 2; ++ai)
#pragma unroll
                for (int m = 0; m < 4; ++m) { const int row = row0 + ai * HALF + m * 16, t = row & (T - 1);
                    const f32x4 cs0 = *(const f32x4*)(RC + t * 128 + c0), cs1 = *(const f32x4*)(RC + t * 128 + c0 + 4), sn0 = *(const f32x4*)(RS + t * 128 + c0), sn1 = *(const f32x4*)(RS + t * 128 + c0 + 4);
                    const f32x4 x10 = acc[ai][0][m][0], x11 = acc[ai][0][m][1], x20 = acc[ai][1][m][0], x21 = acc[ai][1][m][1];
                    const f32x4 a0 = (x10 * cs0 - x20 * sn0) * sc, a1 = (x11 * cs1 - x21 * sn1) * sc, b0 = (x10 * sn0 + x20 * cs0) * sc, b1 = (x11 * sn1 + x21 * cs1) * sc;
                    h16* rp = dst + (size_t)row * 1024 + c0;
                    *(u32x4*)rp = pack8(a0, a1); *(u32x4*)(rp + 128) = pack8(b0, b1); }
        } else {
            h16* dst = ((u.pn < 16) ? V0 : G0) + ((u.pn - 8) & 7) * 256;
#pragma unroll
            for (int ai = 0; ai < 2; ++ai)
#pragma unroll
                for (int m = 0; m < 4; ++m) { h16* rp = dst + (size_t)(row0 + ai * HALF + m * 16) * 2048 + c0;
#pragma unroll
                    for (int bj = 0; bj < 2; ++bj) *(u32x4*)(rp + bj * HALF) = pack8(acc[ai][bj][m][0], acc[ai][bj][m][1]); }
        }
    }
};
struct EpiF32F { static constexpr bool PERM = true; float* O; int ldc;
    __device__ __forceinline__ void operator()(const AccT& acc, const Unit& u, int wr, int wc, int fr, int fq) const {
        const int row0 = u.pm * BM + wr * 64 + fr, c0 = u.pn * BM + wc * 32 + 8 * fq;
#pragma unroll
        for (int ai = 0; ai < 2; ++ai)
#pragma unroll
            for (int m = 0; m < 4; ++m) { float* rp = O + (size_t)(row0 + ai * HALF + m * 16) * ldc + c0;
#pragma unroll
                for (int bj = 0; bj < 2; ++bj) { *(f32x4*)(rp + bj * HALF) = acc[ai][bj][m][0]; *(f32x4*)(rp + bj * HALF + 4) = acc[ai][bj][m][1]; } }
    }
};
struct EpiSwigluF { static constexpr bool PERM = true; h16* H;
    __device__ __forceinline__ void operator()(const AccT& acc, const Unit& u, int wr, int wc, int fr, int fq) const {
        const int row0 = u.pm * BM + wr * 64 + fr, c0 = u.pn * 128 + wc * 32 + 8 * fq;
#pragma unroll
        for (int ai = 0; ai < 2; ++ai)
#pragma unroll
            for (int m = 0; m < 4; ++m) { f32x4 o[2];
#pragma unroll
                for (int n = 0; n < 2; ++n)
#pragma unroll
                    for (int e = 0; e < 4; ++e) o[n][e] = silu_f(acc[ai][0][m][n][e]) * acc[ai][1][m][n][e];
                *(u32x4*)(H + (size_t)(row0 + ai * HALF + m * 16) * DFF + c0) = pack8(o[0], o[1]); }
    }
};
struct EpiKvqF {
    static constexpr bool PERM = true;
    h16* KV6; h16* QN; float* GATES; const float *NC, *NS;
    __device__ __forceinline__ void operator()(const AccT& acc, const Unit& u, int wr, int wc, int fr, int fq) const {
        const int row0 = u.pm * BM + wr * 64 + fr;
        const int pn = u.pn;
        if (pn == 10) {
            if (wc < 2) {
#pragma unroll
                for (int ai = 0; ai < 2; ++ai)
#pragma unroll
                    for (int m = 0; m < 4; ++m) { const int row = row0 + ai * HALF + m * 16; const int c = wc * 32 + 8 * fq;
                        if (c < 48) { f32x4 o0, o1;
#pragma unroll
                            for (int e = 0; e < 4; ++e) { o0[e] = sigmoid_f(acc[ai][0][m][0][e]); o1[e] = sigmoid_f(acc[ai][0][m][1][e]); }
                            *(f32x4*)(GATES + (size_t)row * 48 + c) = o0; *(f32x4*)(GATES + (size_t)row * 48 + c + 4) = o1; } }
            }
            return;
        }
        const bool rot = (pn >= 6) || ((pn & 1) == 0);
        const bool rlane = rot && ((wc & 1) == 0);
        const float sc = (pn >= 6) ? 0.125f : 1.f;
#pragma unroll
        for (int ai = 0; ai < 2; ++ai)
#pragma unroll
            for (int m = 0; m < 4; ++m) { const int row = row0 + ai * HALF + m * 16, t = row & (T - 1), b = row >> 13;
#pragma unroll
                for (int bj = 0; bj < 2; ++bj) { f32x4 v0 = acc[ai][bj][m][0], v1 = acc[ai][bj][m][1];
                    if (rlane) {
                        f32x4 p0, p1;
#pragma unroll
                        for (int e = 0; e < 4; ++e) { p0[e] = __shfl_xor(v0[e], 16); p1[e] = __shfl_xor(v1[e], 16); }
                        if (fq < 2) { const f32x4 cs0 = *(const f32x4*)(NC + t * 8), cs1 = *(const f32x4*)(NC + t * 8 + 4), sn0 = *(const f32x4*)(NS + t * 8), sn1 = *(const f32x4*)(NS + t * 8 + 4);
                            if (fq == 0) { v0 = v0 * cs0 - p0 * sn0; v1 = v1 * cs1 - p1 * sn1; } else { v0 = p0 * sn0 + v0 * cs0; v1 = p1 * sn1 + v1 * cs1; } }
                    }
                    v0 = v0 * sc; v1 = v1 * sc;
                    const int c = bj * HALF + wc * 32 + 8 * fq;
                    if (pn < 6) { const int g = c >> 6, d = c & 63; *(u32x4*)(KV6 + (size_t)pn * (8u * T * 64) + ((size_t)(b * 4 + g) * T + t) * 64 + d) = pack8(v0, v1); }
                    else *(u32x4*)(QN + (size_t)row * 1024 + (pn - 6) * 256 + c) = pack8(v0, v1); } }
    }
};
struct EpiCmpF { static constexpr bool PERM = true; h16* HC; const float* bias;
    __device__ __forceinline__ void operator()(const AccT& acc, const Unit& u, int wr, int wc, int fr, int fq) const {
        const int row0 = u.pm * BM + wr * 64 + fr;
#pragma unroll
        for (int bj = 0; bj < 2; ++bj) { const int c = bj * HALF + wc * 32 + 8 * fq; const f32x4 b0 = *(const f32x4*)(bias + c), b1 = *(const f32x4*)(bias + c + 4);
#pragma unroll
            for (int ai = 0; ai < 2; ++ai)
#pragma unroll
                for (int m = 0; m < 4; ++m) { f32x4 o0, o1;
#pragma unroll
                    for (int e = 0; e < 4; ++e) { o0[e] = gelu_tanh_f(acc[ai][bj][m][0][e] + b0[e]); o1[e] = gelu_tanh_f(acc[ai][bj][m][1][e] + b1[e]); }
                    *(u32x4*)(HC + (size_t)(row0 + ai * HALF + m * 16) * 256 + c) = pack8(o0, o1); } }
    }
};
}

constexpr int MISC_OFF = LDS_BYTES - 64;
constexpr int CW_BAR = 4096;
constexpr size_t CTL_ZERO_BYTES = 64 * 1024;

template <int PH> __global__ void __launch_bounds__(NT, 2) mk(Args args) {
    extern __shared__ __attribute__((aligned(16))) unsigned char lds_raw[];
    float* lds = (float*)lds_raw;
    const int tid = threadIdx.x, lane = tid & 63, wave = tid >> 6;
    const int gw = blockIdx.x * 8 + wave, NGW = gridDim.x * 8, gt = blockIdx.x * NT + tid, NGT = gridDim.x * NT;
    unsigned char* ws = args.ws;
    const float* x = args.in[0]; const float* norms = args.in[1];
    float* RC = (float*)(ws + WS_RC); float* RS = (float*)(ws + WS_RS); float* NC = (float*)(ws + WS_NC); float* NS = (float*)(ws + WS_NS);
    float* BIASK = (float*)(ws + WS_BIASK); float* BIASV = (float*)(ws + WS_BIASV);
    h16* XN = (h16*)(ws + WS_XN); float* MB = (float*)(ws + WS_MB); h16* HID = (h16*)(ws + WS_HID);
    h16* WFI = (h16*)(ws + WS_WFI); h16* WFO = (h16*)(ws + WS_WFO);
    h16* Q0 = (h16*)(ws + WS_Q0); h16* K0 = (h16*)(ws + WS_K0); h16* V0 = (h16*)(ws + WS_V0); h16* G0 = (h16*)args.out; h16* SS = (h16*)(ws + WS_SS); h16* Y = (h16*)(ws + WS_Y);
    h16* KV6 = (h16*)(ws + WS_KC); h16* QN = (h16*)(ws + WS_QN); float* GATES = (float*)(ws + WS_GATES); h16* HC = (h16*)(ws + WS_HC); h16* CK = (h16*)(ws + WS_CK); h16* CV = (h16*)(ws + WS_CV); h16* O1 = (h16*)(ws + WS_O1);
    float* XR = args.out;
    float* scr = lds + wave * (64 * 33);
    const int lo = args.ph_lo, hi = args.ph_hi;
    XcdBarrier bar; bar.bar = nullptr; bar.x = 0; bar.st = nullptr;
    if (PH < 0) {
        volatile LAS unsigned* misc = (volatile LAS unsigned*)((LAS unsigned char*)lds_raw + MISC_OFF);
        if (tid < 2) misc[tid] = 0u;
        __syncthreads();
        bar = xcd_barrier_post((unsigned*)(ws + WS_CTL) + CW_BAR, misc);
    }
#define FGEMM(EpiT, Eobj, Aptr, lda_, Btptr, Mrows, N_, K_, cidx, ALIGN) { const pg8::Gemm g_{Aptr, Btptr, Mrows, N_, K_, lda_}; pg8::StaticOrder S_; S_.init(Mrows, N_, (int)gridDim.x, (int)(cidx)); \
        const EpiT E_ = Eobj; pg8::gemm_phase<EpiT, pg8::StaticOrder, ALIGN, true>((LAS unsigned char*)lds_raw, g_, S_, E_); }
#define SEAM(k) { if (PH < 0 && IN(k) && IN((k) + 1)) xcd_barrier(bar); }
#define IN(k) (PH < 0 ? (lo <= (k) && (k) < hi) : (PH == (k)))

    if (IN(0)) {
        const int NI = 16 * 192 + 32 * 32;
        for (int it = gw; it < NI; it += NGW) { int r = it;
            WT_JOB(r, args.in[2], 1024, 6144, (h16*)(ws + WS_WA), norms + 0 * 1024, 0, 0);
            WT_JOB(r, args.in[4], 2048, 1024, (h16*)(ws + WS_WRO), nullptr, 0, 0); }
        for (int i = gt; i < T * 128; i += NGT) { const int t = i >> 7, j = i & 127; const float fr = (float)(1.0 / pow(10000.0, (double)((float)j / 127.0f))); float c, s; sincos_acc((float)t * fr, c, s); RC[i] = c; RS[i] = s; }
        for (int i = gt; i < T * 8; i += NGT) { const int t = i >> 3, j = i & 7; const float fr = (float)pow(500000.0, -(double)(2 * j) / 16.0); float c, s; sincos_acc((float)t * fr, c, s); NC[i] = c; NS[i] = s; }
        for (int m = gw; m < M; m += NGW) xn_row(x + (size_t)m * D, XN + (size_t)m * D, lane);
    }
    SEAM(0)
    if (IN(1)) FGEMM(pg8::EpiRetInF, (pg8::EpiRetInF{Q0, K0, V0, G0, RC, RS}), XN, 1024, (const h16*)(ws + WS_WA), M, 6144, 1024, blockIdx.x, true)
    SEAM(1)
    if (IN(2)) n_ret_state(K0, V0, SS);
    SEAM(2)
    if (IN(3)) n_ret_out(Q0, K0, V0, G0, SS, args.in[3], Y, lds);
    SEAM(3)
    if (IN(4)) FGEMM(pg8::EpiF32F, (pg8::EpiF32F{MB, 1024}), Y, 2048, (const h16*)(ws + WS_WRO), M, 1024, 2048, blockIdx.x, false)
#define PH_NORM_A(L, xin) {     \
            for (int m = gw; m < M; m += NGW) res_norm_row((xin) + (size_t)m * D, MB + (size_t)m * D, norms + ((L) * 4 + 1) * 1024, XR + (size_t)m * D, XN + (size_t)m * D, lane); \
            const int NI = 16 * 176 + 44 * 32; \
            for (int it = gw; it < NI; it += NGW) { int r = it; \
                WT_JOB(r, args.in[15] + (size_t)(L) * 1024 * 5632, 1024, 5632, WFI, norms + ((L) * 4 + 2) * 1024, 1, 0); \
                WT_JOB(r, args.in[16] + (size_t)(L) * 2816 * 1024, 2816, 1024, WFO, nullptr, 0, 0); } }
#define PH_FFN_IN() FGEMM(pg8::EpiSwigluF, (pg8::EpiSwigluF{HID}), XN, 1024, WFI, M, 5632, 1024, blockIdx.x, true)
#define PH_FFN_OUT() FGEMM(pg8::EpiF32F, (pg8::EpiF32F{MB, 1024}), HID, DFF, WFO, M, 1024, DFF, blockIdx.x, false)
    SEAM(4)
    if (IN(5)) PH_NORM_A(0, x)
    SEAM(5)
    if (IN(6)) PH_FFN_IN()
    SEAM(6)
    if (IN(7)) PH_FFN_OUT()
    SEAM(7)
    if (IN(8)) {
        for (int m = gw; m < M; m += NGW) res_norm_row(XR + (size_t)m * D, MB + (size_t)m * D, norms + 3 * 1024, XR + (size_t)m * D, XN + (size_t)m * D, lane);
        const int NI = 16 * 48 + 16 * 34 + 16 * 32 + 2 * 32 * 8;
        for (int it = gw; it < NI; it += NGW) { int r = it;
            WT_JOB(r, args.in[8], 1024, 1536, (h16*)(ws + WS_WKVQ), args.in[7], 0, 0);
            WT_JOB(r, args.in[5], 1024, 1072, (h16*)(ws + WS_WKVQ), norms + 4 * 1024, 0, 1536);
            WT_JOB(r, args.in[6], 1024, 1024, (h16*)(ws + WS_WNO), nullptr, 0, 0);
            WT_JOB(r, args.in[11], 2048, 256, (h16*)(ws + WS_WC1K), nullptr, 0, 0);
            WT_JOB(r, args.in[13], 2048, 256, (h16*)(ws + WS_WC1V), nullptr, 0, 0); }
        { h16* z = (h16*)(ws + WS_WKVQ) + (size_t)2608 * 1024; for (int i = gt; i < 208 * 1024; i += NGT) z[i] = (h16)0.f; }
        for (int o = gw; o < 512; o += NGW) {
            const int which = o >> 8, c = o & 255; const float* pos = args.in[which ? 10 : 9]; const float* w1 = args.in[which ? 13 : 11]; float a = 0.f;
            for (int k = lane; k < 2048; k += 64) a += pos[k] * w1[(size_t)k * 256 + c];
            a = wave_sum(a); if (lane == 0) (which ? BIASV : BIASK)[c] = a; }
    }
    SEAM(8)
    if (IN(9)) FGEMM(pg8::EpiKvqF, (pg8::EpiKvqF{KV6, QN, GATES, NC, NS}), XN, 1024, (const h16*)(ws + WS_WKVQ), M, 2816, 1024, blockIdx.x, true)
    SEAM(9)
    if (IN(10)) {
        FGEMM(pg8::EpiCmpF, (pg8::EpiCmpF{HC, BIASK}), KV6, 1024, (const h16*)(ws + WS_WC1K), 4096, 256, 2048, blockIdx.x, false)
        FGEMM(pg8::EpiCmpF, (pg8::EpiCmpF{HC + (size_t)4096 * 256, BIASV}), KV6 + (size_t)8 * T * 64, 1024, (const h16*)(ws + WS_WC1V), 4096, 256, 2048, (blockIdx.x + 240) & 255, false)
    }
    SEAM(10)
    if (IN(11)) {
        for (int i = gt; i < 2 * 4096 * 64; i += NGT) { const int which = i >> 18, r = (i >> 6) & 4095, d = i & 63; const float* w2 = args.in[which ? 14 : 12]; const h16* hr = HC + ((size_t)which * 4096 + r) * 256; float a = 0.f;
            for (int c = 0; c < 256; ++c) a += (float)hr[c] * w2[c * 64 + d];
            if ((r & 511) == 511) a = 0.f;
            (which ? CV : CK)[(size_t)r * 64 + d] = (h16)a; }
    }
    SEAM(11)
    if (IN(12)) n_nsa_attn(QN, KV6, CK, CV, GATES, O1, lds);
    SEAM(12)
    if (IN(13)) FGEMM(pg8::EpiF32F, (pg8::EpiF32F{MB, 1024}), O1, 1024, (const h16*)(ws + WS_WNO), M, 1024, 1024, blockIdx.x, false)
    SEAM(13)
    if (IN(14)) PH_NORM_A(1, XR)
    SEAM(14)
    if (IN(15)) PH_FFN_IN()
    SEAM(15)
    if (IN(16)) PH_FFN_OUT()
    SEAM(16)
    if (IN(17)) { for (int m = gw; m < M; m += NGW) res_norm_row(XR + (size_t)m * D, MB + (size_t)m * D, norms + 7 * 1024, XR + (size_t)m * D, nullptr, lane); }
#undef IN
}

extern "C" void kernel_launch(void* const* d_in, const int* in_sizes, int n_in, void* d_out, int out_size, void* d_ws, size_t ws_size, hipStream_t stream) {
    static int grid = 0;
    if (grid == 0) {
        if (n_in != 17 || out_size != M * D || ws_size < WS_END) { fprintf(stderr, "kernel_launch: unexpected problem (n_in %d out %d ws %zu)\n", n_in, out_size, ws_size); grid = -1; return; }
        int dev = 0, cus = 0;
        (void)hipGetDevice(&dev); (void)hipDeviceGetAttribute(&cus, hipDeviceAttributeMultiprocessorCount, dev);
#define SETATTR(p) if (hipFuncSetAttribute((const void*)mk<p>, hipFuncAttributeMaxDynamicSharedMemorySize, LDS_BYTES) != hipSuccess) { fprintf(stderr, "kernel_launch: hipFuncSetAttribute failed\n"); grid = -1; return; }
        SETATTR(-1) SETATTR(0) SETATTR(1) SETATTR(2) SETATTR(3) SETATTR(4) SETATTR(5) SETATTR(6) SETATTR(7) SETATTR(8) SETATTR(9)
        SETATTR(10) SETATTR(11) SETATTR(12) SETATTR(13) SETATTR(14) SETATTR(15) SETATTR(16) SETATTR(17)
        (void)hipGetLastError();
        grid = cus > 0 ? cus : 256;
    }
    if (grid < 0) return;
    Args a{};
    for (int i = 0; i < 17; ++i) a.in[i] = (const float*)d_in[i];
    a.out = (float*)d_out; a.ws = (unsigned char*)d_ws;
#if MK_ONE_LAUNCH
    if (hipMemsetAsync((char*)d_ws + WS_CTL, 0, CTL_ZERO_BYTES, stream) != hipSuccess) { fprintf(stderr, "kernel_launch: memset failed\n"); return; }
    a.ph_lo = 0; a.ph_hi = NPHASE; hipLaunchKernelGGL(mk<-1>, dim3(grid), dim3(NT), LDS_BYTES, stream, a);
    return;
#endif
#define LAUNCH_PH(p) { a.ph_lo = p; a.ph_hi = p + 1; hipLaunchKernelGGL(mk<p>, dim3(grid), dim3(NT), LDS_BYTES, stream, a); }
    LAUNCH_PH(0) LAUNCH_PH(1) LAUNCH_PH(2) LAUNCH_PH(3) LAUNCH_PH(4) LAUNCH_PH(5) LAUNCH_PH(6) LAUNCH_PH(7) LAUNCH_PH(8) LAUNCH_PH(9)
    LAUNCH_PH(10) LAUNCH_PH(11) LAUNCH_PH(12) LAUNCH_PH(13) LAUNCH_PH(14) LAUNCH_PH(15) LAUNCH_PH(16) LAUNCH_PH(17)
}
```

```cpp
#include <hip/hip_runtime.h>
#include <cstdio>
#include <cstdint>

#ifndef MK_ONE_LAUNCH
#define MK_ONE_LAUNCH 1
#endif

typedef _Float16 h16;
typedef _Float16 h16x8 __attribute__((ext_vector_type(8)));
typedef _Float16 h16x4 __attribute__((ext_vector_type(4)));
typedef float f32x4 __attribute__((ext_vector_type(4)));

constexpr int BATCH = 2, T = 8192, D = 1024, M = BATCH * T;
constexpr int RH = 4, DK = 256, DV = 512;
constexpr int NG = 4, HD = 64, NCP = 512;
constexpr int DFF = 2816;
constexpr int SUP = 512, NSUP = T / SUP;
constexpr float EPS = 1e-6f;
constexpr int NPHASE = 18;
constexpr int NT = 512;
constexpr int LDS_BYTES = 147456;

constexpr size_t MiB = 1u << 20;
constexpr size_t WS_CTL = 0;
constexpr size_t WS_RC = 1 * MiB, WS_RS = 5 * MiB;
constexpr size_t WS_NC = 9 * MiB, WS_NS = 9 * MiB + 256 * 1024;
constexpr size_t WS_BIASK = 9 * MiB + 512 * 1024, WS_BIASV = WS_BIASK + 1024;
constexpr size_t WS_WC1K = 10 * MiB, WS_WC1V = 11 * MiB;
constexpr size_t WS_WA = 12 * MiB;
constexpr size_t WS_WKVQ = 12 * MiB, WS_WNO = 18 * MiB;
constexpr size_t WS_WRO = 24 * MiB;
constexpr size_t WS_XN = 28 * MiB;
constexpr size_t WS_SS = 28 * MiB;
constexpr size_t WS_O1 = 28 * MiB;
constexpr size_t WS_Q0 = 60 * MiB, WS_K0 = 92 * MiB, WS_VT = 124 * MiB, WS_KT = 188 * MiB, WS_Y = 188 * MiB;
constexpr size_t WS_MB = 60 * MiB;
constexpr size_t WS_WFI = 124 * MiB, WS_WFO = 135 * MiB;
constexpr size_t WS_HID = 144 * MiB;
constexpr size_t WS_KC = 124 * MiB, WS_VC = 132 * MiB, WS_KS = 140 * MiB, WS_VS = 148 * MiB, WS_KW = 156 * MiB, WS_VW = 164 * MiB;
constexpr size_t WS_QN = 172 * MiB;
constexpr size_t WS_GATES = 204 * MiB;
constexpr size_t WS_HC = 208 * MiB;
constexpr size_t WS_CK = 212 * MiB, WS_CV = 212 * MiB + 512 * 1024;
constexpr size_t WS_END = 252 * MiB;

struct Args { const float* in[17]; float* out; unsigned char* ws; int ph_lo, ph_hi; };

__device__ __forceinline__ float wave_sum(float v) {
#pragma unroll
    for (int o = 1; o < 64; o <<= 1) v += __shfl_xor(v, o);
    return v;
}
__device__ __forceinline__ float wave_max(float v) {
#pragma unroll
    for (int o = 1; o < 64; o <<= 1) v = fmaxf(v, __shfl_xor(v, o));
    return v;
}
#define LDS_FENCE() asm volatile("s_waitcnt lgkmcnt(0)" ::: "memory")

__device__ __forceinline__ void sincos_acc(float ang, float& c, float& s) {
    const double x = (double)ang;
    const double k = __builtin_rint(x * 0.63661977236758134308);
    double y = __builtin_fma(-k, 1.57079632679489655800, x);
    y = __builtin_fma(-k, 6.12323399573676603587e-17, y);
    const double y2 = y * y;
    double sp = -2.5052108385441718775e-08; sp = sp * y2 + 2.7557319223985890653e-06; sp = sp * y2 - 1.9841269841269841270e-04; sp = sp * y2 + 8.3333333333333332177e-03; sp = sp * y2 - 1.6666666666666665741e-01;
    const double sy = y + y * y2 * sp;
    double cp = 2.0876756987868098979e-09; cp = cp * y2 - 2.7557319223985888e-07; cp = cp * y2 + 2.4801587301587301566e-05; cp = cp * y2 - 1.3888888888888889419e-03; cp = cp * y2 + 4.1666666666666664354e-02; cp = cp * y2 - 0.5;
    const double cy = 1.0 + y2 * cp;
    const int q = ((int)k) & 3;
    const double sr = (q == 0) ? sy : (q == 1) ? cy : (q == 2) ? -sy : -cy;
    const double cr = (q == 0) ? cy : (q == 1) ? -sy : (q == 2) ? -cy : sy;
    c = (float)cr; s = (float)sr;
}
__device__ __forceinline__ float silu_f(float x) { return x / (1.f + __expf(-x)); }
__device__ __forceinline__ float sigmoid_f(float x) { return 1.f / (1.f + __expf(-x)); }
__device__ __forceinline__ float gelu_tanh_f(float x) { const float u = 0.7978845608028654f * (x + 0.044715f * x * x * x); return 0.5f * x * (1.f + tanhf(u)); }
__device__ __forceinline__ float ret_lg(int h) { return log1pf(-exp2f(-5.0f - (float)h)); }

__device__ __forceinline__ void wt_item(const float* W, int K, int N, h16* WT, const float* gain, int kind, int rowoff, float* scr, int item, int lane) {
    const int nblk = (N + 31) / 32, kb = item / nblk, nb = item % nblk, k0 = 64 * kb, n0 = 32 * nb;
    const int ncol = n0 + (lane & 31);
#pragma unroll 8
    for (int i = 0; i < 32; ++i) { const int kk = 2 * i + (lane >> 5); float v = 0.f; if (ncol < N) v = W[(size_t)(k0 + kk) * N + ncol]; if (gain) v *= gain[k0 + kk]; scr[kk * 33 + (lane & 31)] = v; }
    LDS_FENCE();
    const int c = lane & 7;
#pragma unroll
    for (int j = 0; j < 4; ++j) {
        const int nl = (lane >> 3) + 8 * j, n = n0 + nl; const float* s = scr + (8 * c) * 33 + nl;
        h16x8 o;
#pragma unroll
        for (int e = 0; e < 8; ++e) o[e] = (h16)s[e * 33];
        int row;
        if (kind == 0) row = rowoff + n;
        else if (kind == 3) row = (n < 2048) ? n : (n < 4096 ? n + 2048 : n - 2048);
        else { row = (n < DFF) ? (256 * (n >> 7) + (n & 127)) : (256 * ((n - DFF) >> 7) + 128 + ((n - DFF) & 127)); }
        if (n < N || kind == 2) *(h16x8*)(WT + (size_t)row * K + k0 + 8 * c) = o;
    }
    LDS_FENCE();
}
#define WT_JOB(r, W, K, N, WT, gain, kind, rowoff) { const int _ni = ((K) / 64) * (((N) + 31) / 32); if ((r) >= 0 && (r) < _ni) wt_item(W, K, N, WT, gain, kind, rowoff, scr, r, lane); (r) -= _ni; }

__device__ __forceinline__ void xn_row(const float* xrow, h16* orow, int lane) {
    f32x4 v[4]; float s = 0.f;
#pragma unroll
    for (int j = 0; j < 4; ++j) { v[j] = *(const f32x4*)(xrow + 4 * lane + 256 * j); s += v[j].x * v[j].x + v[j].y * v[j].y + v[j].z * v[j].z + v[j].w * v[j].w; }
    const float rstd = rsqrtf(wave_sum(s) * (1.f / D) + EPS);
#pragma unroll
    for (int j = 0; j < 4; ++j) { h16x4 o; o[0] = (h16)(v[j].x * rstd); o[1] = (h16)(v[j].y * rstd); o[2] = (h16)(v[j].z * rstd); o[3] = (h16)(v[j].w * rstd); *(h16x4*)(orow + 4 * lane + 256 * j) = o; }
}
__device__ __forceinline__ void res_norm_row(const float* xi, const float* mb, const float* gain, float* xo, h16* xn, int lane) {
    f32x4 a[4], r[4]; float s = 0.f;
#pragma unroll
    for (int j = 0; j < 4; ++j) { a[j] = *(const f32x4*)(mb + 4 * lane + 256 * j); r[j] = *(const f32x4*)(xi + 4 * lane + 256 * j); s += a[j].x * a[j].x + a[j].y * a[j].y + a[j].z * a[j].z + a[j].w * a[j].w; }
    const float rstd = rsqrtf(wave_sum(s) * (1.f / D) + EPS); float s2 = 0.f;
#pragma unroll
    for (int j = 0; j < 4; ++j) { const f32x4 g = *(const f32x4*)(gain + 4 * lane + 256 * j); r[j] = r[j] + a[j] * rstd * g; *(f32x4*)(xo + 4 * lane + 256 * j) = r[j]; s2 += r[j].x * r[j].x + r[j].y * r[j].y + r[j].z * r[j].z + r[j].w * r[j].w; }
    if (xn) {
        const float rs2 = rsqrtf(wave_sum(s2) * (1.f / D) + EPS);
#pragma unroll
        for (int j = 0; j < 4; ++j) { h16x4 o; o[0] = (h16)(r[j].x * rs2); o[1] = (h16)(r[j].y * rs2); o[2] = (h16)(r[j].z * rs2); o[3] = (h16)(r[j].w * rs2); *(h16x4*)(xn + 4 * lane + 256 * j) = o; }
    }
}

constexpr int CT_LD = 260;
template <class Epi>
__device__ __forceinline__ void ngemm(const h16* A, int lda, const h16* Bt, int K, int Mrows, int Ntiles, float* lds, const Epi& E) {
    float* As = lds; float* Bs = lds + 64 * 33; float* Ct = lds + 64 * 33 + 256 * 33;
    const int tid = threadIdx.x, ty = tid >> 5, tx = tid & 31;
    const int nunits = (Mrows / 64) * Ntiles;
    for (int u = blockIdx.x; u < nunits; u += gridDim.x) {
        const int um = u / Ntiles, un = u % Ntiles;
        float acc[4][8];
#pragma unroll
        for (int i = 0; i < 4; ++i)
#pragma unroll
            for (int j = 0; j < 8; ++j) acc[i][j] = 0.f;
        for (int k0 = 0; k0 < K; k0 += 32) {
            { const h16x4 v = *(const h16x4*)(A + (size_t)(um * 64 + (tid >> 3)) * lda + k0 + (tid & 7) * 4);
#pragma unroll
              for (int j = 0; j < 4; ++j) As[(tid >> 3) * 33 + (tid & 7) * 4 + j] = (float)v[j]; }
            { const h16* p = Bt + (size_t)(un * 256 + (tid >> 1)) * K + k0 + (tid & 1) * 16; const h16x8 v0 = *(const h16x8*)p, v1 = *(const h16x8*)(p + 8);
#pragma unroll
              for (int j = 0; j < 8; ++j) { Bs[(tid >> 1) * 33 + (tid & 1) * 16 + j] = (float)v0[j]; Bs[(tid >> 1) * 33 + (tid & 1) * 16 + 8 + j] = (float)v1[j]; } }
            __syncthreads();
#pragma unroll 4
            for (int kk = 0; kk < 32; ++kk) {
                float a[4], b[8];
#pragma unroll
                for (int i = 0; i < 4; ++i) a[i] = As[(ty * 4 + i) * 33 + kk];
#pragma unroll
                for (int j = 0; j < 8; ++j) b[j] = Bs[(tx + 32 * j) * 33 + kk];
#pragma unroll
                for (int i = 0; i < 4; ++i)
#pragma unroll
                    for (int j = 0; j < 8; ++j) acc[i][j] += a[i] * b[j];
            }
            __syncthreads();
        }
#pragma unroll
        for (int i = 0; i < 4; ++i)
#pragma unroll
            for (int j = 0; j < 8; ++j) Ct[(ty * 4 + i) * CT_LD + tx + 32 * j] = acc[i][j];
        __syncthreads();
        E(um, un, Ct);
        __syncthreads();
    }
}

struct EpiF32 { float* O; int ldc;
    __device__ __forceinline__ void operator()(int um, int un, const float* Ct) const {
        for (int idx = threadIdx.x; idx < 64 * 256; idx += NT) { const int r = idx >> 8, c = idx & 255; O[(size_t)(um * 64 + r) * ldc + un * 256 + c] = Ct[r * CT_LD + c]; } }
};
struct EpiSwiglu { h16* H;
    __device__ __forceinline__ void operator()(int um, int un, const float* Ct) const {
        for (int idx = threadIdx.x; idx < 64 * 128; idx += NT) { const int r = idx >> 7, c = idx & 127; H[(size_t)(um * 64 + r) * DFF + un * 128 + c] = (h16)(silu_f(Ct[r * CT_LD + c]) * Ct[r * CT_LD + c + 128]); } }
};
struct EpiKvq {
    h16* KV6; h16* QN; float* GATES; const float *NC, *NS;
    __device__ __forceinline__ void operator()(int um, int un, const float* Ct) const {
        const int tid = threadIdx.x;
        if (un < 6) {
            h16* dst = KV6 + (size_t)un * (8u * T * 64); const bool rot = (un & 1) == 0;
            for (int idx = tid; idx < 64 * 256; idx += NT) { const int r = idx >> 8, c = idx & 255, m = um * 64 + r, b = m >> 13, t = m & (T - 1), g = c >> 6, d = c & 63;
                float v = Ct[r * CT_LD + c];
                if (rot && d < 16) { const int i = d & 7; const float cs = NC[t * 8 + i], sn = NS[t * 8 + i]; const float x1 = Ct[r * CT_LD + (c & ~15) + i], x2 = Ct[r * CT_LD + (c & ~15) + i + 8]; v = (d < 8) ? (x1 * cs - x2 * sn) : (x1 * sn + x2 * cs); }
                dst[((size_t)(b * 4 + g) * T + t) * 64 + d] = (h16)v; }
        } else if (un < 10) {
            for (int idx = tid; idx < 64 * 256; idx += NT) { const int r = idx >> 8, c = idx & 255, m = um * 64 + r, t = m & (T - 1), d = c & 63;
                float v = Ct[r * CT_LD + c];
                if (d < 16) { const int i = d & 7; const float cs = NC[t * 8 + i], sn = NS[t * 8 + i]; const float x1 = Ct[r * CT_LD + (c & ~15) + i], x2 = Ct[r * CT_LD + (c & ~15) + i + 8]; v = (d < 8) ? (x1 * cs - x2 * sn) : (x1 * sn + x2 * cs); }
                QN[(size_t)m * 1024 + (un - 6) * 256 + c] = (h16)(v * 0.125f); }
        } else {
            for (int idx = tid; idx < 64 * 48; idx += NT) { const int r = idx / 48, c = idx % 48; GATES[(size_t)(um * 64 + r) * 48 + c] = sigmoid_f(Ct[r * CT_LD + c]); }
        }
    }
};
struct EpiCmp { h16* HC; const float* bias;
    __device__ __forceinline__ void operator()(int um, int un, const float* Ct) const {
        for (int idx = threadIdx.x; idx < 64 * 256; idx += NT) { const int r = idx >> 8, c = idx & 255; HC[(size_t)(um * 64 + r) * 256 + c] = (h16)gelu_tanh_f(Ct[r * CT_LD + c] + bias[c]); } }
};

__device__ __forceinline__ void n_ret_state(const h16* K0, const h16* VT, h16* SS) {
    const int tid = threadIdx.x, d = tid & 255, half = tid >> 8;
    for (int it = blockIdx.x; it < 8 * 128; it += gridDim.x) {
        const int bh = it >> 7, vq = it & 127, b = bh >> 2, h = bh & 3, c0 = vq * 4 + half * 2;
        const float gam = 1.f - exp2f(-5.f - (float)h);
        const h16* kp = K0 + (size_t)(b * T) * 1024 + h * 256 + d; const h16* vp = VT + ((size_t)b * 2048 + h * 512 + c0) * T;
        float s0 = 0.f, s1 = 0.f;
        for (int jb = 0; jb < (NSUP - 1) * SUP; jb += 8) {
            float kv[8], v0[8], v1[8];
#pragma unroll
            for (int e = 0; e < 8; ++e) { kv[e] = (float)kp[(size_t)(jb + e) * 1024]; v0[e] = (float)vp[jb + e]; v1[e] = (float)vp[(size_t)T + jb + e]; }
#pragma unroll
            for (int e = 0; e < 8; ++e) { s0 = gam * s0 + kv[e] * v0[e]; s1 = gam * s1 + kv[e] * v1[e]; }
            if (((jb + 8) & (SUP - 1)) == 0) { const int ms = (jb + 8) / SUP - 1; h16* sp = SS + (((size_t)bh * (NSUP - 1) + ms) * 512 + c0) * 256 + d; sp[0] = (h16)s0; sp[256] = (h16)s1; }
        }
    }
}
__device__ __forceinline__ void n_ret_out(const h16* Q0, const h16* K0, const h16* VT, const h16* G0, const h16* SS, const float* gn, h16* Y, float* lds) {
    const int tid = threadIdx.x, lane = tid & 63, wave = tid >> 6;
    float* qs = lds + wave * 768; float* sc = qs + 256;
    const int gw = blockIdx.x * 8 + wave, NGW = gridDim.x * 8;
    for (int it = gw; it < M * 4; it += NGW) {
        const int m = ((it >> 5) << 3) | (it & 7), h = (it >> 3) & 3, b = m >> 13, t = m & (T - 1), tl = t & (SUP - 1), s0 = t - tl, ms = t / SUP, bh = b * 4 + h;
        const float lgh = ret_lg(h);
        for (int i = lane; i < 256; i += 64) qs[i] = (float)Q0[(size_t)m * 1024 + h * 256 + i];
        LDS_FENCE();
        for (int jj = lane; jj <= tl; jj += 64) {
            const h16* kr = K0 + (size_t)(b * T + s0 + jj) * 1024 + h * 256; float dot = 0.f;
#pragma unroll 2
            for (int d = 0; d < 256; d += 8) { const h16x8 kv = *(const h16x8*)(kr + d);
#pragma unroll
                for (int e = 0; e < 8; ++e) dot += (float)kv[e] * qs[d + e]; }
            sc[jj] = dot * __expf(lgh * (float)(tl - jj));
        }
        LDS_FENCE();
        float o[8];
#pragma unroll
        for (int e = 0; e < 8; ++e) o[e] = 0.f;
        const h16* vb = VT + ((size_t)b * 2048 + h * 512 + lane * 8) * T + s0;
        for (int jj = 0; jj <= tl; ++jj) { const float s = sc[jj];
#pragma unroll
            for (int e = 0; e < 8; ++e) o[e] += s * (float)vb[(size_t)e * T + jj]; }
        if (ms > 0) {
            const h16* sp = SS + (((size_t)bh * (NSUP - 1) + ms - 1) * 512 + lane * 8) * 256; const float qd = __expf(lgh * (float)(tl + 1));
            float cr[8];
#pragma unroll
            for (int e = 0; e < 8; ++e) cr[e] = 0.f;
#pragma unroll 1
            for (int d = 0; d < 256; d += 8) {
#pragma unroll
                for (int e = 0; e < 8; ++e) { const h16x8 sv = *(const h16x8*)(sp + e * 256 + d);
#pragma unroll
                    for (int f = 0; f < 8; ++f) cr[e] += (float)sv[f] * qs[d + f]; } }
#pragma unroll
            for (int e = 0; e < 8; ++e) o[e] += qd * cr[e];
        }
        float s1 = 0.f;
#pragma unroll
        for (int e = 0; e < 8; ++e) s1 += o[e];
        const float mu = wave_sum(s1) * (1.f / DV); float s2 = 0.f;
#pragma unroll
        for (int e = 0; e < 8; ++e) { o[e] -= mu; s2 += o[e] * o[e]; }
        const float rstd = rsqrtf(wave_sum(s2) * (1.f / DV) + EPS);
        const h16x8 gv = *(const h16x8*)(G0 + (size_t)m * 2048 + h * 512 + lane * 8); h16x8 yo;
#pragma unroll
        for (int e = 0; e < 8; ++e) yo[e] = (h16)(silu_f((float)gv[e]) * o[e] * rstd * gn[h * 512 + lane * 8 + e]);
        *(h16x8*)(Y + (size_t)m * 2048 + h * 512 + lane * 8) = yo;
        LDS_FENCE();
    }
}

__device__ __forceinline__ void dots4(const h16* krow, const float* qs, float (&dt)[4]) {
#pragma unroll
    for (int r = 0; r < 4; ++r) dt[r] = 0.f;
#pragma unroll
    for (int c = 0; c < 8; ++c) { const h16x8 kv = *(const h16x8*)(krow + 8 * c);
#pragma unroll
        for (int r = 0; r < 4; ++r)
#pragma unroll
            for (int e = 0; e < 8; ++e) dt[r] += (float)kv[e] * qs[r * 64 + 8 * c + e]; }
}
__device__ __forceinline__ void softmax4(float* sc, int n, int lane) {
    for (int r = 0; r < 4; ++r) {
        float mx = -INFINITY; for (int i = lane; i < n; i += 64) mx = fmaxf(mx, sc[r * 1024 + i]);
        mx = wave_max(mx); float sum = 0.f;
        for (int i = lane; i < n; i += 64) { const float e = __expf(sc[r * 1024 + i] - mx); sc[r * 1024 + i] = e; sum += e; }
        sum = wave_sum(sum); const float inv = 1.f / sum;
        for (int i = lane; i < n; i += 64) sc[r * 1024 + i] *= inv;
    }
    LDS_FENCE();
}
__device__ __forceinline__ int select_blocks(float imp0, float imp1, int cur, int* sel, int lane) {
    int nsel = 0;
    if (lane == 0) { sel[0] = 0; }
    nsel = 1;
    if (cur >= 1) { if (lane == 0) sel[nsel] = cur; ++nsel; }
    if (cur >= 2) { if (lane == 0) sel[nsel] = cur - 1; ++nsel; }
    const int sA = lane, sB = lane + 64;
    float v0 = (sA <= cur && sA != 0 && sA != cur && sA != cur - 1) ? imp0 : -INFINITY;
    float v1 = (sB <= cur && sB != 0 && sB != cur && sB != cur - 1) ? imp1 : -INFINITY;
    while (nsel < 16) {
        const float mx = wave_max(fmaxf(v0, v1));
        if (mx == -INFINITY) break;
        const unsigned long long b0 = __ballot(v0 == mx);
        int s;
        if (b0) { const int l = __ffsll((long long)b0) - 1; s = l; if (lane == l) v0 = -INFINITY; }
        else { const unsigned long long b1 = __ballot(v1 == mx); const int l = __ffsll((long long)b1) - 1; s = l + 64; if (lane == l) v1 = -INFINITY; }
        if (lane == 0) sel[nsel] = s;
        ++nsel;
    }
    LDS_FENCE();
    return nsel;
}
__device__ __forceinline__ void n_nsa_attn(const h16* QN, const h16* KV6, const h16* CK, const h16* CV, const float* GATES, h16* O1, float* lds) {
    const int tid = threadIdx.x, lane = tid & 63, wave = tid >> 6;
    float* qs = lds + wave * 4480; float* sc = qs + 256; int* sel = (int*)(sc + 4096);
    const h16 *KS = KV6 + 2 * (size_t)(8 * T * 64), *VS = KV6 + 3 * (size_t)(8 * T * 64), *KW = KV6 + 4 * (size_t)(8 * T * 64), *VW = KV6 + 5 * (size_t)(8 * T * 64);
    const int gw = blockIdx.x * 8 + wave, NGW = gridDim.x * 8;
    for (int it = gw; it < M * 4; it += NGW) {
        const int m = it >> 2, g = it & 3, b = m >> 13, t = m & (T - 1), bg = b * 4 + g;
        for (int i = lane; i < 256; i += 64) qs[i] = (float)QN[(size_t)m * 1024 + g * 256 + i];
        LDS_FENCE();
        const int nv = (t >= 31) ? ((t - 31) >> 4) + 1 : 0;
        float oc[4] = {0.f, 0.f, 0.f, 0.f};
        if (nv > 0) {
            for (int n = lane; n < nv; n += 64) { float dt[4]; dots4(CK + ((size_t)bg * NCP + n) * 64, qs, dt);
#pragma unroll
                for (int r = 0; r < 4; ++r) sc[r * 1024 + n] = dt[r]; }
            LDS_FENCE();
            softmax4(sc, nv, lane);
            for (int n = 0; n < nv; ++n) { const float vv = (float)CV[((size_t)bg * NCP + n) * 64 + lane];
#pragma unroll
                for (int r = 0; r < 4; ++r) oc[r] += sc[r * 1024 + n] * vv; }
        }
        float imp[2];
#pragma unroll
        for (int q = 0; q < 2; ++q) { const int s = lane + 64 * q; float a = 0.f;
#pragma unroll
            for (int e = -1; e < 4; ++e) { const int n = 4 * s + e; if (n >= 0 && n < nv) { const float p = sc[n] + sc[1024 + n] + sc[2048 + n] + sc[3072 + n]; a += (e == -1 || e == 3) ? p : 2.f * p; } }
            imp[q] = a; }
        LDS_FENCE();
        const int cur = t >> 6;
        const int nsel = select_blocks(imp[0], imp[1], cur, sel, lane);
        float os[4] = {0.f, 0.f, 0.f, 0.f};
        for (int i2 = 0; i2 < nsel; ++i2) { const int tok = sel[i2] * 64 + lane; float dt[4]; dots4(KS + ((size_t)bg * T + tok) * 64, qs, dt);
#pragma unroll
            for (int r = 0; r < 4; ++r) sc[r * 1024 + i2 * 64 + lane] = (tok <= t) ? dt[r] : -INFINITY; }
        LDS_FENCE();
        softmax4(sc, nsel * 64, lane);
        for (int kk = 0; kk < nsel * 64; ++kk) { const int tok = sel[kk >> 6] * 64 + (kk & 63); const float vv = (float)VS[((size_t)bg * T + tok) * 64 + lane];
#pragma unroll
            for (int r = 0; r < 4; ++r) os[r] += sc[r * 1024 + kk] * vv; }
        LDS_FENCE();
        float ow[4] = {0.f, 0.f, 0.f, 0.f};
        const int nw = (t + 1 < 512) ? t + 1 : 512, t0 = t - nw + 1;
        for (int i = lane; i < nw; i += 64) { float dt[4]; dots4(KW + ((size_t)bg * T + t0 + i) * 64, qs, dt);
#pragma unroll
            for (int r = 0; r < 4; ++r) sc[r * 1024 + i] = dt[r]; }
        LDS_FENCE();
        softmax4(sc, nw, lane);
        for (int i = 0; i < nw; ++i) { const float vv = (float)VW[((size_t)bg * T + t0 + i) * 64 + lane];
#pragma unroll
            for (int r = 0; r < 4; ++r) ow[r] += sc[r * 1024 + i] * vv; }
        LDS_FENCE();
#pragma unroll
        for (int r = 0; r < 4; ++r) { const float* gp = GATES + (size_t)m * 48 + (g * 4 + r) * 3;
            O1[(size_t)m * 1024 + (g * 4 + r) * 64 + lane] = (h16)(gp[0] * oc[r] + gp[1] * os[r] + gp[2] * ow[r]); }
    }
}

#define LAS __attribute__((address_space(3)))
#define XB_TMO      128
#define XB_XCNT(j)  (256  + 64 * (j))
#define XB_XSUB(j)  (1280 + 64 * (j))
#define XB_XGEN(j)  (2304 + 64 * (j))
#define XB_TOP      3328
#define XB_TOPGEN   3392
#define XCD_BAR_WORDS 3456
#define XB_SPIN_CAP (1u << 18)
__device__ __forceinline__ unsigned xb_ld(unsigned* p)              { return __hip_atomic_load(p, __ATOMIC_RELAXED, __HIP_MEMORY_SCOPE_AGENT); }
__device__ __forceinline__ unsigned xb_add(unsigned* p, unsigned v) { return __hip_atomic_fetch_add(p, v, __ATOMIC_RELAXED, __HIP_MEMORY_SCOPE_AGENT); }
__device__ __forceinline__ unsigned xb_xcc_id() { return (unsigned)__builtin_amdgcn_s_getreg((3 << 11) | 20) & 0xFu; }
#define XB_SPIN(cond, bar) do { unsigned _sp = 0; while (cond) { __builtin_amdgcn_s_sleep(1); \
    if ((++_sp & 255u) == 0u) { if (xb_ld(&(bar)[XB_TMO])) break; if (_sp > XB_SPIN_CAP) { atomicAdd(&(bar)[XB_TMO], 1u); break; } } } } while (0)
struct XcdBarrier { unsigned* bar; unsigned x; volatile LAS unsigned* st; };
__device__ __forceinline__ XcdBarrier xcd_barrier_post(unsigned* bar, volatile LAS unsigned* st) {
    XcdBarrier b; b.bar = bar; b.x = xb_xcc_id(); b.st = st;
    if (threadIdx.x == 0) (void)xb_add(&bar[XB_XCNT(b.x)], 1u);
    return b;
}
__device__ __forceinline__ void xcd_barrier_complete(unsigned* bar, unsigned x, unsigned& nloc, unsigned& nx) {
    const unsigned G = gridDim.x * gridDim.y * gridDim.z;
    unsigned sum, cnt, mine, sp = 0u;
    for (;;) {
        sum = 0u; cnt = 0u; mine = 0u;
#pragma unroll
        for (unsigned j = 0; j < 16; ++j) { const unsigned c = xb_ld(&bar[XB_XCNT(j)]); sum += c; cnt += (c > 0u) ? 1u : 0u; mine = (j == x) ? c : mine; }
        if (sum == G) break;
        __builtin_amdgcn_s_sleep(1);
        if ((++sp & 255u) == 0u) { if (xb_ld(&bar[XB_TMO])) break; if (sp > XB_SPIN_CAP) { atomicAdd(&bar[XB_TMO], 1u); break; } }
    }
    nloc = mine > 0u ? mine : 1u; nx = cnt > 0u ? cnt : 1u;
}
__device__ __forceinline__ void xcd_barrier(const XcdBarrier& b) {
    asm volatile("s_waitcnt vmcnt(0)" ::: "memory");
    __syncthreads();
    if (threadIdx.x == 0) {
        unsigned* bar = b.bar;
        __builtin_amdgcn_s_waitcnt(0);
        unsigned nloc = b.st[0], nx = b.st[1];
        if (nloc == 0u) { xcd_barrier_complete(bar, b.x, nloc, nx); b.st[0] = nloc; b.st[1] = nx; }
        const unsigned old = xb_add(&bar[XB_XSUB(b.x)], 1u);
        const unsigned gen = old / nloc;
        if (old + 1u == (gen + 1u) * nloc) {
            __builtin_amdgcn_fence(__ATOMIC_RELEASE, "agent");
            asm volatile("s_waitcnt vmcnt(0)" ::: "memory");
            const unsigned og = xb_add(&bar[XB_TOP], 1u);
            const unsigned tg = og / nx;
            if (og + 1u == (tg + 1u) * nx) xb_add(&bar[XB_TOPGEN], 1u);
            else XB_SPIN(xb_ld(&bar[XB_TOPGEN]) == tg, bar);
            __builtin_amdgcn_fence(__ATOMIC_ACQUIRE, "agent");
            xb_add(&bar[XB_XGEN(b.x)], 1u);
            asm volatile("s_waitcnt vmcnt(0)" ::: "memory");
        } else {
            XB_SPIN(xb_ld(&bar[XB_XGEN(b.x)]) == gen, bar);
            __builtin_amdgcn_fence(__ATOMIC_ACQUIRE, "agent");
            asm volatile("s_waitcnt vmcnt(0)" ::: "memory");
        }
    }
    __syncthreads();
}

namespace pg8 {
typedef float f32x4 __attribute__((ext_vector_type(4)));
typedef unsigned u32x4 __attribute__((ext_vector_type(4)));
constexpr int BM = 256, BK = 64, HALF = 128, HTB = HALF * BK * 2, STAGE_BYTES = 8 * HTB, NXCD = 8, WGM = 8;
__host__ __device__ __forceinline__ int lds_byte(int r, int c) { const int st = (r >> 4) * 2 + (c >> 5), rr = r & 15, cc = c & 31, ob = rr * 64 + cc * 2; return st * 1024 + (ob ^ (((ob >> 9) & 1) << 5)); }
__host__ __device__ __forceinline__ void stage_rc(int b, int& R, int& C) { const int st = b / 1024, sb = b % 1024, swz = sb ^ (((sb >> 9) & 1) << 5); R = (st >> 1) * 16 + swz / 64; C = (st & 1) * 32 + (swz % 64) / 2; }
__host__ __device__ __forceinline__ int perm32(int rho) { const int n = rho >> 4, i = rho & 15; return 8 * (i >> 2) + 4 * n + (i & 3); }
struct Unit { int pm, pn; };
struct Gemm { const h16* A; const h16* Bt; int M, N, K, lda; };
struct StaticOrder {
    int nM, nN, nwg, G, c;
    __host__ __device__ void init(int M, int N, int G_, int c_) { nM = M / BM; nN = N / BM; nwg = nM * nN; G = G_; c = c_; }
    __host__ __device__ bool next(int i, Unit& u) const {
        const long L = (long)i * G + c; if (L >= nwg) return false;
        int wgid = (int)L; { const int q = nwg / NXCD, r = nwg % NXCD, xcd = wgid % NXCD, off = wgid / NXCD; wgid = (xcd < r ? xcd * (q + 1) : r * (q + 1) + (xcd - r) * q) + off; }
        const int nig = WGM * nN, gid = wgid / nig, fm = gid * WGM, gsz = (nM - fm) < WGM ? (nM - fm) : WGM;
        u.pm = fm + ((wgid % nig) % gsz); u.pn = (wgid % nig) / gsz; return true;
    }
};
template <class Epi, class Sched, bool ALIGN_EPI, bool SP2, bool SWAP = false>
__device__ __forceinline__ void gemm_phase(LAS unsigned char* lds, const Gemm g, const Sched& S, const Epi& E) {
    const int tid = threadIdx.x, wid = __builtin_amdgcn_readfirstlane(tid >> 6), lane = tid & 63, wr = wid >> 2, wc = wid & 3, fr = lane & 15, fq = lane >> 4;
    const int K = g.K, nt = K / BK, lda = g.lda;
    unsigned voffA[2], voffB[2];
#pragma unroll
    for (int i = 0; i < 2; ++i) { int R, C; stage_rc(tid * 16 + i * 8192, R, C); const int Rb = Epi::PERM ? ((R & ~31) + perm32(R & 31)) : R;
        voffA[i] = (unsigned)(R * lda + C) * 2u; voffB[i] = (unsigned)(Rb * K + C) * 2u; }
    const size_t kstep = (size_t)(BK * 2);
    const size_t hstepA = (size_t)HALF * lda * 2, hstepB = (size_t)HALF * K * 2;
    const size_t tstepA = 2 * hstepA, tstepB = 2 * hstepB;
    const unsigned ldsw = (unsigned)wid * 1024u;
    const int aoff = lds_byte(wr * 64 + fr, fq * 8), boff = lds_byte(wc * 32 + fr, fq * 8);
#define PG8_SA(b, h) (((b) * 2 + (h)) * HTB)
#define PG8_SB(b, h) ((4 + (b) * 2 + (h)) * HTB)
#define PG8_STAGE(bufoff, gbase, voff) do { _Pragma("unroll") for (int _i = 0; _i < 2; ++_i) \
        __builtin_amdgcn_global_load_lds((const unsigned*)((const char*)(gbase) + (voff)[_i]), (LAS unsigned*)(lds + (bufoff) + ldsw + _i * 8192), 16, 0, 0); } while (0)
#define PG8_LDA(dst, b, h) do { _Pragma("unroll") for (int m = 0; m < 4; ++m) _Pragma("unroll") for (int k = 0; k < 2; ++k) dst[m][k] = *(const LAS h16x8*)(lds + PG8_SA(b, h) + aoff + m * 2048 + k * 1024); } while (0)
#define PG8_LDB(dst, b, h) do { _Pragma("unroll") for (int n = 0; n < 2; ++n) _Pragma("unroll") for (int k = 0; k < 2; ++k) dst[n][k] = *(const LAS h16x8*)(lds + PG8_SB(b, h) + boff + n * 2048 + k * 1024); } while (0)
#define PG8_MMA(ai, bj, At, Bt) do { __builtin_amdgcn_s_setprio(1); _Pragma("unroll") for (int m = 0; m < 4; ++m) _Pragma("unroll") for (int n = 0; n < 2; ++n) _Pragma("unroll") for (int k = 0; k < 2; ++k) \
        acc[ai][bj][m][n] = SWAP ? __builtin_amdgcn_mfma_f32_16x16x32_f16(At[m][k], Bt[n][k], acc[ai][bj][m][n], 0, 0, 0) : __builtin_amdgcn_mfma_f32_16x16x32_f16(Bt[n][k], At[m][k], acc[ai][bj][m][n], 0, 0, 0); __builtin_amdgcn_s_setprio(0); } while (0)
#define PG8_WAIT_V(n) asm volatile("s_waitcnt vmcnt(" #n ")" ::: "memory")
#define PG8_WAIT_L(n) asm volatile("s_waitcnt lgkmcnt(" #n ")" ::: "memory")
#define PG8_BAR __builtin_amdgcn_s_barrier()
#define PG8_SCHED __builtin_amdgcn_sched_barrier(0)
    Unit cur, nxt; int ui = 0;
    if (!S.next(0, cur)) return;
    f32x4 acc[2][2][4][2];
#pragma unroll
    for (int a = 0; a < 2; ++a)
#pragma unroll
        for (int b = 0; b < 2; ++b)
#pragma unroll
            for (int m = 0; m < 4; ++m)
#pragma unroll
                for (int n = 0; n < 2; ++n) acc[a][b][m][n] = (f32x4){0.f, 0.f, 0.f, 0.f};
    h16x8 At[4][2], B0[2][2], B1[2][2];
    const char* cA = (const char*)g.A + (size_t)cur.pm * tstepA; const char* cB = (const char*)g.Bt + (size_t)cur.pn * tstepB;
    if constexpr (SP2) {
        PG8_STAGE(PG8_SB(0, 0), cB, voffB); PG8_STAGE(PG8_SB(0, 1), cB + hstepB, voffB); PG8_STAGE(PG8_SA(0, 0), cA, voffA); PG8_STAGE(PG8_SA(0, 1), cA + hstepA, voffA);
        if (wr == 1) PG8_BAR;
        PG8_WAIT_V(2); PG8_BAR;
        PG8_STAGE(PG8_SB(1, 0), cB + kstep, voffB); PG8_STAGE(PG8_SA(1, 0), cA + kstep, voffA); PG8_STAGE(PG8_SB(1, 1), cB + hstepB + kstep, voffB);
        PG8_WAIT_V(6); PG8_BAR;
    } else {
        PG8_STAGE(PG8_SB(0, 0), cB, voffB); PG8_STAGE(PG8_SA(0, 0), cA, voffA); PG8_STAGE(PG8_SB(0, 1), cB + hstepB, voffB); PG8_STAGE(PG8_SA(0, 1), cA + hstepA, voffA);
        if (wr == 1) PG8_BAR;
        PG8_WAIT_V(4); PG8_BAR;
        PG8_STAGE(PG8_SB(1, 0), cB + kstep, voffB); PG8_STAGE(PG8_SA(1, 0), cA + kstep, voffA); PG8_STAGE(PG8_SB(1, 1), cB + hstepB + kstep, voffB);
        PG8_WAIT_V(6); PG8_BAR;
    }
    for (;;) {
        const bool has_next = S.next(ui + 1, nxt);
        const char* nA = has_next ? (const char*)g.A + (size_t)nxt.pm * tstepA : cA; const char* nB = has_next ? (const char*)g.Bt + (size_t)nxt.pn * tstepB : cB;
        for (int t = 0; t < nt; t += 2) {
            const bool last = (t == nt - 2);
            const char* a1 = cA + (size_t)(t + 1) * kstep;
            const char* a2 = last ? nA : cA + (size_t)(t + 2) * kstep; const char* b2 = last ? nB : cB + (size_t)(t + 2) * kstep;
            const char* a3 = a2 + kstep; const char* b3 = b2 + kstep;
            if constexpr (SP2) {
            PG8_LDB(B0, 0, 0); PG8_LDB(B1, 0, 1); PG8_SCHED; PG8_LDA(At, 0, 0); PG8_STAGE(PG8_SA(1, 1), a1 + hstepA, voffA);
            PG8_WAIT_V(8); PG8_WAIT_L(0); PG8_BAR; PG8_MMA(0, 0, At, B0); PG8_MMA(0, 1, At, B1); PG8_BAR; PG8_SCHED;
            PG8_LDA(At, 0, 1); PG8_STAGE(PG8_SB(0, 0), b2, voffB); PG8_STAGE(PG8_SB(0, 1), b2 + hstepB, voffB); PG8_STAGE(PG8_SA(0, 0), a2, voffA);
            PG8_WAIT_V(8); PG8_WAIT_L(0); PG8_BAR; PG8_MMA(1, 0, At, B0); PG8_MMA(1, 1, At, B1); PG8_BAR; PG8_SCHED;
            PG8_LDB(B0, 1, 0); PG8_LDB(B1, 1, 1); PG8_SCHED; PG8_LDA(At, 1, 0); PG8_STAGE(PG8_SA(0, 1), a2 + hstepA, voffA);
            PG8_WAIT_V(8); PG8_WAIT_L(0); PG8_BAR; PG8_MMA(0, 0, At, B0); PG8_MMA(0, 1, At, B1); PG8_BAR; PG8_SCHED;
            PG8_LDA(At, 1, 1); PG8_STAGE(PG8_SB(1, 0), b3, voffB); PG8_STAGE(PG8_SB(1, 1), b3 + hstepB, voffB); PG8_STAGE(PG8_SA(1, 0), a3, voffA);
            PG8_WAIT_V(8); PG8_WAIT_L(0); PG8_BAR; PG8_MMA(1, 0, At, B0); PG8_MMA(1, 1, At, B1); PG8_BAR; PG8_SCHED;
            } else {
            PG8_LDB(B0, 0, 0); PG8_SCHED; PG8_LDA(At, 0, 0); PG8_STAGE(PG8_SA(1, 1), a1 + hstepA, voffA);
            PG8_WAIT_L(8); PG8_BAR; PG8_WAIT_L(0); PG8_MMA(0, 0, At, B0); PG8_BAR; PG8_SCHED;
            PG8_LDB(B1, 0, 1); PG8_STAGE(PG8_SB(0, 0), b2, voffB);
            PG8_BAR; PG8_WAIT_L(0); PG8_MMA(0, 1, At, B1); PG8_BAR;
            PG8_LDA(At, 0, 1); PG8_STAGE(PG8_SA(0, 0), a2, voffA);
            PG8_BAR; PG8_WAIT_L(0); PG8_MMA(1, 0, At, B0); PG8_BAR; PG8_SCHED;
            PG8_STAGE(PG8_SB(0, 1), b2 + hstepB, voffB);
            PG8_WAIT_V(6); PG8_BAR; PG8_MMA(1, 1, At, B1); PG8_BAR;
            PG8_LDB(B0, 1, 0); PG8_SCHED; PG8_LDA(At, 1, 0); PG8_STAGE(PG8_SA(0, 1), a2 + hstepA, voffA);
            PG8_WAIT_L(8); PG8_BAR; PG8_WAIT_L(0); PG8_MMA(0, 0, At, B0); PG8_BAR; PG8_SCHED;
            PG8_LDB(B1, 1, 1); PG8_STAGE(PG8_SB(1, 0), b3, voffB);
            PG8_BAR; PG8_WAIT_L(0); PG8_MMA(0, 1, At, B1); PG8_BAR;
            PG8_LDA(At, 1, 1); PG8_STAGE(PG8_SA(1, 0), a3, voffA);
            PG8_BAR; PG8_WAIT_L(0); PG8_MMA(1, 0, At, B0); PG8_BAR; PG8_SCHED;
            PG8_STAGE(PG8_SB(1, 1), b3 + hstepB, voffB);
            PG8_WAIT_V(6); PG8_BAR; PG8_MMA(1, 1, At, B1); PG8_BAR;
            }
        }
        if constexpr (ALIGN_EPI) { if (wr == 0) PG8_BAR; }
        E(acc, cur, wr, wc, fr, fq);
        if (!has_next) break;
#pragma unroll
        for (int a = 0; a < 2; ++a)
#pragma unroll
            for (int b = 0; b < 2; ++b)
#pragma unroll
                for (int m = 0; m < 4; ++m)
#pragma unroll
                    for (int n = 0; n < 2; ++n) acc[a][b][m][n] = (f32x4){0.f, 0.f, 0.f, 0.f};
        cur = nxt; cA = nA; cB = nB; ++ui;
        if constexpr (ALIGN_EPI) { if (wr == 1) PG8_BAR; }
    }
    PG8_WAIT_V(0);
    if constexpr (!ALIGN_EPI) { if (wr == 0) PG8_BAR; }
    PG8_BAR;
#undef PG8_SA
#undef PG8_SB
#undef PG8_STAGE
#undef PG8_LDA
#undef PG8_LDB
#undef PG8_MMA
#undef PG8_WAIT_V
#undef PG8_WAIT_L
#undef PG8_BAR
#undef PG8_SCHED
}
__device__ __forceinline__ u32x4 pack8(const f32x4& a, const f32x4& b) {
    h16x8 o; o[0] = (h16)a[0]; o[1] = (h16)a[1]; o[2] = (h16)a[2]; o[3] = (h16)a[3]; o[4] = (h16)b[0]; o[5] = (h16)b[1]; o[6] = (h16)b[2]; o[7] = (h16)b[3];
    return __builtin_bit_cast(u32x4, o);
}
typedef f32x4 AccT[2][2][4][2];

struct EpiRetInF {
    static constexpr bool PERM = true;
    h16 *Q0, *K0, *KT, *G0; const float *RC, *RS;
    __device__ __forceinline__ void operator()(const AccT& acc, const Unit& u, int wr, int wc, int fr, int fq) const {
        const int row0 = u.pm * BM + wr * 64 + fr, c0 = wc * 32 + 8 * fq;
        if (u.pn < 8) {
            const bool isk = u.pn >= 4; const int hh = u.pn & 3; h16* dst = (isk ? K0 : Q0) + hh * 256; const float sc = isk ? 0.0625f : 1.f;
#pragma unroll
            for (int ai = 0; ai < 2; ++ai)
#pragma unroll
                for (int m = 0; m < 4; ++m) { const int row = row0 + ai * HALF + m * 16, t = row & (T - 1), b = row >> 13;
                    const f32x4 cs0 = *(const f32x4*)(RC + t * 128 + c0), cs1 = *(const f32x4*)(RC + t * 128 + c0 + 4), sn0 = *(const f32x4*)(RS + t * 128 + c0), sn1 = *(const f32x4*)(RS + t * 128 + c0 + 4);
                    const f32x4 x10 = acc[ai][0][m][0], x11 = acc[ai][0][m][1], x20 = acc[ai][1][m][0], x21 = acc[ai][1][m][1];
                    const f32x4 a0 = (x10 * cs0 - x20 * sn0) * sc, a1 = (x11 * cs1 - x21 * sn1) * sc, b0 = (x10 * sn0 + x20 * cs0) * sc, b1 = (x11 * sn1 + x21 * cs1) * sc;
                    h16* rp = dst + (size_t)row * 1024 + c0;
                    *(u32x4*)rp = pack8(a0, a1); *(u32x4*)(rp + 128) = pack8(b0, b1);
                    if (isk) { h16* kt = KT + ((size_t)(b * 4 + hh) * 256 + c0) * T + t;
#pragma unroll
                        for (int e = 0; e < 4; ++e) { kt[(size_t)e * T] = (h16)a0[e]; kt[(size_t)(e + 4) * T] = (h16)a1[e]; kt[(size_t)(e + 128) * T] = (h16)b0[e]; kt[(size_t)(e + 132) * T] = (h16)b1[e]; } } }
        } else {
            h16* dst = G0 + (u.pn - 8) * 256;
#pragma unroll
            for (int ai = 0; ai < 2; ++ai)
#pragma unroll
                for (int m = 0; m < 4; ++m) { h16* rp = dst + (size_t)(row0 + ai * HALF + m * 16) * 2048 + c0;
#pragma unroll
                    for (int bj = 0; bj < 2; ++bj) *(u32x4*)(rp + bj * HALF) = pack8(acc[ai][bj][m][0], acc[ai][bj][m][1]); }
        }
    }
};
struct EpiVT {
    static constexpr bool PERM = false;
    h16* dst; int ncols;
    __device__ __forceinline__ void operator()(const AccT& acc, const Unit& u, int wr, int wc, int fr, int fq) const {
#pragma unroll
        for (int ai = 0; ai < 2; ++ai)
#pragma unroll
            for (int m = 0; m < 4; ++m) { const int tok = u.pm * BM + ai * HALF + wr * 64 + m * 16 + 4 * fq, b = tok >> 13, t = tok & (T - 1);
#pragma unroll
                for (int bj = 0; bj < 2; ++bj)
#pragma unroll
                    for (int n = 0; n < 2; ++n) { const int col = u.pn * BM + bj * HALF + wc * 32 + n * 16 + fr; const f32x4 v = acc[ai][bj][m][n];
                        h16x4 o; o[0] = (h16)v[0]; o[1] = (h16)v[1]; o[2] = (h16)v[2]; o[3] = (h16)v[3];
                        *(h16x4*)(dst + ((size_t)b * ncols + col) * T + t) = o; } }
    }
};
struct EpiF32F { static constexpr bool PERM = true; float* O; int ldc;
    __device__ __forceinline__ void operator()(const AccT& acc, const Unit& u, int wr, int wc, int fr, int fq) const {
        const int row0 = u.pm * BM + wr * 64 + fr, c0 = u.pn * BM + wc * 32 + 8 * fq;
#pragma unroll
        for (int ai = 0; ai < 2; ++ai)
#pragma unroll
            for (int m = 0; m < 4; ++m) { float* rp = O + (size_t)(row0 + ai * HALF + m * 16) * ldc + c0;
#pragma unroll
                for (int bj = 0; bj < 2; ++bj) { *(f32x4*)(rp + bj * HALF) = acc[ai][bj][m][0]; *(f32x4*)(rp + bj * HALF + 4) = acc[ai][bj][m][1]; } }
    }
};
struct EpiSwigluF { static constexpr bool PERM = true; h16* H;
    __device__ __forceinline__ void operator()(const AccT& acc, const Unit& u, int wr, int wc, int fr, int fq) const {
        const int row0 = u.pm * BM + wr * 64 + fr, c0 = u.pn * 128 + wc * 32 + 8 * fq;
#pragma unroll
        for (int ai = 0; ai < 2; ++ai)
#pragma unroll
            for (int m = 0; m < 4; ++m) { f32x4 o[2];
#pragma unroll
                for (int n = 0; n < 2; ++n)
#pragma unroll
                    for (int e = 0; e < 4; ++e) o[n][e] = silu_f(acc[ai][0][m][n][e]) * acc[ai][1][m][n][e];
                *(u32x4*)(H + (size_t)(row0 + ai * HALF + m * 16) * DFF + c0) = pack8(o[0], o[1]); }
    }
};
struct EpiKvqF {
    static constexpr bool PERM = true;
    h16* KV6; h16* QN; float* GATES; const float *NC, *NS;
    __device__ __forceinline__ void operator()(const AccT& acc, const Unit& u, int wr, int wc, int fr, int fq) const {
        const int row0 = u.pm * BM + wr * 64 + fr;
        const int pn = u.pn;
        if (pn == 10) {
            if (wc < 2) {
#pragma unroll
                for (int ai = 0; ai < 2; ++ai)
#pragma unroll
                    for (int m = 0; m < 4; ++m) { const int row = row0 + ai * HALF + m * 16; const int c = wc * 32 + 8 * fq;
                        if (c < 48) { f32x4 o0, o1;
#pragma unroll
                            for (int e = 0; e < 4; ++e) { o0[e] = sigmoid_f(acc[ai][0][m][0][e]); o1[e] = sigmoid_f(acc[ai][0][m][1][e]); }
                            *(f32x4*)(GATES + (size_t)row * 48 + c) = o0; *(f32x4*)(GATES + (size_t)row * 48 + c + 4) = o1; } }
            }
            return;
        }
        const bool rot = (pn >= 6) || ((pn & 1) == 0);
        const bool rlane = rot && ((wc & 1) == 0);
        const float sc = (pn >= 6) ? 0.125f : 1.f;
#pragma unroll
        for (int ai = 0; ai < 2; ++ai)
#pragma unroll
            for (int m = 0; m < 4; ++m) { const int row = row0 + ai * HALF + m * 16, t = row & (T - 1), b = row >> 13;
#pragma unroll
                for (int bj = 0; bj < 2; ++bj) { f32x4 v0 = acc[ai][bj][m][0], v1 = acc[ai][bj][m][1];
                    if (rlane) {
                        f32x4 p0, p1;
#pragma unroll
                        for (int e = 0; e < 4; ++e) { p0[e] = __shfl_xor(v0[e], 16); p1[e] = __shfl_xor(v1[e], 16); }
                        if (fq < 2) { const f32x4 cs0 = *(const f32x4*)(NC + t * 8), cs1 = *(const f32x4*)(NC + t * 8 + 4), sn0 = *(const f32x4*)(NS + t * 8), sn1 = *(const f32x4*)(NS + t * 8 + 4);
                            if (fq == 0) { v0 = v0 * cs0 - p0 * sn0; v1 = v1 * cs1 - p1 * sn1; } else { v0 = p0 * sn0 + v0 * cs0; v1 = p1 * sn1 + v1 * cs1; } }
                    }
                    v0 = v0 * sc; v1 = v1 * sc;
                    const int c = bj * HALF + wc * 32 + 8 * fq;
                    if (pn < 6) { const int g = c >> 6, d = c & 63; *(u32x4*)(KV6 + (size_t)pn * (8u * T * 64) + ((size_t)(b * 4 + g) * T + t) * 64 + d) = pack8(v0, v1); }
                    else *(u32x4*)(QN + (size_t)row * 1024 + (pn - 6) * 256 + c) = pack8(v0, v1); } }
    }
};
struct EpiCmpF { static constexpr bool PERM = true; h16* HC; const float* bias;
    __device__ __forceinline__ void operator()(const AccT& acc, const Unit& u, int wr, int wc, int fr, int fq) const {
        const int row0 = u.pm * BM + wr * 64 + fr;
#pragma unroll
        for (int bj = 0; bj < 2; ++bj) { const int c = bj * HALF + wc * 32 + 8 * fq; const f32x4 b0 = *(const f32x4*)(bias + c), b1 = *(const f32x4*)(bias + c + 4);
#pragma unroll
            for (int ai = 0; ai < 2; ++ai)
#pragma unroll
                for (int m = 0; m < 4; ++m) { f32x4 o0, o1;
#pragma unroll
                    for (int e = 0; e < 4; ++e) { o0[e] = gelu_tanh_f(acc[ai][bj][m][0][e] + b0[e]); o1[e] = gelu_tanh_f(acc[ai][bj][m][1][e] + b1[e]); }
                    *(u32x4*)(HC + (size_t)(row0 + ai * HALF + m * 16) * 256 + c) = pack8(o0, o1); } }
    }
};
}

#define MFMA16(a, b, c) __builtin_amdgcn_mfma_f32_16x16x32_f16((a), (b), (c), 0, 0, 0)
__device__ __forceinline__ void f_ret_state(const h16* KT, const h16* VT, h16* SS) {
    const int tid = threadIdx.x, lane = tid & 63, w = tid >> 6, fr = lane & 15, kg = lane >> 4;
    for (int it = blockIdx.x; it < 256; it += gridDim.x) {
        const int bh = it & 7, rem = it >> 3, dvt = rem >> 2, dkt = rem & 3, b = bh >> 2, h = bh & 3;
        const float lg = ret_lg(h), g32 = __expf(32.f * lg);
        const int dvr = dvt * 64 + (w >> 1) * 16, dkc = dkt * 64 + (w & 1) * 32;
        const h16* vrow = VT + ((size_t)b * 2048 + h * 512 + dvr + fr) * T + 8 * kg;
        const h16* krow0 = KT + ((size_t)bh * 256 + dkc + fr) * T + 8 * kg;
        const h16* krow1 = krow0 + (size_t)16 * T;
        h16x8 dec;
#pragma unroll
        for (int j = 0; j < 8; ++j) dec[j] = (h16)__expf(lg * (float)(31 - 8 * kg - j));
        f32x4 acc0 = {0.f, 0.f, 0.f, 0.f}, acc1 = {0.f, 0.f, 0.f, 0.f};
        for (int sb = 0; sb < (NSUP - 1) * 16; sb += 16) {
#pragma unroll
            for (int s2 = 0; s2 < 16; ++s2) { const int tok = (sb + s2) * 32;
                const h16x8 a = *(const h16x8*)(vrow + tok) * dec; const h16x8 b0 = *(const h16x8*)(krow0 + tok), b1 = *(const h16x8*)(krow1 + tok);
                acc0 = acc0 * g32; acc1 = acc1 * g32;
                acc0 = MFMA16(a, b0, acc0); acc1 = MFMA16(a, b1, acc1); }
            const int ms = sb >> 4;
            h16* sp = SS + (((size_t)bh * (NSUP - 1) + ms) * 512 + dvr + 4 * kg) * 256 + dkc + fr;
#pragma unroll
            for (int r = 0; r < 4; ++r) { sp[(size_t)r * 256] = (h16)acc0[r]; sp[(size_t)r * 256 + 16] = (h16)acc1[r]; }
        }
    }
}
__device__ __forceinline__ void f_ret_out(const h16* Q0, const h16* K0, const h16* VT, const h16* G0, const h16* SS, const float* gn, h16* Y, LAS unsigned char* lds) {
    const int tid = threadIdx.x, lane = tid & 63, w = __builtin_amdgcn_readfirstlane(tid >> 6), fr = lane & 15, kg = lane >> 4;
    LAS unsigned char* QL = lds; LAS unsigned char* KL = lds + 32768; LAS unsigned char* PL = lds + 65536; LAS float* RED = (LAS float*)(lds + 81920);
    for (int it = blockIdx.x; it < 1024; it += gridDim.x) {
        const int c = it & 255, ii = it >> 8, bh = c & 7, u = c >> 3, sup = u >> 1, half = u & 1;
        const int j = (ii < 2) ? (half * 2 + ii) : (7 - half * 2 - (ii - 2));
        const int b = bh >> 2, h = bh & 3, tok0 = sup * SUP + j * 64, m0 = b * T + tok0;
        const float lgh = ret_lg(h);
        h16x8 kreg[4];
#pragma unroll
        for (int i = 0; i < 4; ++i) { const int id = tid + 512 * i, row = id >> 5, cch = id & 31;
            const h16x8 v = *(const h16x8*)(Q0 + (size_t)(m0 + row) * 1024 + h * 256 + cch * 8);
            *(LAS h16x8*)(QL + row * 512 + ((cch ^ (row & 15)) << 4)) = v;
            kreg[i] = *(const h16x8*)(K0 + (size_t)(b * T + sup * SUP + row) * 1024 + h * 256 + cch * 8); }
        __syncthreads();
        f32x4 acc[4][4];
#pragma unroll
        for (int mt = 0; mt < 4; ++mt)
#pragma unroll
            for (int nt = 0; nt < 4; ++nt) acc[mt][nt] = (f32x4){0.f, 0.f, 0.f, 0.f};
        if (sup > 0) {
            const h16* sp = SS + (((size_t)bh * (NSUP - 1) + sup - 1) * 512 + 64 * w + fr) * 256 + 8 * kg;
#pragma unroll 2
            for (int ks = 0; ks < 8; ++ks) {
                h16x8 af[4], bf[4];
#pragma unroll
                for (int mt = 0; mt < 4; ++mt) af[mt] = *(const h16x8*)(sp + (size_t)mt * 16 * 256 + 32 * ks);
#pragma unroll
                for (int nt = 0; nt < 4; ++nt) { const int row = 16 * nt + fr; bf[nt] = *(const LAS h16x8*)(QL + row * 512 + (((4 * ks + kg) ^ (row & 15)) << 4)); }
#pragma unroll
                for (int mt = 0; mt < 4; ++mt)
#pragma unroll
                    for (int nt = 0; nt < 4; ++nt) acc[mt][nt] = MFMA16(af[mt], bf[nt], acc[mt][nt]);
            }
#pragma unroll
            for (int nt = 0; nt < 4; ++nt) { const float qd = __expf(lgh * (float)(j * 64 + 16 * nt + fr + 1));
#pragma unroll
                for (int mt = 0; mt < 4; ++mt) acc[mt][nt] = acc[mt][nt] * qd; }
        }
        const int kw = w & 3, tw = w >> 2;
        for (int kt = 0; kt <= j; ++kt) {
            const int key0 = sup * SUP + kt * 64;
#pragma unroll
            for (int i = 0; i < 4; ++i) { const int id = tid + 512 * i, row = id >> 5, cch = id & 31; *(LAS h16x8*)(KL + row * 512 + ((cch ^ (row & 15)) << 4)) = kreg[i]; }
            if (kt < j) {
#pragma unroll
                for (int i = 0; i < 4; ++i) { const int id = tid + 512 * i, row = id >> 5, cch = id & 31; kreg[i] = *(const h16x8*)(K0 + (size_t)(b * T + key0 + 64 + row) * 1024 + h * 256 + cch * 8); }
            }
            h16x8 av[4][2];
#pragma unroll
            for (int mt = 0; mt < 4; ++mt)
#pragma unroll
                for (int ks = 0; ks < 2; ++ks) av[mt][ks] = *(const h16x8*)(VT + ((size_t)b * 2048 + h * 512 + 64 * w + 16 * mt + fr) * T + key0 + 32 * ks + 8 * kg);
            __syncthreads();
            f32x4 s[2] = {{0.f, 0.f, 0.f, 0.f}, {0.f, 0.f, 0.f, 0.f}};
#pragma unroll
            for (int ks = 0; ks < 8; ++ks) {
                const int kr = 16 * kw + fr; const h16x8 a = *(const LAS h16x8*)(KL + kr * 512 + (((4 * ks + kg) ^ (kr & 15)) << 4));
#pragma unroll
                for (int n = 0; n < 2; ++n) { const int qr = 32 * tw + 16 * n + fr; const h16x8 bq = *(const LAS h16x8*)(QL + qr * 512 + (((4 * ks + kg) ^ (qr & 15)) << 4)); s[n] = MFMA16(a, bq, s[n]); }
            }
            LAS unsigned char* PB = PL + (kt & 1) * 8192;
#pragma unroll
            for (int n = 0; n < 2; ++n) { const int tl = 32 * tw + 16 * n + fr; h16x4 p;
#pragma unroll
                for (int r = 0; r < 4; ++r) { const int dlt = (tok0 + tl) - (key0 + 16 * kw + 4 * kg + r); p[r] = (h16)((dlt >= 0) ? s[n][r] * __expf(lgh * (float)dlt) : 0.f); }
                *(LAS h16x4*)(PB + tl * 128 + (((2 * kw + (kg >> 1)) ^ (tl & 7)) << 4) + (kg & 1) * 8) = p; }
            __syncthreads();
#pragma unroll
            for (int ks = 0; ks < 2; ++ks) {
                h16x8 bp[4];
#pragma unroll
                for (int nt = 0; nt < 4; ++nt) { const int tl = 16 * nt + fr; bp[nt] = *(const LAS h16x8*)(PB + tl * 128 + (((4 * ks + kg) ^ (tl & 7)) << 4)); }
#pragma unroll
                for (int mt = 0; mt < 4; ++mt)
#pragma unroll
                    for (int nt = 0; nt < 4; ++nt) acc[mt][nt] = MFMA16(av[mt][ks], bp[nt], acc[mt][nt]);
            }
        }
        float mean[4], rstd[4];
#pragma unroll
        for (int nt = 0; nt < 4; ++nt) { float s1 = 0.f, s2 = 0.f;
#pragma unroll
            for (int mt = 0; mt < 4; ++mt)
#pragma unroll
                for (int r = 0; r < 4; ++r) { const float x = acc[mt][nt][r]; s1 += x; s2 += x * x; }
            s1 += __shfl_xor(s1, 16); s1 += __shfl_xor(s1, 32); s2 += __shfl_xor(s2, 16); s2 += __shfl_xor(s2, 32);
            if (kg == 0) { RED[(w * 64 + 16 * nt + fr) * 2] = s1; RED[(w * 64 + 16 * nt + fr) * 2 + 1] = s2; } }
        __syncthreads();
#pragma unroll
        for (int nt = 0; nt < 4; ++nt) { float s1 = 0.f, s2 = 0.f;
#pragma unroll
            for (int ww = 0; ww < 8; ++ww) { s1 += RED[(ww * 64 + 16 * nt + fr) * 2]; s2 += RED[(ww * 64 + 16 * nt + fr) * 2 + 1]; }
            mean[nt] = s1 * (1.f / DV); rstd[nt] = rsqrtf(fmaxf(s2 * (1.f / DV) - mean[nt] * mean[nt], 0.f) + EPS); }
#pragma unroll
        for (int mt = 0; mt < 4; ++mt) { const int dv = 64 * w + 16 * mt + 4 * kg; const f32x4 gv = *(const f32x4*)(gn + h * 512 + dv);
#pragma unroll
            for (int nt = 0; nt < 4; ++nt) { const size_t off = (size_t)(m0 + 16 * nt + fr) * 2048 + h * 512 + dv; const h16x4 gg = *(const h16x4*)(G0 + off); h16x4 yo;
#pragma unroll
                for (int r = 0; r < 4; ++r) yo[r] = (h16)(silu_f((float)gg[r]) * (acc[mt][nt][r] - mean[nt]) * rstd[nt] * gv[r]);
                *(h16x4*)(Y + off) = yo; } }
        __syncthreads();
    }
}

constexpr int MISC_OFF = LDS_BYTES - 64;
constexpr int CW_BAR = 4096;
constexpr size_t CTL_ZERO_BYTES = 64 * 1024;

template <int PH> __global__ void __launch_bounds__(NT, 2) mk(Args args) {
    extern __shared__ __attribute__((aligned(16))) unsigned char lds_raw[];
    float* lds = (float*)lds_raw;
    const int tid = threadIdx.x, lane = tid & 63, wave = tid >> 6;
    const int gw = blockIdx.x * 8 + wave, NGW = gridDim.x * 8, gt = blockIdx.x * NT + tid, NGT = gridDim.x * NT;
    unsigned char* ws = args.ws;
    const float* x = args.in[0]; const float* norms = args.in[1];
    float* RC = (float*)(ws + WS_RC); float* RS = (float*)(ws + WS_RS); float* NC = (float*)(ws + WS_NC); float* NS = (float*)(ws + WS_NS);
    float* BIASK = (float*)(ws + WS_BIASK); float* BIASV = (float*)(ws + WS_BIASV);
    h16* XN = (h16*)(ws + WS_XN); float* MB = (float*)(ws + WS_MB); h16* HID = (h16*)(ws + WS_HID);
    h16* WFI = (h16*)(ws + WS_WFI); h16* WFO = (h16*)(ws + WS_WFO);
    h16* Q0 = (h16*)(ws + WS_Q0); h16* K0 = (h16*)(ws + WS_K0); h16* VT = (h16*)(ws + WS_VT); h16* KT = (h16*)(ws + WS_KT); h16* G0 = (h16*)args.out; h16* SS = (h16*)(ws + WS_SS); h16* Y = (h16*)(ws + WS_Y);
    h16* KV6 = (h16*)(ws + WS_KC); h16* QN = (h16*)(ws + WS_QN); float* GATES = (float*)(ws + WS_GATES); h16* HC = (h16*)(ws + WS_HC); h16* CK = (h16*)(ws + WS_CK); h16* CV = (h16*)(ws + WS_CV); h16* O1 = (h16*)(ws + WS_O1);
    float* XR = args.out;
    float* scr = lds + wave * (64 * 33);
    const int lo = args.ph_lo, hi = args.ph_hi;
    XcdBarrier bar; bar.bar = nullptr; bar.x = 0; bar.st = nullptr;
    if (PH < 0) {
        volatile LAS unsigned* misc = (volatile LAS unsigned*)((LAS unsigned char*)lds_raw + MISC_OFF);
        if (tid < 2) misc[tid] = 0u;
        __syncthreads();
        bar = xcd_barrier_post((unsigned*)(ws + WS_CTL) + CW_BAR, misc);
    }
#define FGEMM(EpiT, Eobj, Aptr, lda_, Btptr, Mrows, N_, K_, cidx, ALIGN) { const pg8::Gemm g_{Aptr, Btptr, Mrows, N_, K_, lda_}; pg8::StaticOrder S_; S_.init(Mrows, N_, (int)gridDim.x, (int)(cidx)); \
        const EpiT E_ = Eobj; pg8::gemm_phase<EpiT, pg8::StaticOrder, ALIGN, true>((LAS unsigned char*)lds_raw, g_, S_, E_); }
#define FGEMM_SW(EpiT, Eobj, Aptr, lda_, Btptr, Mrows, N_, K_, cidx, ALIGN) { const pg8::Gemm g_{Aptr, Btptr, Mrows, N_, K_, lda_}; pg8::StaticOrder S_; S_.init(Mrows, N_, (int)gridDim.x, (int)(cidx)); \
        const EpiT E_ = Eobj; pg8::gemm_phase<EpiT, pg8::StaticOrder, ALIGN, true, true>((LAS unsigned char*)lds_raw, g_, S_, E_); }
#define SEAM(k) { if (PH < 0 && IN(k) && IN((k) + 1)) xcd_barrier(bar); }
#define IN(k) (PH < 0 ? (lo <= (k) && (k) < hi) : (PH == (k)))

    if (IN(0)) {
        const int NI = 16 * 192 + 32 * 32;
        for (int it = gw; it < NI; it += NGW) { int r = it;
            WT_JOB(r, args.in[2], 1024, 6144, (h16*)(ws + WS_WA), norms + 0 * 1024, 3, 0);
            WT_JOB(r, args.in[4], 2048, 1024, (h16*)(ws + WS_WRO), nullptr, 0, 0); }
        for (int i = gt; i < T * 128; i += NGT) { const int t = i >> 7, j = i & 127; const float fr = (float)(1.0 / pow(10000.0, (double)((float)j / 127.0f))); float c, s; sincos_acc((float)t * fr, c, s); RC[i] = c; RS[i] = s; }
        for (int i = gt; i < T * 8; i += NGT) { const int t = i >> 3, j = i & 7; const float fr = (float)pow(500000.0, -(double)(2 * j) / 16.0); float c, s; sincos_acc((float)t * fr, c, s); NC[i] = c; NS[i] = s; }
        for (int m = gw; m < M; m += NGW) xn_row(x + (size_t)m * D, XN + (size_t)m * D, lane);
    }
    SEAM(0)
    if (IN(1)) { FGEMM(pg8::EpiRetInF, (pg8::EpiRetInF{Q0, K0, KT, G0, RC, RS}), XN, 1024, (const h16*)(ws + WS_WA), M, 4096, 1024, blockIdx.x, true)
                 FGEMM_SW(pg8::EpiVT, (pg8::EpiVT{VT, 2048}), XN, 1024, (const h16*)(ws + WS_WA) + (size_t)4096 * 1024, M, 2048, 1024, blockIdx.x, true) }
    SEAM(1)
    if (IN(2)) f_ret_state(KT, VT, SS);
    SEAM(2)
    if (IN(3)) f_ret_out(Q0, K0, VT, G0, SS, args.in[3], Y, (LAS unsigned char*)lds_raw);
    SEAM(3)
    if (IN(4)) FGEMM(pg8::EpiF32F, (pg8::EpiF32F{MB, 1024}), Y, 2048, (const h16*)(ws + WS_WRO), M, 1024, 2048, blockIdx.x, false)
#define PH_NORM_A(L, xin) {     \
            for (int m = gw; m < M; m += NGW) res_norm_row((xin) + (size_t)m * D, MB + (size_t)m * D, norms + ((L) * 4 + 1) * 1024, XR + (size_t)m * D, XN + (size_t)m * D, lane); \
            const int NI = 16 * 176 + 44 * 32; \
            for (int it = gw; it < NI; it += NGW) { int r = it; \
                WT_JOB(r, args.in[15] + (size_t)(L) * 1024 * 5632, 1024, 5632, WFI, norms + ((L) * 4 + 2) * 1024, 1, 0); \
                WT_JOB(r, args.in[16] + (size_t)(L) * 2816 * 1024, 2816, 1024, WFO, nullptr, 0, 0); } }
#define PH_FFN_IN() FGEMM(pg8::EpiSwigluF, (pg8::EpiSwigluF{HID}), XN, 1024, WFI, M, 5632, 1024, blockIdx.x, true)
#define PH_FFN_OUT() FGEMM(pg8::EpiF32F, (pg8::EpiF32F{MB, 1024}), HID, DFF, WFO, M, 1024, DFF, blockIdx.x, false)
    SEAM(4)
    if (IN(5)) PH_NORM_A(0, x)
    SEAM(5)
    if (IN(6)) PH_FFN_IN()
    SEAM(6)
    if (IN(7)) PH_FFN_OUT()
    SEAM(7)
    if (IN(8)) {
        for (int m = gw; m < M; m += NGW) res_norm_row(XR + (size_t)m * D, MB + (size_t)m * D, norms + 3 * 1024, XR + (size_t)m * D, XN + (size_t)m * D, lane);
        const int NI = 16 * 48 + 16 * 34 + 16 * 32 + 2 * 32 * 8;
        for (int it = gw; it < NI; it += NGW) { int r = it;
            WT_JOB(r, args.in[8], 1024, 1536, (h16*)(ws + WS_WKVQ), args.in[7], 0, 0);
            WT_JOB(r, args.in[5], 1024, 1072, (h16*)(ws + WS_WKVQ), norms + 4 * 1024, 0, 1536);
            WT_JOB(r, args.in[6], 1024, 1024, (h16*)(ws + WS_WNO), nullptr, 0, 0);
            WT_JOB(r, args.in[11], 2048, 256, (h16*)(ws + WS_WC1K), nullptr, 0, 0);
            WT_JOB(r, args.in[13], 2048, 256, (h16*)(ws + WS_WC1V), nullptr, 0, 0); }
        { h16* z = (h16*)(ws + WS_WKVQ) + (size_t)2608 * 1024; for (int i = gt; i < 208 * 1024; i += NGT) z[i] = (h16)0.f; }
        for (int o = gw; o < 512; o += NGW) {
            const int which = o >> 8, c = o & 255; const float* pos = args.in[which ? 10 : 9]; const float* w1 = args.in[which ? 13 : 11]; float a = 0.f;
            for (int k = lane; k < 2048; k += 64) a += pos[k] * w1[(size_t)k * 256 + c];
            a = wave_sum(a); if (lane == 0) (which ? BIASV : BIASK)[c] = a; }
    }
    SEAM(8)
    if (IN(9)) FGEMM(pg8::EpiKvqF, (pg8::EpiKvqF{KV6, QN, GATES, NC, NS}), XN, 1024, (const h16*)(ws + WS_WKVQ), M, 2816, 1024, blockIdx.x, true)
    SEAM(9)
    if (IN(10)) {
        FGEMM(pg8::EpiCmpF, (pg8::EpiCmpF{HC, BIASK}), KV6, 1024, (const h16*)(ws + WS_WC1K), 4096, 256, 2048, blockIdx.x, false)
        FGEMM(pg8::EpiCmpF, (pg8::EpiCmpF{HC + (size_t)4096 * 256, BIASV}), KV6 + (size_t)8 * T * 64, 1024, (const h16*)(ws + WS_WC1V), 4096, 256, 2048, (blockIdx.x + 240) & 255, false)
    }
    SEAM(10)
    if (IN(11)) {
        for (int i = gt; i < 2 * 4096 * 64; i += NGT) { const int which = i >> 18, r = (i >> 6) & 4095, d = i & 63; const float* w2 = args.in[which ? 14 : 12]; const h16* hr = HC + ((size_t)which * 4096 + r) * 256; float a = 0.f;
            for (int c = 0; c < 256; ++c) a += (float)hr[c] * w2[c * 64 + d];
            if ((r & 511) == 511) a = 0.f;
            (which ? CV : CK)[(size_t)r * 64 + d] = (h16)a; }
    }
    SEAM(11)
    if (IN(12)) n_nsa_attn(QN, KV6, CK, CV, GATES, O1, lds);
    SEAM(12)
    if (IN(13)) FGEMM(pg8::EpiF32F, (pg8::EpiF32F{MB, 1024}), O1, 1024, (const h16*)(ws + WS_WNO), M, 1024, 1024, blockIdx.x, false)
    SEAM(13)
    if (IN(14)) PH_NORM_A(1, XR)
    SEAM(14)
    if (IN(15)) PH_FFN_IN()
    SEAM(15)
    if (IN(16)) PH_FFN_OUT()
    SEAM(16)
    if (IN(17)) { for (int m = gw; m < M; m += NGW) res_norm_row(XR + (size_t)m * D, MB + (size_t)m * D, norms + 7 * 1024, XR + (size_t)m * D, nullptr, lane); }
#undef IN
}

extern "C" void kernel_launch(void* const* d_in, const int* in_sizes, int n_in, void* d_out, int out_size, void* d_ws, size_t ws_size, hipStream_t stream) {
    static int grid = 0;
    if (grid == 0) {
        if (n_in != 17 || out_size != M * D || ws_size < WS_END) { fprintf(stderr, "kernel_launch: unexpected problem (n_in %d out %d ws %zu)\n", n_in, out_size, ws_size); grid = -1; return; }
        int dev = 0, cus = 0;
        (void)hipGetDevice(&dev); (void)hipDeviceGetAttribute(&cus, hipDeviceAttributeMultiprocessorCount, dev);
#define SETATTR(p) if (hipFuncSetAttribute((const void*)mk<p>, hipFuncAttributeMaxDynamicSharedMemorySize, LDS_BYTES) != hipSuccess) { fprintf(stderr, "kernel_launch: hipFuncSetAttribute failed\n"); grid = -1; return; }
        SETATTR(-1) SETATTR(0) SETATTR(1) SETATTR(2) SETATTR(3) SETATTR(4) SETATTR(5) SETATTR(6) SETATTR(7) SETATTR(8) SETATTR(9)
        SETATTR(10) SETATTR(11) SETATTR(12) SETATTR(13) SETATTR(14) SETATTR(15) SETATTR(16) SETATTR(17)
        (void)hipGetLastError();
        grid = cus > 0 ? cus : 256;
    }
    if (grid < 0) return;
    Args a{};
    for (int i = 0; i < 17; ++i) a.in[i] = (const float*)d_in[i];
    a.out = (float*)d_out; a.ws = (unsigned char*)d_ws;
#if MK_ONE_LAUNCH
    if (hipMemsetAsync((char*)d_ws + WS_CTL, 0, CTL_ZERO_BYTES, stream) != hipSuccess) { fprintf(stderr, "kernel_launch: memset failed\n"); return; }
    a.ph_lo = 0; a.ph_hi = NPHASE; hipLaunchKernelGGL(mk<-1>, dim3(grid), dim3(NT), LDS_BYTES, stream, a);
    return;
#endif
#define LAUNCH_PH(p) { a.ph_lo = p; a.ph_hi = p + 1; hipLaunchKernelGGL(mk<p>, dim3(grid), dim3(NT), LDS_BYTES, stream, a); }
    LAUNCH_PH(0) LAUNCH_PH(1) LAUNCH_PH(2) LAUNCH_PH(3) LAUNCH_PH(4) LAUNCH_PH(5) LAUNCH_PH(6) LAUNCH_PH(7) LAUNCH_PH(8) LAUNCH_PH(9)
    LAUNCH_PH(10) LAUNCH_PH(11) LAUNCH_PH(12) LAUNCH_PH(13) LAUNCH_PH(14) LAUNCH_PH(15) LAUNCH_PH(16) LAUNCH_PH(17)
}
```

```cpp
#include <hip/hip_runtime.h>
#include <cstdio>
#include <cstdint>

#ifndef MK_ONE_LAUNCH
#define MK_ONE_LAUNCH 1
#endif

typedef _Float16 h16;
typedef _Float16 h16x8 __attribute__((ext_vector_type(8)));
typedef _Float16 h16x4 __attribute__((ext_vector_type(4)));
typedef float f32x4 __attribute__((ext_vector_type(4)));

constexpr int BATCH = 2, T = 8192, D = 1024, M = BATCH * T;
constexpr int RH = 4, DK = 256, DV = 512;
constexpr int NG = 4, HD = 64, NCP = 512;
constexpr int DFF = 2816;
constexpr int SUP = 512, NSUP = T / SUP;
constexpr float EPS = 1e-6f;
constexpr int NPHASE = 18;
constexpr int NT = 512;
constexpr int LDS_BYTES = 147456;

constexpr size_t MiB = 1u << 20;
constexpr size_t WS_CTL = 0;
constexpr size_t WS_RC = 1 * MiB, WS_RS = 5 * MiB;
constexpr size_t WS_NC = 9 * MiB, WS_NS = 9 * MiB + 256 * 1024;
constexpr size_t WS_BIASK = 9 * MiB + 512 * 1024, WS_BIASV = WS_BIASK + 1024;
constexpr size_t WS_WC1K = 10 * MiB, WS_WC1V = 11 * MiB;
constexpr size_t WS_WA = 12 * MiB;
constexpr size_t WS_WKVQ = 12 * MiB, WS_WNO = 18 * MiB;
constexpr size_t WS_WRO = 24 * MiB;
constexpr size_t WS_XN = 28 * MiB;
constexpr size_t WS_SS = 28 * MiB;
constexpr size_t WS_O1 = 28 * MiB;
constexpr size_t WS_Q0 = 60 * MiB, WS_K0 = 92 * MiB, WS_VT = 124 * MiB, WS_KT = 188 * MiB, WS_Y = 188 * MiB;
constexpr size_t WS_MB = 60 * MiB;
constexpr size_t WS_WFI = 124 * MiB, WS_WFO = 135 * MiB;
constexpr size_t WS_HID = 144 * MiB;
constexpr size_t WS_KC = 124 * MiB, WS_VC = 132 * MiB, WS_KS = 140 * MiB, WS_VS = 148 * MiB, WS_KW = 156 * MiB, WS_VW = 164 * MiB;
constexpr size_t WS_QN = 172 * MiB;
constexpr size_t WS_GATES = 204 * MiB;
constexpr size_t WS_HC = 208 * MiB;
constexpr size_t WS_CK = 212 * MiB, WS_CV = 212 * MiB + 512 * 1024;
constexpr size_t WS_END = 252 * MiB;

struct Args { const float* in[17]; float* out; unsigned char* ws; int ph_lo, ph_hi; };

__device__ __forceinline__ float wave_sum(float v) {
#pragma unroll
    for (int o = 1; o < 64; o <<= 1) v += __shfl_xor(v, o);
    return v;
}
__device__ __forceinline__ float wave_max(float v) {
#pragma unroll
    for (int o = 1; o < 64; o <<= 1) v = fmaxf(v, __shfl_xor(v, o));
    return v;
}
#define LDS_FENCE() asm volatile("s_waitcnt lgkmcnt(0)" ::: "memory")

__device__ __forceinline__ void sincos_acc(float ang, float& c, float& s) {
    const double x = (double)ang;
    const double k = __builtin_rint(x * 0.63661977236758134308);
    double y = __builtin_fma(-k, 1.57079632679489655800, x);
    y = __builtin_fma(-k, 6.12323399573676603587e-17, y);
    const double y2 = y * y;
    double sp = -2.5052108385441718775e-08; sp = sp * y2 + 2.7557319223985890653e-06; sp = sp * y2 - 1.9841269841269841270e-04; sp = sp * y2 + 8.3333333333333332177e-03; sp = sp * y2 - 1.6666666666666665741e-01;
    const double sy = y + y * y2 * sp;
    double cp = 2.0876756987868098979e-09; cp = cp * y2 - 2.7557319223985888e-07; cp = cp * y2 + 2.4801587301587301566e-05; cp = cp * y2 - 1.3888888888888889419e-03; cp = cp * y2 + 4.1666666666666664354e-02; cp = cp * y2 - 0.5;
    const double cy = 1.0 + y2 * cp;
    const int q = ((int)k) & 3;
    const double sr = (q == 0) ? sy : (q == 1) ? cy : (q == 2) ? -sy : -cy;
    const double cr = (q == 0) ? cy : (q == 1) ? -sy : (q == 2) ? -cy : sy;
    c = (float)cr; s = (float)sr;
}
__device__ __forceinline__ float silu_f(float x) { return x / (1.f + __expf(-x)); }
__device__ __forceinline__ float sigmoid_f(float x) { return 1.f / (1.f + __expf(-x)); }
__device__ __forceinline__ float gelu_tanh_f(float x) { const float u = 0.7978845608028654f * (x + 0.044715f * x * x * x); return 0.5f * x * (1.f + tanhf(u)); }
__device__ __forceinline__ float ret_lg(int h) { return log1pf(-exp2f(-5.0f - (float)h)); }

__device__ __forceinline__ void wt_item(const float* W, int K, int N, h16* WT, const float* gain, int kind, int rowoff, float* scr, int item, int lane) {
    const int nblk = (N + 31) / 32, kb = item / nblk, nb = item % nblk, k0 = 64 * kb, n0 = 32 * nb;
    const int ncol = n0 + (lane & 31);
#pragma unroll 8
    for (int i = 0; i < 32; ++i) { const int kk = 2 * i + (lane >> 5); float v = 0.f; if (ncol < N) v = W[(size_t)(k0 + kk) * N + ncol]; if (gain) v *= gain[k0 + kk]; scr[kk * 33 + (lane & 31)] = v; }
    LDS_FENCE();
    const int c = lane & 7;
#pragma unroll
    for (int j = 0; j < 4; ++j) {
        const int nl = (lane >> 3) + 8 * j, n = n0 + nl; const float* s = scr + (8 * c) * 33 + nl;
        h16x8 o;
#pragma unroll
        for (int e = 0; e < 8; ++e) o[e] = (h16)s[e * 33];
        int row;
        if (kind == 0) row = rowoff + n;
        else if (kind == 3) row = (n < 2048) ? n : (n < 4096 ? n + 2048 : n - 2048);
        else if (kind == 4) { const int blk = n >> 8; const int tm = (blk == 3) ? 9 : (blk == 4) ? 3 : (blk == 5) ? 10 : blk; row = tm * 256 + (n & 255); }
        else { row = (n < DFF) ? (256 * (n >> 7) + (n & 127)) : (256 * ((n - DFF) >> 7) + 128 + ((n - DFF) & 127)); }
        if (n < N || kind == 2) *(h16x8*)(WT + (size_t)row * K + k0 + 8 * c) = o;
    }
    LDS_FENCE();
}
#define WT_JOB(r, W, K, N, WT, gain, kind, rowoff) { const int _ni = ((K) / 64) * (((N) + 31) / 32); if ((r) >= 0 && (r) < _ni) wt_item(W, K, N, WT, gain, kind, rowoff, scr, r, lane); (r) -= _ni; }

__device__ __forceinline__ void xn_row(const float* xrow, h16* orow, int lane) {
    f32x4 v[4]; float s = 0.f;
#pragma unroll
    for (int j = 0; j < 4; ++j) { v[j] = *(const f32x4*)(xrow + 4 * lane + 256 * j); s += v[j].x * v[j].x + v[j].y * v[j].y + v[j].z * v[j].z + v[j].w * v[j].w; }
    const float rstd = rsqrtf(wave_sum(s) * (1.f / D) + EPS);
#pragma unroll
    for (int j = 0; j < 4; ++j) { h16x4 o; o[0] = (h16)(v[j].x * rstd); o[1] = (h16)(v[j].y * rstd); o[2] = (h16)(v[j].z * rstd); o[3] = (h16)(v[j].w * rstd); *(h16x4*)(orow + 4 * lane + 256 * j) = o; }
}
__device__ __forceinline__ void res_norm_row(const float* xi, const float* mb, const float* gain, float* xo, h16* xn, int lane) {
    f32x4 a[4], r[4]; float s = 0.f;
#pragma unroll
    for (int j = 0; j < 4; ++j) { a[j] = *(const f32x4*)(mb + 4 * lane + 256 * j); r[j] = *(const f32x4*)(xi + 4 * lane + 256 * j); s += a[j].x * a[j].x + a[j].y * a[j].y + a[j].z * a[j].z + a[j].w * a[j].w; }
    const float rstd = rsqrtf(wave_sum(s) * (1.f / D) + EPS); float s2 = 0.f;
#pragma unroll
    for (int j = 0; j < 4; ++j) { const f32x4 g = *(const f32x4*)(gain + 4 * lane + 256 * j); r[j] = r[j] + a[j] * rstd * g; *(f32x4*)(xo + 4 * lane + 256 * j) = r[j]; s2 += r[j].x * r[j].x + r[j].y * r[j].y + r[j].z * r[j].z + r[j].w * r[j].w; }
    if (xn) {
        const float rs2 = rsqrtf(wave_sum(s2) * (1.f / D) + EPS);
#pragma unroll
        for (int j = 0; j < 4; ++j) { h16x4 o; o[0] = (h16)(r[j].x * rs2); o[1] = (h16)(r[j].y * rs2); o[2] = (h16)(r[j].z * rs2); o[3] = (h16)(r[j].w * rs2); *(h16x4*)(xn + 4 * lane + 256 * j) = o; }
    }
}

constexpr int CT_LD = 260;
template <class Epi>
__device__ __forceinline__ void ngemm(const h16* A, int lda, const h16* Bt, int K, int Mrows, int Ntiles, float* lds, const Epi& E) {
    float* As = lds; float* Bs = lds + 64 * 33; float* Ct = lds + 64 * 33 + 256 * 33;
    const int tid = threadIdx.x, ty = tid >> 5, tx = tid & 31;
    const int nunits = (Mrows / 64) * Ntiles;
    for (int u = blockIdx.x; u < nunits; u += gridDim.x) {
        const int um = u / Ntiles, un = u % Ntiles;
        float acc[4][8];
#pragma unroll
        for (int i = 0; i < 4; ++i)
#pragma unroll
            for (int j = 0; j < 8; ++j) acc[i][j] = 0.f;
        for (int k0 = 0; k0 < K; k0 += 32) {
            { const h16x4 v = *(const h16x4*)(A + (size_t)(um * 64 + (tid >> 3)) * lda + k0 + (tid & 7) * 4);
#pragma unroll
              for (int j = 0; j < 4; ++j) As[(tid >> 3) * 33 + (tid & 7) * 4 + j] = (float)v[j]; }
            { const h16* p = Bt + (size_t)(un * 256 + (tid >> 1)) * K + k0 + (tid & 1) * 16; const h16x8 v0 = *(const h16x8*)p, v1 = *(const h16x8*)(p + 8);
#pragma unroll
              for (int j = 0; j < 8; ++j) { Bs[(tid >> 1) * 33 + (tid & 1) * 16 + j] = (float)v0[j]; Bs[(tid >> 1) * 33 + (tid & 1) * 16 + 8 + j] = (float)v1[j]; } }
            __syncthreads();
#pragma unroll 4
            for (int kk = 0; kk < 32; ++kk) {
                float a[4], b[8];
#pragma unroll
                for (int i = 0; i < 4; ++i) a[i] = As[(ty * 4 + i) * 33 + kk];
#pragma unroll
                for (int j = 0; j < 8; ++j) b[j] = Bs[(tx + 32 * j) * 33 + kk];
#pragma unroll
                for (int i = 0; i < 4; ++i)
#pragma unroll
                    for (int j = 0; j < 8; ++j) acc[i][j] += a[i] * b[j];
            }
            __syncthreads();
        }
#pragma unroll
        for (int i = 0; i < 4; ++i)
#pragma unroll
            for (int j = 0; j < 8; ++j) Ct[(ty * 4 + i) * CT_LD + tx + 32 * j] = acc[i][j];
        __syncthreads();
        E(um, un, Ct);
        __syncthreads();
    }
}

struct EpiF32 { float* O; int ldc;
    __device__ __forceinline__ void operator()(int um, int un, const float* Ct) const {
        for (int idx = threadIdx.x; idx < 64 * 256; idx += NT) { const int r = idx >> 8, c = idx & 255; O[(size_t)(um * 64 + r) * ldc + un * 256 + c] = Ct[r * CT_LD + c]; } }
};
struct EpiSwiglu { h16* H;
    __device__ __forceinline__ void operator()(int um, int un, const float* Ct) const {
        for (int idx = threadIdx.x; idx < 64 * 128; idx += NT) { const int r = idx >> 7, c = idx & 127; H[(size_t)(um * 64 + r) * DFF + un * 128 + c] = (h16)(silu_f(Ct[r * CT_LD + c]) * Ct[r * CT_LD + c + 128]); } }
};
struct EpiCmp { h16* HC; const float* bias;
    __device__ __forceinline__ void operator()(int um, int un, const float* Ct) const {
        for (int idx = threadIdx.x; idx < 64 * 256; idx += NT) { const int r = idx >> 8, c = idx & 255; HC[(size_t)(um * 64 + r) * 256 + c] = (h16)gelu_tanh_f(Ct[r * CT_LD + c] + bias[c]); } }
};

__device__ __forceinline__ void n_ret_state(const h16* K0, const h16* VT, h16* SS) {
    const int tid = threadIdx.x, d = tid & 255, half = tid >> 8;
    for (int it = blockIdx.x; it < 8 * 128; it += gridDim.x) {
        const int bh = it >> 7, vq = it & 127, b = bh >> 2, h = bh & 3, c0 = vq * 4 + half * 2;
        const float gam = 1.f - exp2f(-5.f - (float)h);
        const h16* kp = K0 + (size_t)(b * T) * 1024 + h * 256 + d; const h16* vp = VT + ((size_t)b * 2048 + h * 512 + c0) * T;
        float s0 = 0.f, s1 = 0.f;
        for (int jb = 0; jb < (NSUP - 1) * SUP; jb += 8) {
            float kv[8], v0[8], v1[8];
#pragma unroll
            for (int e = 0; e < 8; ++e) { kv[e] = (float)kp[(size_t)(jb + e) * 1024]; v0[e] = (float)vp[jb + e]; v1[e] = (float)vp[(size_t)T + jb + e]; }
#pragma unroll
            for (int e = 0; e < 8; ++e) { s0 = gam * s0 + kv[e] * v0[e]; s1 = gam * s1 + kv[e] * v1[e]; }
            if (((jb + 8) & (SUP - 1)) == 0) { const int ms = (jb + 8) / SUP - 1; h16* sp = SS + (((size_t)bh * (NSUP - 1) + ms) * 512 + c0) * 256 + d; sp[0] = (h16)s0; sp[256] = (h16)s1; }
        }
    }
}
__device__ __forceinline__ void n_ret_out(const h16* Q0, const h16* K0, const h16* VT, const h16* G0, const h16* SS, const float* gn, h16* Y, float* lds) {
    const int tid = threadIdx.x, lane = tid & 63, wave = tid >> 6;
    float* qs = lds + wave * 768; float* sc = qs + 256;
    const int gw = blockIdx.x * 8 + wave, NGW = gridDim.x * 8;
    for (int it = gw; it < M * 4; it += NGW) {
        const int m = ((it >> 5) << 3) | (it & 7), h = (it >> 3) & 3, b = m >> 13, t = m & (T - 1), tl = t & (SUP - 1), s0 = t - tl, ms = t / SUP, bh = b * 4 + h;
        const float lgh = ret_lg(h);
        for (int i = lane; i < 256; i += 64) qs[i] = (float)Q0[(size_t)m * 1024 + h * 256 + i];
        LDS_FENCE();
        for (int jj = lane; jj <= tl; jj += 64) {
            const h16* kr = K0 + (size_t)(b * T + s0 + jj) * 1024 + h * 256; float dot = 0.f;
#pragma unroll 2
            for (int d = 0; d < 256; d += 8) { const h16x8 kv = *(const h16x8*)(kr + d);
#pragma unroll
                for (int e = 0; e < 8; ++e) dot += (float)kv[e] * qs[d + e]; }
            sc[jj] = dot * __expf(lgh * (float)(tl - jj));
        }
        LDS_FENCE();
        float o[8];
#pragma unroll
        for (int e = 0; e < 8; ++e) o[e] = 0.f;
        const h16* vb = VT + ((size_t)b * 2048 + h * 512 + lane * 8) * T + s0;
        for (int jj = 0; jj <= tl; ++jj) { const float s = sc[jj];
#pragma unroll
            for (int e = 0; e < 8; ++e) o[e] += s * (float)vb[(size_t)e * T + jj]; }
        if (ms > 0) {
            const h16* sp = SS + (((size_t)bh * (NSUP - 1) + ms - 1) * 512 + lane * 8) * 256; const float qd = __expf(lgh * (float)(tl + 1));
            float cr[8];
#pragma unroll
            for (int e = 0; e < 8; ++e) cr[e] = 0.f;
#pragma unroll 1
            for (int d = 0; d < 256; d += 8) {
#pragma unroll
                for (int e = 0; e < 8; ++e) { const h16x8 sv = *(const h16x8*)(sp + e * 256 + d);
#pragma unroll
                    for (int f = 0; f < 8; ++f) cr[e] += (float)sv[f] * qs[d + f]; } }
#pragma unroll
            for (int e = 0; e < 8; ++e) o[e] += qd * cr[e];
        }
        float s1 = 0.f;
#pragma unroll
        for (int e = 0; e < 8; ++e) s1 += o[e];
        const float mu = wave_sum(s1) * (1.f / DV); float s2 = 0.f;
#pragma unroll
        for (int e = 0; e < 8; ++e) { o[e] -= mu; s2 += o[e] * o[e]; }
        const float rstd = rsqrtf(wave_sum(s2) * (1.f / DV) + EPS);
        const h16x8 gv = *(const h16x8*)(G0 + (size_t)m * 2048 + h * 512 + lane * 8); h16x8 yo;
#pragma unroll
        for (int e = 0; e < 8; ++e) yo[e] = (h16)(silu_f((float)gv[e]) * o[e] * rstd * gn[h * 512 + lane * 8 + e]);
        *(h16x8*)(Y + (size_t)m * 2048 + h * 512 + lane * 8) = yo;
        LDS_FENCE();
    }
}

__device__ __forceinline__ void dots4(const h16* krow, const float* qs, float (&dt)[4]) {
#pragma unroll
    for (int r = 0; r < 4; ++r) dt[r] = 0.f;
#pragma unroll
    for (int c = 0; c < 8; ++c) { const h16x8 kv = *(const h16x8*)(krow + 8 * c);
#pragma unroll
        for (int r = 0; r < 4; ++r)
#pragma unroll
            for (int e = 0; e < 8; ++e) dt[r] += (float)kv[e] * qs[r * 64 + 8 * c + e]; }
}
__device__ __forceinline__ void softmax4(float* sc, int n, int lane) {
    for (int r = 0; r < 4; ++r) {
        float mx = -INFINITY; for (int i = lane; i < n; i += 64) mx = fmaxf(mx, sc[r * 1024 + i]);
        mx = wave_max(mx); float sum = 0.f;
        for (int i = lane; i < n; i += 64) { const float e = __expf(sc[r * 1024 + i] - mx); sc[r * 1024 + i] = e; sum += e; }
        sum = wave_sum(sum); const float inv = 1.f / sum;
        for (int i = lane; i < n; i += 64) sc[r * 1024 + i] *= inv;
    }
    LDS_FENCE();
}
__device__ __forceinline__ int select_blocks(float imp0, float imp1, int cur, int* sel, int lane) {
    int nsel = 0;
    if (lane == 0) { sel[0] = 0; }
    nsel = 1;
    if (cur >= 1) { if (lane == 0) sel[nsel] = cur; ++nsel; }
    if (cur >= 2) { if (lane == 0) sel[nsel] = cur - 1; ++nsel; }
    const int sA = lane, sB = lane + 64;
    float v0 = (sA <= cur && sA != 0 && sA != cur && sA != cur - 1) ? imp0 : -INFINITY;
    float v1 = (sB <= cur && sB != 0 && sB != cur && sB != cur - 1) ? imp1 : -INFINITY;
    while (nsel < 16) {
        const float mx = wave_max(fmaxf(v0, v1));
        if (mx == -INFINITY) break;
        const unsigned long long b0 = __ballot(v0 == mx);
        int s;
        if (b0) { const int l = __ffsll((long long)b0) - 1; s = l; if (lane == l) v0 = -INFINITY; }
        else { const unsigned long long b1 = __ballot(v1 == mx); const int l = __ffsll((long long)b1) - 1; s = l + 64; if (lane == l) v1 = -INFINITY; }
        if (lane == 0) sel[nsel] = s;
        ++nsel;
    }
    LDS_FENCE();
    return nsel;
}
__device__ __forceinline__ void n_nsa_attn(const h16* QN, const h16* KV6, const h16* CK, const h16* CV, const float* GATES, h16* O1, float* lds) {
    const int tid = threadIdx.x, lane = tid & 63, wave = tid >> 6;
    float* qs = lds + wave * 4480; float* sc = qs + 256; int* sel = (int*)(sc + 4096);
    const h16 *KS = KV6 + 2 * (size_t)(8 * T * 64), *KW = KV6 + 3 * (size_t)(8 * T * 64), *VST = KV6 + 4 * (size_t)(8 * T * 64), *VWT = KV6 + 5 * (size_t)(8 * T * 64);
    const int gw = blockIdx.x * 8 + wave, NGW = gridDim.x * 8;
    for (int it = gw; it < M * 4; it += NGW) {
        const int m = it >> 2, g = it & 3, b = m >> 13, t = m & (T - 1), bg = b * 4 + g;
        for (int i = lane; i < 256; i += 64) qs[i] = (float)QN[(size_t)m * 1024 + g * 256 + i];
        LDS_FENCE();
        const int nv = (t >= 31) ? ((t - 31) >> 4) + 1 : 0;
        float oc[4] = {0.f, 0.f, 0.f, 0.f};
        if (nv > 0) {
            for (int n = lane; n < nv; n += 64) { float dt[4]; dots4(CK + ((size_t)bg * NCP + n) * 64, qs, dt);
#pragma unroll
                for (int r = 0; r < 4; ++r) sc[r * 1024 + n] = dt[r]; }
            LDS_FENCE();
            softmax4(sc, nv, lane);
            for (int n = 0; n < nv; ++n) { const float vv = (float)CV[((size_t)bg * 64 + lane) * 512 + n];
#pragma unroll
                for (int r = 0; r < 4; ++r) oc[r] += sc[r * 1024 + n] * vv; }
        }
        float imp[2];
#pragma unroll
        for (int q = 0; q < 2; ++q) { const int s = lane + 64 * q; float a = 0.f;
#pragma unroll
            for (int e = -1; e < 4; ++e) { const int n = 4 * s + e; if (n >= 0 && n < nv) { const float p = sc[n] + sc[1024 + n] + sc[2048 + n] + sc[3072 + n]; a += (e == -1 || e == 3) ? p : 2.f * p; } }
            imp[q] = a; }
        LDS_FENCE();
        const int cur = t >> 6;
        const int nsel = select_blocks(imp[0], imp[1], cur, sel, lane);
        float os[4] = {0.f, 0.f, 0.f, 0.f};
        for (int i2 = 0; i2 < nsel; ++i2) { const int tok = sel[i2] * 64 + lane; float dt[4]; dots4(KS + ((size_t)bg * T + tok) * 64, qs, dt);
#pragma unroll
            for (int r = 0; r < 4; ++r) sc[r * 1024 + i2 * 64 + lane] = (tok <= t) ? dt[r] : -INFINITY; }
        LDS_FENCE();
        softmax4(sc, nsel * 64, lane);
        for (int kk = 0; kk < nsel * 64; ++kk) { const int tok = sel[kk >> 6] * 64 + (kk & 63); const float vv = (float)VST[((size_t)bg * 64 + lane) * T + tok];
#pragma unroll
            for (int r = 0; r < 4; ++r) os[r] += sc[r * 1024 + kk] * vv; }
        LDS_FENCE();
        float ow[4] = {0.f, 0.f, 0.f, 0.f};
        const int nw = (t + 1 < 512) ? t + 1 : 512, t0 = t - nw + 1;
        for (int i = lane; i < nw; i += 64) { float dt[4]; dots4(KW + ((size_t)bg * T + t0 + i) * 64, qs, dt);
#pragma unroll
            for (int r = 0; r < 4; ++r) sc[r * 1024 + i] = dt[r]; }
        LDS_FENCE();
        softmax4(sc, nw, lane);
        for (int i = 0; i < nw; ++i) { const float vv = (float)VWT[((size_t)bg * 64 + lane) * T + t0 + i];
#pragma unroll
            for (int r = 0; r < 4; ++r) ow[r] += sc[r * 1024 + i] * vv; }
        LDS_FENCE();
#pragma unroll
        for (int r = 0; r < 4; ++r) { const float* gp = GATES + (size_t)m * 48 + (g * 4 + r) * 3;
            O1[(size_t)m * 1024 + (g * 4 + r) * 64 + lane] = (h16)(gp[0] * oc[r] + gp[1] * os[r] + gp[2] * ow[r]); }
    }
}

#define LAS __attribute__((address_space(3)))
#define XB_TMO      128
#define XB_XCNT(j)  (256  + 64 * (j))
#define XB_XSUB(j)  (1280 + 64 * (j))
#define XB_XGEN(j)  (2304 + 64 * (j))
#define XB_TOP      3328
#define XB_TOPGEN   3392
#define XCD_BAR_WORDS 3456
#define XB_SPIN_CAP (1u << 18)
__device__ __forceinline__ unsigned xb_ld(unsigned* p)              { return __hip_atomic_load(p, __ATOMIC_RELAXED, __HIP_MEMORY_SCOPE_AGENT); }
__device__ __forceinline__ unsigned xb_add(unsigned* p, unsigned v) { return __hip_atomic_fetch_add(p, v, __ATOMIC_RELAXED, __HIP_MEMORY_SCOPE_AGENT); }
__device__ __forceinline__ unsigned xb_xcc_id() { return (unsigned)__builtin_amdgcn_s_getreg((3 << 11) | 20) & 0xFu; }
#define XB_SPIN(cond, bar) do { unsigned _sp = 0; while (cond) { __builtin_amdgcn_s_sleep(1); \
    if ((++_sp & 255u) == 0u) { if (xb_ld(&(bar)[XB_TMO])) break; if (_sp > XB_SPIN_CAP) { atomicAdd(&(bar)[XB_TMO], 1u); break; } } } } while (0)
struct XcdBarrier { unsigned* bar; unsigned x; volatile LAS unsigned* st; };
__device__ __forceinline__ XcdBarrier xcd_barrier_post(unsigned* bar, volatile LAS unsigned* st) {
    XcdBarrier b; b.bar = bar; b.x = xb_xcc_id(); b.st = st;
    if (threadIdx.x == 0) (void)xb_add(&bar[XB_XCNT(b.x)], 1u);
    return b;
}
__device__ __forceinline__ void xcd_barrier_complete(unsigned* bar, unsigned x, unsigned& nloc, unsigned& nx) {
    const unsigned G = gridDim.x * gridDim.y * gridDim.z;
    unsigned sum, cnt, mine, sp = 0u;
    for (;;) {
        sum = 0u; cnt = 0u; mine = 0u;
#pragma unroll
        for (unsigned j = 0; j < 16; ++j) { const unsigned c = xb_ld(&bar[XB_XCNT(j)]); sum += c; cnt += (c > 0u) ? 1u : 0u; mine = (j == x) ? c : mine; }
        if (sum == G) break;
        __builtin_amdgcn_s_sleep(1);
        if ((++sp & 255u) == 0u) { if (xb_ld(&bar[XB_TMO])) break; if (sp > XB_SPIN_CAP) { atomicAdd(&bar[XB_TMO], 1u); break; } }
    }
    nloc = mine > 0u ? mine : 1u; nx = cnt > 0u ? cnt : 1u;
}
__device__ __forceinline__ void xcd_barrier(const XcdBarrier& b) {
    asm volatile("s_waitcnt vmcnt(0)" ::: "memory");
    __syncthreads();
    if (threadIdx.x == 0) {
        unsigned* bar = b.bar;
        __builtin_amdgcn_s_waitcnt(0);
        unsigned nloc = b.st[0], nx = b.st[1];
        if (nloc == 0u) { xcd_barrier_complete(bar, b.x, nloc, nx); b.st[0] = nloc; b.st[1] = nx; }
        const unsigned old = xb_add(&bar[XB_XSUB(b.x)], 1u);
        const unsigned gen = old / nloc;
        if (old + 1u == (gen + 1u) * nloc) {
            __builtin_amdgcn_fence(__ATOMIC_RELEASE, "agent");
            asm volatile("s_waitcnt vmcnt(0)" ::: "memory");
            const unsigned og = xb_add(&bar[XB_TOP], 1u);
            const unsigned tg = og / nx;
            if (og + 1u == (tg + 1u) * nx) xb_add(&bar[XB_TOPGEN], 1u);
            else XB_SPIN(xb_ld(&bar[XB_TOPGEN]) == tg, bar);
            __builtin_amdgcn_fence(__ATOMIC_ACQUIRE, "agent");
            xb_add(&bar[XB_XGEN(b.x)], 1u);
            asm volatile("s_waitcnt vmcnt(0)" ::: "memory");
        } else {
            XB_SPIN(xb_ld(&bar[XB_XGEN(b.x)]) == gen, bar);
            __builtin_amdgcn_fence(__ATOMIC_ACQUIRE, "agent");
            asm volatile("s_waitcnt vmcnt(0)" ::: "memory");
        }
    }
    __syncthreads();
}

namespace pg8 {
typedef float f32x4 __attribute__((ext_vector_type(4)));
typedef unsigned u32x4 __attribute__((ext_vector_type(4)));
constexpr int BM = 256, BK = 64, HALF = 128, HTB = HALF * BK * 2, STAGE_BYTES = 8 * HTB, NXCD = 8, WGM = 8;
__host__ __device__ __forceinline__ int lds_byte(int r, int c) { const int st = (r >> 4) * 2 + (c >> 5), rr = r & 15, cc = c & 31, ob = rr * 64 + cc * 2; return st * 1024 + (ob ^ (((ob >> 9) & 1) << 5)); }
__host__ __device__ __forceinline__ void stage_rc(int b, int& R, int& C) { const int st = b / 1024, sb = b % 1024, swz = sb ^ (((sb >> 9) & 1) << 5); R = (st >> 1) * 16 + swz / 64; C = (st & 1) * 32 + (swz % 64) / 2; }
__host__ __device__ __forceinline__ int perm32(int rho) { const int n = rho >> 4, i = rho & 15; return 8 * (i >> 2) + 4 * n + (i & 3); }
struct Unit { int pm, pn; };
struct Gemm { const h16* A; const h16* Bt; int M, N, K, lda; };
struct StaticOrder {
    int nM, nN, nwg, G, c;
    __host__ __device__ void init(int M, int N, int G_, int c_) { nM = M / BM; nN = N / BM; nwg = nM * nN; G = G_; c = c_; }
    __host__ __device__ bool next(int i, Unit& u) const {
        const long L = (long)i * G + c; if (L >= nwg) return false;
        int wgid = (int)L; { const int q = nwg / NXCD, r = nwg % NXCD, xcd = wgid % NXCD, off = wgid / NXCD; wgid = (xcd < r ? xcd * (q + 1) : r * (q + 1) + (xcd - r) * q) + off; }
        const int nig = WGM * nN, gid = wgid / nig, fm = gid * WGM, gsz = (nM - fm) < WGM ? (nM - fm) : WGM;
        u.pm = fm + ((wgid % nig) % gsz); u.pn = (wgid % nig) / gsz; return true;
    }
};
template <class Epi, class Sched, bool ALIGN_EPI, bool SP2, bool SWAP = false>
__device__ __forceinline__ void gemm_phase(LAS unsigned char* lds, const Gemm g, const Sched& S, const Epi& E) {
    const int tid = threadIdx.x, wid = __builtin_amdgcn_readfirstlane(tid >> 6), lane = tid & 63, wr = wid >> 2, wc = wid & 3, fr = lane & 15, fq = lane >> 4;
    const int K = g.K, nt = K / BK, lda = g.lda;
    unsigned voffA[2], voffB[2];
#pragma unroll
    for (int i = 0; i < 2; ++i) { int R, C; stage_rc(tid * 16 + i * 8192, R, C); const int Rb = Epi::PERM ? ((R & ~31) + perm32(R & 31)) : R;
        voffA[i] = (unsigned)(R * lda + C) * 2u; voffB[i] = (unsigned)(Rb * K + C) * 2u; }
    const size_t kstep = (size_t)(BK * 2);
    const size_t hstepA = (size_t)HALF * lda * 2, hstepB = (size_t)HALF * K * 2;
    const size_t tstepA = 2 * hstepA, tstepB = 2 * hstepB;
    const unsigned ldsw = (unsigned)wid * 1024u;
    const int aoff = lds_byte(wr * 64 + fr, fq * 8), boff = lds_byte(wc * 32 + fr, fq * 8);
#define PG8_SA(b, h) (((b) * 2 + (h)) * HTB)
#define PG8_SB(b, h) ((4 + (b) * 2 + (h)) * HTB)
#define PG8_STAGE(bufoff, gbase, voff) do { _Pragma("unroll") for (int _i = 0; _i < 2; ++_i) \
        __builtin_amdgcn_global_load_lds((const unsigned*)((const char*)(gbase) + (voff)[_i]), (LAS unsigned*)(lds + (bufoff) + ldsw + _i * 8192), 16, 0, 0); } while (0)
#define PG8_LDA(dst, b, h) do { _Pragma("unroll") for (int m = 0; m < 4; ++m) _Pragma("unroll") for (int k = 0; k < 2; ++k) dst[m][k] = *(const LAS h16x8*)(lds + PG8_SA(b, h) + aoff + m * 2048 + k * 1024); } while (0)
#define PG8_LDB(dst, b, h) do { _Pragma("unroll") for (int n = 0; n < 2; ++n) _Pragma("unroll") for (int k = 0; k < 2; ++k) dst[n][k] = *(const LAS h16x8*)(lds + PG8_SB(b, h) + boff + n * 2048 + k * 1024); } while (0)
#define PG8_MMA(ai, bj, At, Bt) do { __builtin_amdgcn_s_setprio(1); _Pragma("unroll") for (int m = 0; m < 4; ++m) _Pragma("unroll") for (int n = 0; n < 2; ++n) _Pragma("unroll") for (int k = 0; k < 2; ++k) \
        acc[ai][bj][m][n] = SWAP ? __builtin_amdgcn_mfma_f32_16x16x32_f16(At[m][k], Bt[n][k], acc[ai][bj][m][n], 0, 0, 0) : __builtin_amdgcn_mfma_f32_16x16x32_f16(Bt[n][k], At[m][k], acc[ai][bj][m][n], 0, 0, 0); __builtin_amdgcn_s_setprio(0); } while (0)
#define PG8_WAIT_V(n) asm volatile("s_waitcnt vmcnt(" #n ")" ::: "memory")
#define PG8_WAIT_L(n) asm volatile("s_waitcnt lgkmcnt(" #n ")" ::: "memory")
#define PG8_BAR __builtin_amdgcn_s_barrier()
#define PG8_SCHED __builtin_amdgcn_sched_barrier(0)
    Unit cur, nxt; int ui = 0;
    if (!S.next(0, cur)) return;
    f32x4 acc[2][2][4][2];
#pragma unroll
    for (int a = 0; a < 2; ++a)
#pragma unroll
        for (int b = 0; b < 2; ++b)
#pragma unroll
            for (int m = 0; m < 4; ++m)
#pragma unroll
                for (int n = 0; n < 2; ++n) acc[a][b][m][n] = (f32x4){0.f, 0.f, 0.f, 0.f};
    h16x8 At[4][2], B0[2][2], B1[2][2];
    const char* cA = (const char*)g.A + (size_t)cur.pm * tstepA; const char* cB = (const char*)g.Bt + (size_t)cur.pn * tstepB;
    if constexpr (SP2) {
        PG8_STAGE(PG8_SB(0, 0), cB, voffB); PG8_STAGE(PG8_SB(0, 1), cB + hstepB, voffB); PG8_STAGE(PG8_SA(0, 0), cA, voffA); PG8_STAGE(PG8_SA(0, 1), cA + hstepA, voffA);
        if (wr == 1) PG8_BAR;
        PG8_WAIT_V(2); PG8_BAR;
        PG8_STAGE(PG8_SB(1, 0), cB + kstep, voffB); PG8_STAGE(PG8_SA(1, 0), cA + kstep, voffA); PG8_STAGE(PG8_SB(1, 1), cB + hstepB + kstep, voffB);
        PG8_WAIT_V(6); PG8_BAR;
    } else {
        PG8_STAGE(PG8_SB(0, 0), cB, voffB); PG8_STAGE(PG8_SA(0, 0), cA, voffA); PG8_STAGE(PG8_SB(0, 1), cB + hstepB, voffB); PG8_STAGE(PG8_SA(0, 1), cA + hstepA, voffA);
        if (wr == 1) PG8_BAR;
        PG8_WAIT_V(4); PG8_BAR;
        PG8_STAGE(PG8_SB(1, 0), cB + kstep, voffB); PG8_STAGE(PG8_SA(1, 0), cA + kstep, voffA); PG8_STAGE(PG8_SB(1, 1), cB + hstepB + kstep, voffB);
        PG8_WAIT_V(6); PG8_BAR;
    }
    for (;;) {
        const bool has_next = S.next(ui + 1, nxt);
        const char* nA = has_next ? (const char*)g.A + (size_t)nxt.pm * tstepA : cA; const char* nB = has_next ? (const char*)g.Bt + (size_t)nxt.pn * tstepB : cB;
        for (int t = 0; t < nt; t += 2) {
            const bool last = (t == nt - 2);
            const char* a1 = cA + (size_t)(t + 1) * kstep;
            const char* a2 = last ? nA : cA + (size_t)(t + 2) * kstep; const char* b2 = last ? nB : cB + (size_t)(t + 2) * kstep;
            const char* a3 = a2 + kstep; const char* b3 = b2 + kstep;
            if constexpr (SP2) {
            PG8_LDB(B0, 0, 0); PG8_LDB(B1, 0, 1); PG8_SCHED; PG8_LDA(At, 0, 0); PG8_STAGE(PG8_SA(1, 1), a1 + hstepA, voffA);
            PG8_WAIT_V(8); PG8_WAIT_L(0); PG8_BAR; PG8_MMA(0, 0, At, B0); PG8_MMA(0, 1, At, B1); PG8_BAR; PG8_SCHED;
            PG8_LDA(At, 0, 1); PG8_STAGE(PG8_SB(0, 0), b2, voffB); PG8_STAGE(PG8_SB(0, 1), b2 + hstepB, voffB); PG8_STAGE(PG8_SA(0, 0), a2, voffA);
            PG8_WAIT_V(8); PG8_WAIT_L(0); PG8_BAR; PG8_MMA(1, 0, At, B0); PG8_MMA(1, 1, At, B1); PG8_BAR; PG8_SCHED;
            PG8_LDB(B0, 1, 0); PG8_LDB(B1, 1, 1); PG8_SCHED; PG8_LDA(At, 1, 0); PG8_STAGE(PG8_SA(0, 1), a2 + hstepA, voffA);
            PG8_WAIT_V(8); PG8_WAIT_L(0); PG8_BAR; PG8_MMA(0, 0, At, B0); PG8_MMA(0, 1, At, B1); PG8_BAR; PG8_SCHED;
            PG8_LDA(At, 1, 1); PG8_STAGE(PG8_SB(1, 0), b3, voffB); PG8_STAGE(PG8_SB(1, 1), b3 + hstepB, voffB); PG8_STAGE(PG8_SA(1, 0), a3, voffA);
            PG8_WAIT_V(8); PG8_WAIT_L(0); PG8_BAR; PG8_MMA(1, 0, At, B0); PG8_MMA(1, 1, At, B1); PG8_BAR; PG8_SCHED;
            } else {
            PG8_LDB(B0, 0, 0); PG8_SCHED; PG8_LDA(At, 0, 0); PG8_STAGE(PG8_SA(1, 1), a1 + hstepA, voffA);
            PG8_WAIT_L(8); PG8_BAR; PG8_WAIT_L(0); PG8_MMA(0, 0, At, B0); PG8_BAR; PG8_SCHED;
            PG8_LDB(B1, 0, 1); PG8_STAGE(PG8_SB(0, 0), b2, voffB);
            PG8_BAR; PG8_WAIT_L(0); PG8_MMA(0, 1, At, B1); PG8_BAR;
            PG8_LDA(At, 0, 1); PG8_STAGE(PG8_SA(0, 0), a2, voffA);
            PG8_BAR; PG8_WAIT_L(0); PG8_MMA(1, 0, At, B0); PG8_BAR; PG8_SCHED;
            PG8_STAGE(PG8_SB(0, 1), b2 + hstepB, voffB);
            PG8_WAIT_V(6); PG8_BAR; PG8_MMA(1, 1, At, B1); PG8_BAR;
            PG8_LDB(B0, 1, 0); PG8_SCHED; PG8_LDA(At, 1, 0); PG8_STAGE(PG8_SA(0, 1), a2 + hstepA, voffA);
            PG8_WAIT_L(8); PG8_BAR; PG8_WAIT_L(0); PG8_MMA(0, 0, At, B0); PG8_BAR; PG8_SCHED;
            PG8_LDB(B1, 1, 1); PG8_STAGE(PG8_SB(1, 0), b3, voffB);
            PG8_BAR; PG8_WAIT_L(0); PG8_MMA(0, 1, At, B1); PG8_BAR;
            PG8_LDA(At, 1, 1); PG8_STAGE(PG8_SA(1, 0), a3, voffA);
            PG8_BAR; PG8_WAIT_L(0); PG8_MMA(1, 0, At, B0); PG8_BAR; PG8_SCHED;
            PG8_STAGE(PG8_SB(1, 1), b3 + hstepB, voffB);
            PG8_WAIT_V(6); PG8_BAR; PG8_MMA(1, 1, At, B1); PG8_BAR;
            }
        }
        if constexpr (ALIGN_EPI) { if (wr == 0) PG8_BAR; }
        E(acc, cur, wr, wc, fr, fq);
        if (!has_next) break;
#pragma unroll
        for (int a = 0; a < 2; ++a)
#pragma unroll
            for (int b = 0; b < 2; ++b)
#pragma unroll
                for (int m = 0; m < 4; ++m)
#pragma unroll
                    for (int n = 0; n < 2; ++n) acc[a][b][m][n] = (f32x4){0.f, 0.f, 0.f, 0.f};
        cur = nxt; cA = nA; cB = nB; ++ui;
        if constexpr (ALIGN_EPI) { if (wr == 1) PG8_BAR; }
    }
    PG8_WAIT_V(0);
    if constexpr (!ALIGN_EPI) { if (wr == 0) PG8_BAR; }
    PG8_BAR;
#undef PG8_SA
#undef PG8_SB
#undef PG8_STAGE
#undef PG8_LDA
#undef PG8_LDB
#undef PG8_MMA
#undef PG8_WAIT_V
#undef PG8_WAIT_L
#undef PG8_BAR
#undef PG8_SCHED
}
__device__ __forceinline__ u32x4 pack8(const f32x4& a, const f32x4& b) {
    h16x8 o; o[0] = (h16)a[0]; o[1] = (h16)a[1]; o[2] = (h16)a[2]; o[3] = (h16)a[3]; o[4] = (h16)b[0]; o[5] = (h16)b[1]; o[6] = (h16)b[2]; o[7] = (h16)b[3];
    return __builtin_bit_cast(u32x4, o);
}
typedef f32x4 AccT[2][2][4][2];

struct EpiRetInF {
    static constexpr bool PERM = true;
    h16 *Q0, *K0, *KT, *G0; const float *RC, *RS;
    __device__ __forceinline__ void operator()(const AccT& acc, const Unit& u, int wr, int wc, int fr, int fq) const {
        const int row0 = u.pm * BM + wr * 64 + fr, c0 = wc * 32 + 8 * fq;
        if (u.pn < 8) {
            const bool isk = u.pn >= 4; const int hh = u.pn & 3; h16* dst = (isk ? K0 : Q0) + hh * 256; const float sc = isk ? 0.0625f : 1.f;
#pragma unroll
            for (int ai = 0; ai < 2; ++ai)
#pragma unroll
                for (int m = 0; m < 4; ++m) { const int row = row0 + ai * HALF + m * 16, t = row & (T - 1), b = row >> 13;
                    const f32x4 cs0 = *(const f32x4*)(RC + t * 128 + c0), cs1 = *(const f32x4*)(RC + t * 128 + c0 + 4), sn0 = *(const f32x4*)(RS + t * 128 + c0), sn1 = *(const f32x4*)(RS + t * 128 + c0 + 4);
                    const f32x4 x10 = acc[ai][0][m][0], x11 = acc[ai][0][m][1], x20 = acc[ai][1][m][0], x21 = acc[ai][1][m][1];
                    const f32x4 a0 = (x10 * cs0 - x20 * sn0) * sc, a1 = (x11 * cs1 - x21 * sn1) * sc, b0 = (x10 * sn0 + x20 * cs0) * sc, b1 = (x11 * sn1 + x21 * cs1) * sc;
                    h16* rp = dst + (size_t)row * 1024 + c0;
                    *(u32x4*)rp = pack8(a0, a1); *(u32x4*)(rp + 128) = pack8(b0, b1);
                    if (isk) { h16* kt = KT + ((size_t)(b * 4 + hh) * 256 + c0) * T + t;
#pragma unroll
                        for (int e = 0; e < 4; ++e) { kt[(size_t)e * T] = (h16)a0[e]; kt[(size_t)(e + 4) * T] = (h16)a1[e]; kt[(size_t)(e + 128) * T] = (h16)b0[e]; kt[(size_t)(e + 132) * T] = (h16)b1[e]; } } }
        } else {
            h16* dst = G0 + (u.pn - 8) * 256;
#pragma unroll
            for (int ai = 0; ai < 2; ++ai)
#pragma unroll
                for (int m = 0; m < 4; ++m) { h16* rp = dst + (size_t)(row0 + ai * HALF + m * 16) * 2048 + c0;
#pragma unroll
                    for (int bj = 0; bj < 2; ++bj) *(u32x4*)(rp + bj * HALF) = pack8(acc[ai][bj][m][0], acc[ai][bj][m][1]); }
        }
    }
};
struct EpiVT {
    static constexpr bool PERM = false;
    h16* dst; int ncols; size_t tile_stride;
    __device__ __forceinline__ void operator()(const AccT& acc, const Unit& u, int wr, int wc, int fr, int fq) const {
#pragma unroll
        for (int ai = 0; ai < 2; ++ai)
#pragma unroll
            for (int m = 0; m < 4; ++m) { const int tok = u.pm * BM + ai * HALF + wr * 64 + m * 16 + 4 * fq, b = tok >> 13, t = tok & (T - 1);
#pragma unroll
                for (int bj = 0; bj < 2; ++bj)
#pragma unroll
                    for (int n = 0; n < 2; ++n) { const int col = bj * HALF + wc * 32 + n * 16 + fr; const f32x4 v = acc[ai][bj][m][n];
                        h16x4 o; o[0] = (h16)v[0]; o[1] = (h16)v[1]; o[2] = (h16)v[2]; o[3] = (h16)v[3];
                        *(h16x4*)(dst + (size_t)u.pn * tile_stride + ((size_t)b * ncols + col) * T + t) = o; } }
    }
};
struct EpiF32F { static constexpr bool PERM = true; float* O; int ldc;
    __device__ __forceinline__ void operator()(const AccT& acc, const Unit& u, int wr, int wc, int fr, int fq) const {
        const int row0 = u.pm * BM + wr * 64 + fr, c0 = u.pn * BM + wc * 32 + 8 * fq;
#pragma unroll
        for (int ai = 0; ai < 2; ++ai)
#pragma unroll
            for (int m = 0; m < 4; ++m) { float* rp = O + (size_t)(row0 + ai * HALF + m * 16) * ldc + c0;
#pragma unroll
                for (int bj = 0; bj < 2; ++bj) { *(f32x4*)(rp + bj * HALF) = acc[ai][bj][m][0]; *(f32x4*)(rp + bj * HALF + 4) = acc[ai][bj][m][1]; } }
    }
};
struct EpiSwigluF { static constexpr bool PERM = true; h16* H;
    __device__ __forceinline__ void operator()(const AccT& acc, const Unit& u, int wr, int wc, int fr, int fq) const {
        const int row0 = u.pm * BM + wr * 64 + fr, c0 = u.pn * 128 + wc * 32 + 8 * fq;
#pragma unroll
        for (int ai = 0; ai < 2; ++ai)
#pragma unroll
            for (int m = 0; m < 4; ++m) { f32x4 o[2];
#pragma unroll
                for (int n = 0; n < 2; ++n)
#pragma unroll
                    for (int e = 0; e < 4; ++e) o[n][e] = silu_f(acc[ai][0][m][n][e]) * acc[ai][1][m][n][e];
                *(u32x4*)(H + (size_t)(row0 + ai * HALF + m * 16) * DFF + c0) = pack8(o[0], o[1]); }
    }
};
struct EpiKvqF {
    static constexpr bool PERM = true;
    h16* KV6; h16* QN; float* GATES; const float *NC, *NS;
    __device__ __forceinline__ void operator()(const AccT& acc, const Unit& u, int wr, int wc, int fr, int fq) const {
        const int row0 = u.pm * BM + wr * 64 + fr;
        const int pn = u.pn;
        if (pn == 8) {
            if (wc < 2) {
#pragma unroll
                for (int ai = 0; ai < 2; ++ai)
#pragma unroll
                    for (int m = 0; m < 4; ++m) { const int row = row0 + ai * HALF + m * 16; const int c = wc * 32 + 8 * fq;
                        if (c < 48) { f32x4 o0, o1;
#pragma unroll
                            for (int e = 0; e < 4; ++e) { o0[e] = sigmoid_f(acc[ai][0][m][0][e]); o1[e] = sigmoid_f(acc[ai][0][m][1][e]); }
                            *(f32x4*)(GATES + (size_t)row * 48 + c) = o0; *(f32x4*)(GATES + (size_t)row * 48 + c + 4) = o1; } }
            }
            return;
        }
        const bool rot = (pn != 1);
        const bool rlane = rot && ((wc & 1) == 0);
        const float sc = (pn >= 4) ? 0.125f : 1.f;
#pragma unroll
        for (int ai = 0; ai < 2; ++ai)
#pragma unroll
            for (int m = 0; m < 4; ++m) { const int row = row0 + ai * HALF + m * 16, t = row & (T - 1), b = row >> 13;
#pragma unroll
                for (int bj = 0; bj < 2; ++bj) { f32x4 v0 = acc[ai][bj][m][0], v1 = acc[ai][bj][m][1];
                    if (rlane) {
                        f32x4 p0, p1;
#pragma unroll
                        for (int e = 0; e < 4; ++e) { p0[e] = __shfl_xor(v0[e], 16); p1[e] = __shfl_xor(v1[e], 16); }
                        if (fq < 2) { const f32x4 cs0 = *(const f32x4*)(NC + t * 8), cs1 = *(const f32x4*)(NC + t * 8 + 4), sn0 = *(const f32x4*)(NS + t * 8), sn1 = *(const f32x4*)(NS + t * 8 + 4);
                            if (fq == 0) { v0 = v0 * cs0 - p0 * sn0; v1 = v1 * cs1 - p1 * sn1; } else { v0 = p0 * sn0 + v0 * cs0; v1 = p1 * sn1 + v1 * cs1; } }
                    }
                    v0 = v0 * sc; v1 = v1 * sc;
                    const int c = bj * HALF + wc * 32 + 8 * fq;
                    if (pn < 4) { const int g = c >> 6, d = c & 63; *(u32x4*)(KV6 + (size_t)pn * (8u * T * 64) + ((size_t)(b * 4 + g) * T + t) * 64 + d) = pack8(v0, v1); }
                    else *(u32x4*)(QN + (size_t)row * 1024 + (pn - 4) * 256 + c) = pack8(v0, v1); } }
    }
};
struct EpiCmpF { static constexpr bool PERM = true; h16* HC; const float* bias;
    __device__ __forceinline__ void operator()(const AccT& acc, const Unit& u, int wr, int wc, int fr, int fq) const {
        const int row0 = u.pm * BM + wr * 64 + fr;
#pragma unroll
        for (int bj = 0; bj < 2; ++bj) { const int c = bj * HALF + wc * 32 + 8 * fq; const f32x4 b0 = *(const f32x4*)(bias + c), b1 = *(const f32x4*)(bias + c + 4);
#pragma unroll
            for (int ai = 0; ai < 2; ++ai)
#pragma unroll
                for (int m = 0; m < 4; ++m) { f32x4 o0, o1;
#pragma unroll
                    for (int e = 0; e < 4; ++e) { o0[e] = gelu_tanh_f(acc[ai][bj][m][0][e] + b0[e]); o1[e] = gelu_tanh_f(acc[ai][bj][m][1][e] + b1[e]); }
                    *(u32x4*)(HC + (size_t)(row0 + ai * HALF + m * 16) * 256 + c) = pack8(o0, o1); } }
    }
};
}

#define MFMA16(a, b, c) __builtin_amdgcn_mfma_f32_16x16x32_f16((a), (b), (c), 0, 0, 0)
__device__ __forceinline__ void f_ret_state(const h16* KT, const h16* VT, h16* SS) {
    const int tid = threadIdx.x, lane = tid & 63, w = tid >> 6, fr = lane & 15, kg = lane >> 4;
    for (int it = blockIdx.x; it < 256; it += gridDim.x) {
        const int bh = it & 7, rem = it >> 3, dvt = rem >> 2, dkt = rem & 3, b = bh >> 2, h = bh & 3;
        const float lg = ret_lg(h), g32 = __expf(32.f * lg);
        const int dvr = dvt * 64 + (w >> 1) * 16, dkc = dkt * 64 + (w & 1) * 32;
        const h16* vrow = VT + ((size_t)b * 2048 + h * 512 + dvr + fr) * T + 8 * kg;
        const h16* krow0 = KT + ((size_t)bh * 256 + dkc + fr) * T + 8 * kg;
        const h16* krow1 = krow0 + (size_t)16 * T;
        h16x8 dec;
#pragma unroll
        for (int j = 0; j < 8; ++j) dec[j] = (h16)__expf(lg * (float)(31 - 8 * kg - j));
        f32x4 acc0 = {0.f, 0.f, 0.f, 0.f}, acc1 = {0.f, 0.f, 0.f, 0.f};
        for (int sb = 0; sb < (NSUP - 1) * 16; sb += 16) {
#pragma unroll
            for (int s2 = 0; s2 < 16; ++s2) { const int tok = (sb + s2) * 32;
                const h16x8 a = *(const h16x8*)(vrow + tok) * dec; const h16x8 b0 = *(const h16x8*)(krow0 + tok), b1 = *(const h16x8*)(krow1 + tok);
                acc0 = acc0 * g32; acc1 = acc1 * g32;
                acc0 = MFMA16(a, b0, acc0); acc1 = MFMA16(a, b1, acc1); }
            const int ms = sb >> 4;
            h16* sp = SS + (((size_t)bh * (NSUP - 1) + ms) * 512 + dvr + 4 * kg) * 256 + dkc + fr;
#pragma unroll
            for (int r = 0; r < 4; ++r) { sp[(size_t)r * 256] = (h16)acc0[r]; sp[(size_t)r * 256 + 16] = (h16)acc1[r]; }
        }
    }
}
__device__ __forceinline__ void f_ret_out(const h16* Q0, const h16* K0, const h16* VT, const h16* G0, const h16* SS, const float* gn, h16* Y, LAS unsigned char* lds) {
    const int tid = threadIdx.x, lane = tid & 63, w = __builtin_amdgcn_readfirstlane(tid >> 6), fr = lane & 15, kg = lane >> 4;
    LAS unsigned char* QL = lds; LAS unsigned char* KL = lds + 32768; LAS unsigned char* PL = lds + 65536; LAS float* RED = (LAS float*)(lds + 81920);
    for (int it = blockIdx.x; it < 1024; it += gridDim.x) {
        const int c = it & 255, ii = it >> 8, bh = c & 7, u = c >> 3, sup = u >> 1, half = u & 1;
        const int j = (ii < 2) ? (half * 2 + ii) : (7 - half * 2 - (ii - 2));
        const int b = bh >> 2, h = bh & 3, tok0 = sup * SUP + j * 64, m0 = b * T + tok0;
        const float lgh = ret_lg(h);
        h16x8 kreg[4];
#pragma unroll
        for (int i = 0; i < 4; ++i) { const int id = tid + 512 * i, row = id >> 5, cch = id & 31;
            const h16x8 v = *(const h16x8*)(Q0 + (size_t)(m0 + row) * 1024 + h * 256 + cch * 8);
            *(LAS h16x8*)(QL + row * 512 + ((cch ^ (row & 15)) << 4)) = v;
            kreg[i] = *(const h16x8*)(K0 + (size_t)(b * T + sup * SUP + row) * 1024 + h * 256 + cch * 8); }
        __syncthreads();
        f32x4 acc[4][4];
#pragma unroll
        for (int mt = 0; mt < 4; ++mt)
#pragma unroll
            for (int nt = 0; nt < 4; ++nt) acc[mt][nt] = (f32x4){0.f, 0.f, 0.f, 0.f};
        if (sup > 0) {
            const h16* sp = SS + (((size_t)bh * (NSUP - 1) + sup - 1) * 512 + 64 * w + fr) * 256 + 8 * kg;
#pragma unroll 2
            for (int ks = 0; ks < 8; ++ks) {
                h16x8 af[4], bf[4];
#pragma unroll
                for (int mt = 0; mt < 4; ++mt) af[mt] = *(const h16x8*)(sp + (size_t)mt * 16 * 256 + 32 * ks);
#pragma unroll
                for (int nt = 0; nt < 4; ++nt) { const int row = 16 * nt + fr; bf[nt] = *(const LAS h16x8*)(QL + row * 512 + (((4 * ks + kg) ^ (row & 15)) << 4)); }
#pragma unroll
                for (int mt = 0; mt < 4; ++mt)
#pragma unroll
                    for (int nt = 0; nt < 4; ++nt) acc[mt][nt] = MFMA16(af[mt], bf[nt], acc[mt][nt]);
            }
#pragma unroll
            for (int nt = 0; nt < 4; ++nt) { const float qd = __expf(lgh * (float)(j * 64 + 16 * nt + fr + 1));
#pragma unroll
                for (int mt = 0; mt < 4; ++mt) acc[mt][nt] = acc[mt][nt] * qd; }
        }
        const int kw = w & 3, tw = w >> 2;
        for (int kt = 0; kt <= j; ++kt) {
            const int key0 = sup * SUP + kt * 64;
#pragma unroll
            for (int i = 0; i < 4; ++i) { const int id = tid + 512 * i, row = id >> 5, cch = id & 31; *(LAS h16x8*)(KL + row * 512 + ((cch ^ (row & 15)) << 4)) = kreg[i]; }
            if (kt < j) {
#pragma unroll
                for (int i = 0; i < 4; ++i) { const int id = tid + 512 * i, row = id >> 5, cch = id & 31; kreg[i] = *(const h16x8*)(K0 + (size_t)(b * T + key0 + 64 + row) * 1024 + h * 256 + cch * 8); }
            }
            h16x8 av[4][2];
#pragma unroll
            for (int mt = 0; mt < 4; ++mt)
#pragma unroll
                for (int ks = 0; ks < 2; ++ks) av[mt][ks] = *(const h16x8*)(VT + ((size_t)b * 2048 + h * 512 + 64 * w + 16 * mt + fr) * T + key0 + 32 * ks + 8 * kg);
            __syncthreads();
            f32x4 s[2] = {{0.f, 0.f, 0.f, 0.f}, {0.f, 0.f, 0.f, 0.f}};
#pragma unroll
            for (int ks = 0; ks < 8; ++ks) {
                const int kr = 16 * kw + fr; const h16x8 a = *(const LAS h16x8*)(KL + kr * 512 + (((4 * ks + kg) ^ (kr & 15)) << 4));
#pragma unroll
                for (int n = 0; n < 2; ++n) { const int qr = 32 * tw + 16 * n + fr; const h16x8 bq = *(const LAS h16x8*)(QL + qr * 512 + (((4 * ks + kg) ^ (qr & 15)) << 4)); s[n] = MFMA16(a, bq, s[n]); }
            }
            LAS unsigned char* PB = PL + (kt & 1) * 8192;
#pragma unroll
            for (int n = 0; n < 2; ++n) { const int tl = 32 * tw + 16 * n + fr; h16x4 p;
#pragma unroll
                for (int r = 0; r < 4; ++r) { const int dlt = (tok0 + tl) - (key0 + 16 * kw + 4 * kg + r); p[r] = (h16)((dlt >= 0) ? s[n][r] * __expf(lgh * (float)dlt) : 0.f); }
                *(LAS h16x4*)(PB + tl * 128 + (((2 * kw + (kg >> 1)) ^ (tl & 7)) << 4) + (kg & 1) * 8) = p; }
            __syncthreads();
#pragma unroll
            for (int ks = 0; ks < 2; ++ks) {
                h16x8 bp[4];
#pragma unroll
                for (int nt = 0; nt < 4; ++nt) { const int tl = 16 * nt + fr; bp[nt] = *(const LAS h16x8*)(PB + tl * 128 + (((4 * ks + kg) ^ (tl & 7)) << 4)); }
#pragma unroll
                for (int mt = 0; mt < 4; ++mt)
#pragma unroll
                    for (int nt = 0; nt < 4; ++nt) acc[mt][nt] = MFMA16(av[mt][ks], bp[nt], acc[mt][nt]);
            }
        }
        float mean[4], rstd[4];
#pragma unroll
        for (int nt = 0; nt < 4; ++nt) { float s1 = 0.f, s2 = 0.f;
#pragma unroll
            for (int mt = 0; mt < 4; ++mt)
#pragma unroll
                for (int r = 0; r < 4; ++r) { const float x = acc[mt][nt][r]; s1 += x; s2 += x * x; }
            s1 += __shfl_xor(s1, 16); s1 += __shfl_xor(s1, 32); s2 += __shfl_xor(s2, 16); s2 += __shfl_xor(s2, 32);
            if (kg == 0) { RED[(w * 64 + 16 * nt + fr) * 2] = s1; RED[(w * 64 + 16 * nt + fr) * 2 + 1] = s2; } }
        __syncthreads();
#pragma unroll
        for (int nt = 0; nt < 4; ++nt) { float s1 = 0.f, s2 = 0.f;
#pragma unroll
            for (int ww = 0; ww < 8; ++ww) { s1 += RED[(ww * 64 + 16 * nt + fr) * 2]; s2 += RED[(ww * 64 + 16 * nt + fr) * 2 + 1]; }
            mean[nt] = s1 * (1.f / DV); rstd[nt] = rsqrtf(fmaxf(s2 * (1.f / DV) - mean[nt] * mean[nt], 0.f) + EPS); }
#pragma unroll
        for (int mt = 0; mt < 4; ++mt) { const int dv = 64 * w + 16 * mt + 4 * kg; const f32x4 gv = *(const f32x4*)(gn + h * 512 + dv);
#pragma unroll
            for (int nt = 0; nt < 4; ++nt) { const size_t off = (size_t)(m0 + 16 * nt + fr) * 2048 + h * 512 + dv; const h16x4 gg = *(const h16x4*)(G0 + off); h16x4 yo;
#pragma unroll
                for (int r = 0; r < 4; ++r) yo[r] = (h16)(silu_f((float)gg[r]) * (acc[mt][nt][r] - mean[nt]) * rstd[nt] * gv[r]);
                *(h16x4*)(Y + off) = yo; } }
        __syncthreads();
    }
}

typedef float f32x16 __attribute__((ext_vector_type(16)));
#define MFMA32(a, b, c) __builtin_amdgcn_mfma_f32_32x32x16_f16((a), (b), (c), 0, 0, 0)
namespace nsa {
constexpr int KB_OFF = 0, VB_OFF = 16384, IMP_OFF = 32768, SEL_OFF = 65536;
enum { M_WIN = 0, M_CMP1 = 1, M_CMP2 = 2, M_SEL = 3 };
__device__ __forceinline__ int crow(int reg, int hh) { return (reg & 3) + 8 * (reg >> 2) + 4 * hh; }
struct Ctx { int tq, nvq; unsigned sel0, sel1, sel2, sel3; float m, l; float cm, cinv, prev; };

template <int MODE>
__device__ __forceinline__ void stream(LAS unsigned char* lds, const h16* Kg, const h16* Vg, int vlen, int tile_lo, int tile_hi, const h16x8& qf0, const h16x8& qf1, const h16x8& qf2, const h16x8& qf3, Ctx& cx, f32x16& o0, f32x16& o1, LAS float* impw) {
    constexpr bool PV = (MODE != M_CMP1);
    const int tid = threadIdx.x, lane = tid & 63, col = lane & 31, hh = lane >> 5;
    const int srow = tid >> 3, sch = tid & 7;
    const int soff = srow * 128 + ((sch ^ ((srow >> 1) & 7)) << 4);
    const int xs = (col >> 1) & 7;
    h16x8 kr = *(const h16x8*)(Kg + (size_t)(tile_lo * 64 + srow) * 64 + sch * 8), vr = kr;
    if (PV) vr = *(const h16x8*)(Vg + (size_t)srow * vlen + tile_lo * 64 + sch * 8);
    *(LAS h16x8*)(lds + KB_OFF + soff) = kr; if (PV) *(LAS h16x8*)(lds + VB_OFF + soff) = vr;
    __syncthreads();
    for (int ti = tile_lo; ti <= tile_hi; ++ti) {
        const int buf = (ti - tile_lo) & 1;
        if (ti < tile_hi) { kr = *(const h16x8*)(Kg + (size_t)((ti + 1) * 64 + srow) * 64 + sch * 8); if (PV) vr = *(const h16x8*)(Vg + (size_t)srow * vlen + (ti + 1) * 64 + sch * 8); }
        bool selj = true;
        if (MODE == M_SEL) { const unsigned wsel = (ti < 32) ? cx.sel0 : (ti < 64) ? cx.sel1 : (ti < 96) ? cx.sel2 : cx.sel3; selj = ((wsel >> (ti & 31)) & 1u) != 0u; }
        if (MODE != M_SEL || __any(selj)) {
            f32x16 s0, s1;
#pragma unroll
            for (int r = 0; r < 16; ++r) { s0[r] = 0.f; s1[r] = 0.f; }
            const LAS unsigned char* kb = lds + KB_OFF + buf * 8192 + col * 128;
#pragma unroll
            for (int ks = 0; ks < 4; ++ks) { const int co = ((2 * ks + hh) ^ xs) << 4;
                const h16x8 a0 = *(const LAS h16x8*)(kb + co), a1 = *(const LAS h16x8*)(kb + 32 * 128 + co);
                const h16x8 qq = (ks == 0) ? qf0 : (ks == 1) ? qf1 : (ks == 2) ? qf2 : qf3;
                s0 = MFMA32(a0, qq, s0); s1 = MFMA32(a1, qq, s1); }
            const int key0 = ti * 64;
#pragma unroll
            for (int r = 0; r < 16; ++r) { const int k0 = key0 + crow(r, hh), k1 = k0 + 32; bool v0, v1;
                if (MODE == M_WIN) { v0 = (k0 <= cx.tq) && (k0 + 511 >= cx.tq); v1 = (k1 <= cx.tq) && (k1 + 511 >= cx.tq); }
                else if (MODE == M_SEL) { v0 = selj && (k0 <= cx.tq); v1 = selj && (k1 <= cx.tq); }
                else { v0 = k0 < cx.nvq; v1 = k1 < cx.nvq; }
                s0[r] = v0 ? s0[r] : -INFINITY; s1[r] = v1 ? s1[r] : -INFINITY; }
            if (MODE == M_CMP2) {
#pragma unroll
                for (int r = 0; r < 16; ++r) { s0[r] = __expf(s0[r] - cx.cm) * cx.cinv; s1[r] = __expf(s1[r] - cx.cm) * cx.cinv; }
            } else {
                float mx = -INFINITY;
#pragma unroll
                for (int r = 0; r < 16; ++r) mx = fmaxf(mx, fmaxf(s0[r], s1[r]));
                mx = fmaxf(mx, __shfl_xor(mx, 32));
                const float mnew = fmaxf(cx.m, mx), muse = (mnew == -INFINITY) ? 0.f : mnew;
                const float alpha = __expf(cx.m - muse);
                float rs = 0.f;
#pragma unroll
                for (int r = 0; r < 16; ++r) { s0[r] = __expf(s0[r] - muse); s1[r] = __expf(s1[r] - muse); rs += s0[r] + s1[r]; }
                rs += __shfl_xor(rs, 32);
                cx.l = cx.l * alpha + rs; cx.m = mnew;
                if (PV) { o0 = o0 * alpha; o1 = o1 * alpha; }
            }
            if (PV) {
                const LAS unsigned char* vb = lds + VB_OFF + buf * 8192 + col * 128 + 8 * hh;
#pragma unroll
                for (int mt = 0; mt < 2; ++mt)
#pragma unroll
                    for (int s2 = 0; s2 < 2; ++s2) {
                        h16x8 pb;
#pragma unroll
                        for (int e = 0; e < 8; ++e) pb[e] = (h16)(mt ? s1[8 * s2 + e] : s0[8 * s2 + e]);
                        const int c0 = ((4 * mt + 2 * s2) ^ xs) << 4, c1 = ((4 * mt + 2 * s2 + 1) ^ xs) << 4;
#pragma unroll
                        for (int dt = 0; dt < 2; ++dt) {
                            const h16x4 lo = *(const LAS h16x4*)(vb + dt * 32 * 128 + c0), hi = *(const LAS h16x4*)(vb + dt * 32 * 128 + c1);
                            const h16x8 av = __builtin_shufflevector(lo, hi, 0, 1, 2, 3, 4, 5, 6, 7);
                            if (dt == 0) o0 = MFMA32(av, pb, o0); else o1 = MFMA32(av, pb, o1); }
                    }
            }
            if (MODE == M_CMP2) {
#pragma unroll
                for (int mt = 0; mt < 2; ++mt)
#pragma unroll
                    for (int rg = 0; rg < 4; ++rg) {
                        const float p0 = mt ? s1[4 * rg] : s0[4 * rg], p1 = mt ? s1[4 * rg + 1] : s0[4 * rg + 1], p2 = mt ? s1[4 * rg + 2] : s0[4 * rg + 2], p3 = mt ? s1[4 * rg + 3] : s0[4 * rg + 3];
                        const float A = 2.f * (p0 + p1 + p2) + p3; const float y = __shfl_xor(p3, 32);
                        float v = A + (hh ? y : cx.prev); if (!hh) cx.prev = y;
                        v += __shfl_xor(v, 1); v += __shfl_xor(v, 2);
                        if ((col & 3) == 0) impw[(col >> 2) * 128 + 16 * ti + 8 * mt + 2 * rg + hh] = v;
                    }
            }
        }
        if (ti < tile_hi) { *(LAS h16x8*)(lds + KB_OFF + (buf ^ 1) * 8192 + soff) = kr; if (PV) *(LAS h16x8*)(lds + VB_OFF + (buf ^ 1) * 8192 + soff) = vr; }
        __syncthreads();
    }
}
__device__ __forceinline__ void topk_mask(float imp0, float imp1, int cur, int lane, LAS unsigned* out4) {
    unsigned long long mlo = 1ull, mhi = 0ull; int nsel = 1;
    if (cur >= 1) { if (cur < 64) mlo |= 1ull << cur; else mhi |= 1ull << (cur - 64); ++nsel; }
    if (cur >= 2) { const int c1 = cur - 1; if (c1 < 64) mlo |= 1ull << c1; else mhi |= 1ull << (c1 - 64); ++nsel; }
    const int sA = lane, sB = lane + 64;
    float v0 = (sA <= cur && sA != 0 && sA != cur && sA != cur - 1) ? imp0 : -INFINITY;
    float v1 = (sB <= cur && sB != 0 && sB != cur && sB != cur - 1) ? imp1 : -INFINITY;
    while (nsel < 16) {
        const float mx = wave_max(fmaxf(v0, v1));
        if (mx == -INFINITY) break;
        const unsigned long long b0 = __ballot(v0 == mx);
        if (b0) { const int l = __ffsll((long long)b0) - 1; mlo |= 1ull << l; if (lane == l) v0 = -INFINITY; }
        else { const unsigned long long b1 = __ballot(v1 == mx); const int l = __ffsll((long long)b1) - 1; mhi |= 1ull << l; if (lane == l) v1 = -INFINITY; }
        ++nsel;
    }
    if (lane == 0) { out4[0] = (unsigned)mlo; out4[1] = (unsigned)(mlo >> 32); out4[2] = (unsigned)mhi; out4[3] = (unsigned)(mhi >> 32); }
}
__device__ __forceinline__ void phase(const h16* QN, const h16* KV6, const h16* CK, const h16* CVT, const float* GATES, h16* O1, LAS unsigned char* lds) {
    const int tid = threadIdx.x, lane = tid & 63, w = __builtin_amdgcn_readfirstlane(tid >> 6), col = lane & 31, hh = lane >> 5, ql = col >> 2, r = col & 3;
    const size_t SL = (size_t)8 * T * 64;
    LAS float* impw = (LAS float*)(lds + IMP_OFF) + w * 1024;
    LAS unsigned* selw = (LAS unsigned*)(lds + SEL_OFF) + w * 32;
    for (int it = blockIdx.x; it < 1024; it += gridDim.x) {
        const int c = it & 255, ii = it >> 8, bg = c & 7, u = c >> 3;
        const int qt = (ii == 0) ? u : (ii == 1) ? 63 - u : (ii == 2) ? 64 + u : 127 - u;
        const int b = bg >> 2, g = bg & 3, t0 = qt * 64, mrow = b * T + t0 + 8 * w + ql;
        Ctx cx; cx.tq = t0 + 8 * w + ql; cx.nvq = (cx.tq >= 31) ? ((cx.tq - 31) >> 4) + 1 : 0; cx.prev = 0.f;
        const h16* qp = QN + (size_t)mrow * 1024 + (g * 4 + r) * 64 + 8 * hh;
        const h16x8 qf0 = *(const h16x8*)(qp), qf1 = *(const h16x8*)(qp + 16), qf2 = *(const h16x8*)(qp + 32), qf3 = *(const h16x8*)(qp + 48);
        const float* gp = GATES + (size_t)mrow * 48 + (g * 4 + r) * 3;
        const float g_c = gp[0], g_s = gp[1], g_w = gp[2];
        f32x16 out0, out1, o0, o1;
        cx.m = -INFINITY; cx.l = 0.f;
#pragma unroll
        for (int e = 0; e < 16; ++e) { o0[e] = 0.f; o1[e] = 0.f; }
        stream<M_WIN>(lds, KV6 + 3 * SL + (size_t)bg * T * 64, KV6 + 5 * SL + (size_t)bg * 64 * T, T, (qt >= 8) ? qt - 8 : 0, qt, qf0, qf1, qf2, qf3, cx, o0, o1, impw);
        { const float f = g_w / cx.l; out0 = o0 * f; out1 = o1 * f; }
        const int nct = (4 * qt + 3 + 63) >> 6;
        cx.m = -INFINITY; cx.l = 0.f;
        stream<M_CMP1>(lds, CK + (size_t)bg * NCP * 64, CVT + (size_t)bg * 64 * NCP, NCP, 0, nct - 1, qf0, qf1, qf2, qf3, cx, o0, o1, impw);
        cx.cm = (cx.m == -INFINITY) ? 0.f : cx.m; cx.cinv = (cx.l > 0.f) ? 1.f / cx.l : 0.f;
#pragma unroll
        for (int e = 0; e < 16; ++e) { o0[e] = 0.f; o1[e] = 0.f; }
        stream<M_CMP2>(lds, CK + (size_t)bg * NCP * 64, CVT + (size_t)bg * 64 * NCP, NCP, 0, nct - 1, qf0, qf1, qf2, qf3, cx, o0, o1, impw);
        out0 = out0 + o0 * g_c; out1 = out1 + o1 * g_c;
        asm volatile("s_waitcnt lgkmcnt(0)" ::: "memory");
        for (int q8 = 0; q8 < 8; ++q8) topk_mask(impw[q8 * 128 + lane], impw[q8 * 128 + 64 + lane], qt, lane, selw + q8 * 4);
        asm volatile("s_waitcnt lgkmcnt(0)" ::: "memory");
        cx.sel0 = selw[ql * 4]; cx.sel1 = selw[ql * 4 + 1]; cx.sel2 = selw[ql * 4 + 2]; cx.sel3 = selw[ql * 4 + 3];
        cx.m = -INFINITY; cx.l = 0.f;
#pragma unroll
        for (int e = 0; e < 16; ++e) { o0[e] = 0.f; o1[e] = 0.f; }
        stream<M_SEL>(lds, KV6 + 2 * SL + (size_t)bg * T * 64, KV6 + 4 * SL + (size_t)bg * 64 * T, T, 0, qt, qf0, qf1, qf2, qf3, cx, o0, o1, impw);
        { const float f = g_s / cx.l; out0 = out0 + o0 * f; out1 = out1 + o1 * f; }
        h16* op = O1 + (size_t)mrow * 1024 + (g * 4 + r) * 64 + 4 * hh;
#pragma unroll
        for (int dt = 0; dt < 2; ++dt)
#pragma unroll
            for (int rg = 0; rg < 4; ++rg) { h16x4 o4; o4[0] = (h16)(dt ? out1[4 * rg] : out0[4 * rg]); o4[1] = (h16)(dt ? out1[4 * rg + 1] : out0[4 * rg + 1]); o4[2] = (h16)(dt ? out1[4 * rg + 2] : out0[4 * rg + 2]); o4[3] = (h16)(dt ? out1[4 * rg + 3] : out0[4 * rg + 3]);
                *(h16x4*)(op + 32 * dt + 8 * rg) = o4; }
    }
}
}

constexpr int MISC_OFF = LDS_BYTES - 64;
constexpr int CW_BAR = 4096;
constexpr size_t CTL_ZERO_BYTES = 64 * 1024;

template <int PH> __global__ void __launch_bounds__(NT, 2) mk(Args args) {
    extern __shared__ __attribute__((aligned(16))) unsigned char lds_raw[];
    float* lds = (float*)lds_raw;
    const int tid = threadIdx.x, lane = tid & 63, wave = tid >> 6;
    const int gw = blockIdx.x * 8 + wave, NGW = gridDim.x * 8, gt = blockIdx.x * NT + tid, NGT = gridDim.x * NT;
    unsigned char* ws = args.ws;
    const float* x = args.in[0]; const float* norms = args.in[1];
    float* RC = (float*)(ws + WS_RC); float* RS = (float*)(ws + WS_RS); float* NC = (float*)(ws + WS_NC); float* NS = (float*)(ws + WS_NS);
    float* BIASK = (float*)(ws + WS_BIASK); float* BIASV = (float*)(ws + WS_BIASV);
    h16* XN = (h16*)(ws + WS_XN); float* MB = (float*)(ws + WS_MB); h16* HID = (h16*)(ws + WS_HID);
    h16* WFI = (h16*)(ws + WS_WFI); h16* WFO = (h16*)(ws + WS_WFO);
    h16* Q0 = (h16*)(ws + WS_Q0); h16* K0 = (h16*)(ws + WS_K0); h16* VT = (h16*)(ws + WS_VT); h16* KT = (h16*)(ws + WS_KT); h16* G0 = (h16*)args.out; h16* SS = (h16*)(ws + WS_SS); h16* Y = (h16*)(ws + WS_Y);
    h16* KV6 = (h16*)(ws + WS_KC); h16* QN = (h16*)(ws + WS_QN); float* GATES = (float*)(ws + WS_GATES); h16* HC = (h16*)(ws + WS_HC); h16* CK = (h16*)(ws + WS_CK); h16* CV = (h16*)(ws + WS_CV); h16* O1 = (h16*)(ws + WS_O1);
    float* XR = args.out;
    float* scr = lds + wave * (64 * 33);
    const int lo = args.ph_lo, hi = args.ph_hi;
    XcdBarrier bar; bar.bar = nullptr; bar.x = 0; bar.st = nullptr;
    if (PH < 0) {
        volatile LAS unsigned* misc = (volatile LAS unsigned*)((LAS unsigned char*)lds_raw + MISC_OFF);
        if (tid < 2) misc[tid] = 0u;
        __syncthreads();
        bar = xcd_barrier_post((unsigned*)(ws + WS_CTL) + CW_BAR, misc);
    }
#define FGEMM(EpiT, Eobj, Aptr, lda_, Btptr, Mrows, N_, K_, cidx, ALIGN) { const pg8::Gemm g_{Aptr, Btptr, Mrows, N_, K_, lda_}; pg8::StaticOrder S_; S_.init(Mrows, N_, (int)gridDim.x, (int)(cidx)); \
        const EpiT E_ = Eobj; pg8::gemm_phase<EpiT, pg8::StaticOrder, ALIGN, true>((LAS unsigned char*)lds_raw, g_, S_, E_); }
#define FGEMM_SW(EpiT, Eobj, Aptr, lda_, Btptr, Mrows, N_, K_, cidx, ALIGN) { const pg8::Gemm g_{Aptr, Btptr, Mrows, N_, K_, lda_}; pg8::StaticOrder S_; S_.init(Mrows, N_, (int)gridDim.x, (int)(cidx)); \
        const EpiT E_ = Eobj; pg8::gemm_phase<EpiT, pg8::StaticOrder, ALIGN, true, true>((LAS unsigned char*)lds_raw, g_, S_, E_); }
#define SEAM(k) { if (PH < 0 && IN(k) && IN((k) + 1)) xcd_barrier(bar); }
#define IN(k) (PH < 0 ? (lo <= (k) && (k) < hi) : (PH == (k)))

    if (IN(0)) {
        const int NI = 16 * 192 + 32 * 32;
        for (int it = gw; it < NI; it += NGW) { int r = it;
            WT_JOB(r, args.in[2], 1024, 6144, (h16*)(ws + WS_WA), norms + 0 * 1024, 3, 0);
            WT_JOB(r, args.in[4], 2048, 1024, (h16*)(ws + WS_WRO), nullptr, 0, 0); }
        for (int i = gt; i < T * 128; i += NGT) { const int t = i >> 7, j = i & 127; const float fr = (float)(1.0 / pow(10000.0, (double)((float)j / 127.0f))); float c, s; sincos_acc((float)t * fr, c, s); RC[i] = c; RS[i] = s; }
        for (int i = gt; i < T * 8; i += NGT) { const int t = i >> 3, j = i & 7; const float fr = (float)pow(500000.0, -(double)(2 * j) / 16.0); float c, s; sincos_acc((float)t * fr, c, s); NC[i] = c; NS[i] = s; }
        for (int m = gw; m < M; m += NGW) xn_row(x + (size_t)m * D, XN + (size_t)m * D, lane);
    }
    SEAM(0)
    if (IN(1)) { FGEMM(pg8::EpiRetInF, (pg8::EpiRetInF{Q0, K0, KT, G0, RC, RS}), XN, 1024, (const h16*)(ws + WS_WA), M, 4096, 1024, blockIdx.x, true)
                 FGEMM_SW(pg8::EpiVT, (pg8::EpiVT{VT, 2048, (size_t)256 * T}), XN, 1024, (const h16*)(ws + WS_WA) + (size_t)4096 * 1024, M, 2048, 1024, blockIdx.x, true) }
    SEAM(1)
    if (IN(2)) f_ret_state(KT, VT, SS);
    SEAM(2)
    if (IN(3)) f_ret_out(Q0, K0, VT, G0, SS, args.in[3], Y, (LAS unsigned char*)lds_raw);
    SEAM(3)
    if (IN(4)) FGEMM(pg8::EpiF32F, (pg8::EpiF32F{MB, 1024}), Y, 2048, (const h16*)(ws + WS_WRO), M, 1024, 2048, blockIdx.x, false)
#define PH_NORM_A(L, xin) {     \
            for (int m = gw; m < M; m += NGW) res_norm_row((xin) + (size_t)m * D, MB + (size_t)m * D, norms + ((L) * 4 + 1) * 1024, XR + (size_t)m * D, XN + (size_t)m * D, lane); \
            const int NI = 16 * 176 + 44 * 32; \
            for (int it = gw; it < NI; it += NGW) { int r = it; \
                WT_JOB(r, args.in[15] + (size_t)(L) * 1024 * 5632, 1024, 5632, WFI, norms + ((L) * 4 + 2) * 1024, 1, 0); \
                WT_JOB(r, args.in[16] + (size_t)(L) * 2816 * 1024, 2816, 1024, WFO, nullptr, 0, 0); } }
#define PH_FFN_IN() FGEMM(pg8::EpiSwigluF, (pg8::EpiSwigluF{HID}), XN, 1024, WFI, M, 5632, 1024, blockIdx.x, true)
#define PH_FFN_OUT() FGEMM(pg8::EpiF32F, (pg8::EpiF32F{MB, 1024}), HID, DFF, WFO, M, 1024, DFF, blockIdx.x, false)
    SEAM(4)
    if (IN(5)) PH_NORM_A(0, x)
    SEAM(5)
    if (IN(6)) PH_FFN_IN()
    SEAM(6)
    if (IN(7)) PH_FFN_OUT()
    SEAM(7)
    if (IN(8)) {
        for (int m = gw; m < M; m += NGW) res_norm_row(XR + (size_t)m * D, MB + (size_t)m * D, norms + 3 * 1024, XR + (size_t)m * D, XN + (size_t)m * D, lane);
        const int NI = 16 * 48 + 16 * 34 + 16 * 32 + 2 * 32 * 8;
        for (int it = gw; it < NI; it += NGW) { int r = it;
            WT_JOB(r, args.in[8], 1024, 1536, (h16*)(ws + WS_WKVQ), args.in[7], 4, 0);
            WT_JOB(r, args.in[5], 1024, 1072, (h16*)(ws + WS_WKVQ), norms + 4 * 1024, 0, 1024);
            WT_JOB(r, args.in[6], 1024, 1024, (h16*)(ws + WS_WNO), nullptr, 0, 0);
            WT_JOB(r, args.in[11], 2048, 256, (h16*)(ws + WS_WC1K), nullptr, 0, 0);
            WT_JOB(r, args.in[13], 2048, 256, (h16*)(ws + WS_WC1V), nullptr, 0, 0); }
        { h16* z = (h16*)(ws + WS_WKVQ) + (size_t)2096 * 1024; for (int i = gt; i < 208 * 1024; i += NGT) z[i] = (h16)0.f; }
        for (int o = gw; o < 512; o += NGW) {
            const int which = o >> 8, c = o & 255; const float* pos = args.in[which ? 10 : 9]; const float* w1 = args.in[which ? 13 : 11]; float a = 0.f;
            for (int k = lane; k < 2048; k += 64) a += pos[k] * w1[(size_t)k * 256 + c];
            a = wave_sum(a); if (lane == 0) (which ? BIASV : BIASK)[c] = a; }
    }
    SEAM(8)
    if (IN(9)) { FGEMM(pg8::EpiKvqF, (pg8::EpiKvqF{KV6, QN, GATES, NC, NS}), XN, 1024, (const h16*)(ws + WS_WKVQ), M, 2304, 1024, blockIdx.x, true)
                 FGEMM_SW(pg8::EpiVT, (pg8::EpiVT{KV6 + (size_t)4 * (8u * T * 64), 256, (size_t)512 * T}), XN, 1024, (const h16*)(ws + WS_WKVQ) + (size_t)2304 * 1024, M, 512, 1024, (blockIdx.x + 128) & 255, true) }
    SEAM(9)
    if (IN(10)) {
        FGEMM(pg8::EpiCmpF, (pg8::EpiCmpF{HC, BIASK}), KV6, 1024, (const h16*)(ws + WS_WC1K), 4096, 256, 2048, blockIdx.x, false)
        FGEMM(pg8::EpiCmpF, (pg8::EpiCmpF{HC + (size_t)4096 * 256, BIASV}), KV6 + (size_t)8 * T * 64, 1024, (const h16*)(ws + WS_WC1V), 4096, 256, 2048, (blockIdx.x + 240) & 255, false)
    }
    SEAM(10)
    if (IN(11)) {
        for (int i = gt; i < 2 * 4096 * 64; i += NGT) { const int which = i >> 18, r = (i >> 6) & 4095, d = i & 63; const float* w2 = args.in[which ? 14 : 12]; const h16* hr = HC + ((size_t)which * 4096 + r) * 256; float a = 0.f;
            for (int c = 0; c < 256; ++c) a += (float)hr[c] * w2[c * 64 + d];
            if ((r & 511) == 511) a = 0.f;
            if (which) CV[((size_t)(r >> 9) * 64 + d) * 512 + (r & 511)] = (h16)a; else CK[(size_t)r * 64 + d] = (h16)a; }
    }
    SEAM(11)
    if (IN(12)) nsa::phase(QN, KV6, CK, CV, GATES, O1, (LAS unsigned char*)lds_raw);
    SEAM(12)
    if (IN(13)) FGEMM(pg8::EpiF32F, (pg8::EpiF32F{MB, 1024}), O1, 1024, (const h16*)(ws + WS_WNO), M, 1024, 1024, blockIdx.x, false)
    SEAM(13)
    if (IN(14)) PH_NORM_A(1, XR)
    SEAM(14)
    if (IN(15)) PH_FFN_IN()
    SEAM(15)
    if (IN(16)) PH_FFN_OUT()
    SEAM(16)
    if (IN(17)) { for (int m = gw; m < M; m += NGW) res_norm_row(XR + (size_t)m * D, MB + (size_t)m * D, norms + 7 * 1024, XR + (size_t)m * D, nullptr, lane); }
#undef IN
}

extern "C" void kernel_launch(void* const* d_in, const int* in_sizes, int n_in, void* d_out, int out_size, void* d_ws, size_t ws_size, hipStream_t stream) {
    static int grid = 0;
    if (grid == 0) {
        if (n_in != 17 || out_size != M * D || ws_size < WS_END) { fprintf(stderr, "kernel_launch: unexpected problem (n_in %d out %d ws %zu)\n", n_in, out_size, ws_size); grid = -1; return; }
        int dev = 0, cus = 0;
        (void)hipGetDevice(&dev); (void)hipDeviceGetAttribute(&cus, hipDeviceAttributeMultiprocessorCount, dev);
#define SETATTR(p) if (hipFuncSetAttribute((const void*)mk<p>, hipFuncAttributeMaxDynamicSharedMemorySize, LDS_BYTES) != hipSuccess) { fprintf(stderr, "kernel_launch: hipFuncSetAttribute failed\n"); grid = -1; return; }
        SETATTR(-1) SETATTR(0) SETATTR(1) SETATTR(2) SETATTR(3) SETATTR(4) SETATTR(5) SETATTR(6) SETATTR(7) SETATTR(8) SETATTR(9)
        SETATTR(10) SETATTR(11) SETATTR(12) SETATTR(13) SETATTR(14) SETATTR(15) SETATTR(16) SETATTR(17)
        (void)hipGetLastError();
        grid = cus > 0 ? cus : 256;
    }
    if (grid < 0) return;
    Args a{};
    for (int i = 0; i < 17; ++i) a.in[i] = (const float*)d_in[i];
    a.out = (float*)d_out; a.ws = (unsigned char*)d_ws;
#if MK_ONE_LAUNCH
    if (hipMemsetAsync((char*)d_ws + WS_CTL, 0, CTL_ZERO_BYTES, stream) != hipSuccess) { fprintf(stderr, "kernel_launch: memset failed\n"); return; }
    a.ph_lo = 0; a.ph_hi = NPHASE; hipLaunchKernelGGL(mk<-1>, dim3(grid), dim3(NT), LDS_BYTES, stream, a);
    return;
#endif
#define LAUNCH_PH(p) { a.ph_lo = p; a.ph_hi = p + 1; hipLaunchKernelGGL(mk<p>, dim3(grid), dim3(NT), LDS_BYTES, stream, a); }
    LAUNCH_PH(0) LAUNCH_PH(1) LAUNCH_PH(2) LAUNCH_PH(3) LAUNCH_PH(4) LAUNCH_PH(5) LAUNCH_PH(6) LAUNCH_PH(7) LAUNCH_PH(8) LAUNCH_PH(9)
    LAUNCH_PH(10) LAUNCH_PH(11) LAUNCH_PH(12) LAUNCH_PH(13) LAUNCH_PH(14) LAUNCH_PH(15) LAUNCH_PH(16) LAUNCH_PH(17)
}
```

```cpp
#include <hip/hip_runtime.h>
#include <cstdio>
#include <cstdint>

#ifndef MK_REP
#define MK_REP -1
#endif
#ifndef MK_ONE_LAUNCH
#define MK_ONE_LAUNCH 1
#endif

typedef _Float16 h16;
typedef _Float16 h16x8 __attribute__((ext_vector_type(8)));
typedef _Float16 h16x4 __attribute__((ext_vector_type(4)));
typedef float f32x4 __attribute__((ext_vector_type(4)));

constexpr int BATCH = 2, T = 8192, D = 1024, M = BATCH * T;
constexpr int RH = 4, DK = 256, DV = 512;
constexpr int NG = 4, HD = 64, NCP = 512;
constexpr int DFF = 2816;
constexpr int SUP = 512, NSUP = T / SUP;
constexpr float EPS = 1e-6f;
constexpr int NPHASE = 18;
constexpr int NT = 512;
constexpr int LDS_BYTES = 147456;

constexpr size_t MiB = 1u << 20;
constexpr size_t WS_CTL = 0;
constexpr size_t WS_RC = 1 * MiB, WS_RS = 5 * MiB;
constexpr size_t WS_NC = 9 * MiB, WS_NS = 9 * MiB + 256 * 1024;
constexpr size_t WS_BIASK = 9 * MiB + 512 * 1024, WS_BIASV = WS_BIASK + 1024;
constexpr size_t WS_WC1K = 10 * MiB, WS_WC1V = 11 * MiB;
constexpr size_t WS_WA = 12 * MiB;
constexpr size_t WS_WKVQ = 12 * MiB, WS_WNO = 18 * MiB;
constexpr size_t WS_WRO = 24 * MiB;
constexpr size_t WS_XN = 28 * MiB;
constexpr size_t WS_SS = 28 * MiB;
constexpr size_t WS_O1 = 28 * MiB;
constexpr size_t WS_Q0 = 60 * MiB, WS_K0 = 92 * MiB, WS_VT = 124 * MiB, WS_KT = 188 * MiB, WS_Y = 188 * MiB;
constexpr size_t WS_MB = 60 * MiB;
constexpr size_t WS_WFI = 124 * MiB, WS_WFO = 135 * MiB;
constexpr size_t WS_HID = 144 * MiB;
constexpr size_t WS_KC = 124 * MiB, WS_VC = 132 * MiB, WS_KS = 140 * MiB, WS_VS = 148 * MiB, WS_KW = 156 * MiB, WS_VW = 164 * MiB;
constexpr size_t WS_QN = 172 * MiB;
constexpr size_t WS_GATES = 204 * MiB;
constexpr size_t WS_SLAB = 28 * MiB;
constexpr size_t WS_CK = 212 * MiB, WS_CV = 212 * MiB + 512 * 1024;
constexpr size_t WS_END = 252 * MiB;

struct Args { const float* in[17]; float* out; unsigned char* ws; int ph_lo, ph_hi; };

__device__ __forceinline__ float wave_sum(float v) {
#pragma unroll
    for (int o = 1; o < 64; o <<= 1) v += __shfl_xor(v, o);
    return v;
}
__device__ __forceinline__ float wave_max(float v) {
#pragma unroll
    for (int o = 1; o < 64; o <<= 1) v = fmaxf(v, __shfl_xor(v, o));
    return v;
}
#define LDS_FENCE() asm volatile("s_waitcnt lgkmcnt(0)" ::: "memory")

__device__ __forceinline__ void sincos_acc(float ang, float& c, float& s) {
    const double x = (double)ang;
    const double k = __builtin_rint(x * 0.63661977236758134308);
    double y = __builtin_fma(-k, 1.57079632679489655800, x);
    y = __builtin_fma(-k, 6.12323399573676603587e-17, y);
    const double y2 = y * y;
    double sp = -2.5052108385441718775e-08; sp = sp * y2 + 2.7557319223985890653e-06; sp = sp * y2 - 1.9841269841269841270e-04; sp = sp * y2 + 8.3333333333333332177e-03; sp = sp * y2 - 1.6666666666666665741e-01;
    const double sy = y + y * y2 * sp;
    double cp = 2.0876756987868098979e-09; cp = cp * y2 - 2.7557319223985888e-07; cp = cp * y2 + 2.4801587301587301566e-05; cp = cp * y2 - 1.3888888888888889419e-03; cp = cp * y2 + 4.1666666666666664354e-02; cp = cp * y2 - 0.5;
    const double cy = 1.0 + y2 * cp;
    const int q = ((int)k) & 3;
    const double sr = (q == 0) ? sy : (q == 1) ? cy : (q == 2) ? -sy : -cy;
    const double cr = (q == 0) ? cy : (q == 1) ? -sy : (q == 2) ? -cy : sy;
    c = (float)cr; s = (float)sr;
}
__device__ __forceinline__ float silu_f(float x) { return x / (1.f + __expf(-x)); }
__device__ __forceinline__ float sigmoid_f(float x) { return 1.f / (1.f + __expf(-x)); }
__device__ __forceinline__ float gelu_tanh_f(float x) { const float u = 0.7978845608028654f * (x + 0.044715f * x * x * x); return 0.5f * x * (1.f + tanhf(u)); }
__device__ __forceinline__ float ret_lg(int h) { return log1pf(-exp2f(-5.0f - (float)h)); }

__device__ __forceinline__ void wt_item(const float* W, int K, int N, h16* WT, const float* gain, int kind, int rowoff, float* scr, int item, int lane) {
    const int nblk = (N + 31) / 32, kb = item / nblk, nb = item % nblk, k0 = 64 * kb, n0 = 32 * nb;
    const int ncol = n0 + (lane & 31);
#pragma unroll 8
    for (int i = 0; i < 32; ++i) { const int kk = 2 * i + (lane >> 5); float v = 0.f; if (ncol < N) v = W[(size_t)(k0 + kk) * N + ncol]; if (gain) v *= gain[k0 + kk]; scr[kk * 33 + (lane & 31)] = v; }
    LDS_FENCE();
    const int c = lane & 7;
#pragma unroll
    for (int j = 0; j < 4; ++j) {
        const int nl = (lane >> 3) + 8 * j, n = n0 + nl; const float* s = scr + (8 * c) * 33 + nl;
        h16x8 o;
#pragma unroll
        for (int e = 0; e < 8; ++e) o[e] = (h16)s[e * 33];
        int row;
        if (kind == 0) row = rowoff + n;
        else if (kind == 3) row = (n < 2048) ? n : (n < 4096 ? n + 2048 : n - 2048);
        else if (kind == 4) { const int blk = n >> 8; const int tm = (blk == 3) ? 9 : (blk == 4) ? 3 : (blk == 5) ? 10 : blk; row = tm * 256 + (n & 255); }
        else { row = (n < DFF) ? (256 * (n >> 7) + (n & 127)) : (256 * ((n - DFF) >> 7) + 128 + ((n - DFF) & 127)); }
        if (n < N || kind == 2) *(h16x8*)(WT + (size_t)row * K + k0 + 8 * c) = o;
    }
    LDS_FENCE();
}
#define WT_JOB(r, W, K, N, WT, gain, kind, rowoff) { const int _ni = ((K) / 64) * (((N) + 31) / 32); if ((r) >= 0 && (r) < _ni) wt_item(W, K, N, WT, gain, kind, rowoff, scr, r, lane); (r) -= _ni; }

__device__ __forceinline__ void xn_row(const float* xrow, h16* orow, int lane) {
    f32x4 v[4]; float s = 0.f;
#pragma unroll
    for (int j = 0; j < 4; ++j) { v[j] = *(const f32x4*)(xrow + 4 * lane + 256 * j); s += v[j].x * v[j].x + v[j].y * v[j].y + v[j].z * v[j].z + v[j].w * v[j].w; }
    const float rstd = rsqrtf(wave_sum(s) * (1.f / D) + EPS);
#pragma unroll
    for (int j = 0; j < 4; ++j) { h16x4 o; o[0] = (h16)(v[j].x * rstd); o[1] = (h16)(v[j].y * rstd); o[2] = (h16)(v[j].z * rstd); o[3] = (h16)(v[j].w * rstd); *(h16x4*)(orow + 4 * lane + 256 * j) = o; }
}
__device__ __forceinline__ void res_norm_row(const float* xi, const float* mb, const float* gain, float* xo, h16* xn, int lane) {
    f32x4 a[4], r[4]; float s = 0.f;
#pragma unroll
    for (int j = 0; j < 4; ++j) { a[j] = *(const f32x4*)(mb + 4 * lane + 256 * j); r[j] = *(const f32x4*)(xi + 4 * lane + 256 * j); s += a[j].x * a[j].x + a[j].y * a[j].y + a[j].z * a[j].z + a[j].w * a[j].w; }
    const float rstd = rsqrtf(wave_sum(s) * (1.f / D) + EPS); float s2 = 0.f;
#pragma unroll
    for (int j = 0; j < 4; ++j) { const f32x4 g = *(const f32x4*)(gain + 4 * lane + 256 * j); r[j] = r[j] + a[j] * rstd * g; *(f32x4*)(xo + 4 * lane + 256 * j) = r[j]; s2 += r[j].x * r[j].x + r[j].y * r[j].y + r[j].z * r[j].z + r[j].w * r[j].w; }
    if (xn) {
        const float rs2 = rsqrtf(wave_sum(s2) * (1.f / D) + EPS);
#pragma unroll
        for (int j = 0; j < 4; ++j) { h16x4 o; o[0] = (h16)(r[j].x * rs2); o[1] = (h16)(r[j].y * rs2); o[2] = (h16)(r[j].z * rs2); o[3] = (h16)(r[j].w * rs2); *(h16x4*)(xn + 4 * lane + 256 * j) = o; }
    }
}

constexpr int CT_LD = 260;
template <class Epi>
__device__ __forceinline__ void ngemm(const h16* A, int lda, const h16* Bt, int K, int Mrows, int Ntiles, float* lds, const Epi& E) {
    float* As = lds; float* Bs = lds + 64 * 33; float* Ct = lds + 64 * 33 + 256 * 33;
    const int tid = threadIdx.x, ty = tid >> 5, tx = tid & 31;
    const int nunits = (Mrows / 64) * Ntiles;
    for (int u = blockIdx.x; u < nunits; u += gridDim.x) {
        const int um = u / Ntiles, un = u % Ntiles;
        float acc[4][8];
#pragma unroll
        for (int i = 0; i < 4; ++i)
#pragma unroll
            for (int j = 0; j < 8; ++j) acc[i][j] = 0.f;
        for (int k0 = 0; k0 < K; k0 += 32) {
            { const h16x4 v = *(const h16x4*)(A + (size_t)(um * 64 + (tid >> 3)) * lda + k0 + (tid & 7) * 4);
#pragma unroll
              for (int j = 0; j < 4; ++j) As[(tid >> 3) * 33 + (tid & 7) * 4 + j] = (float)v[j]; }
            { const h16* p = Bt + (size_t)(un * 256 + (tid >> 1)) * K + k0 + (tid & 1) * 16; const h16x8 v0 = *(const h16x8*)p, v1 = *(const h16x8*)(p + 8);
#pragma unroll
              for (int j = 0; j < 8; ++j) { Bs[(tid >> 1) * 33 + (tid & 1) * 16 + j] = (float)v0[j]; Bs[(tid >> 1) * 33 + (tid & 1) * 16 + 8 + j] = (float)v1[j]; } }
            __syncthreads();
#pragma unroll 4
            for (int kk = 0; kk < 32; ++kk) {
                float a[4], b[8];
#pragma unroll
                for (int i = 0; i < 4; ++i) a[i] = As[(ty * 4 + i) * 33 + kk];
#pragma unroll
                for (int j = 0; j < 8; ++j) b[j] = Bs[(tx + 32 * j) * 33 + kk];
#pragma unroll
                for (int i = 0; i < 4; ++i)
#pragma unroll
                    for (int j = 0; j < 8; ++j) acc[i][j] += a[i] * b[j];
            }
            __syncthreads();
        }
#pragma unroll
        for (int i = 0; i < 4; ++i)
#pragma unroll
            for (int j = 0; j < 8; ++j) Ct[(ty * 4 + i) * CT_LD + tx + 32 * j] = acc[i][j];
        __syncthreads();
        E(um, un, Ct);
        __syncthreads();
    }
}

struct EpiF32 { float* O; int ldc;
    __device__ __forceinline__ void operator()(int um, int un, const float* Ct) const {
        for (int idx = threadIdx.x; idx < 64 * 256; idx += NT) { const int r = idx >> 8, c = idx & 255; O[(size_t)(um * 64 + r) * ldc + un * 256 + c] = Ct[r * CT_LD + c]; } }
};
struct EpiSwiglu { h16* H;
    __device__ __forceinline__ void operator()(int um, int un, const float* Ct) const {
        for (int idx = threadIdx.x; idx < 64 * 128; idx += NT) { const int r = idx >> 7, c = idx & 127; H[(size_t)(um * 64 + r) * DFF + un * 128 + c] = (h16)(silu_f(Ct[r * CT_LD + c]) * Ct[r * CT_LD + c + 128]); } }
};
struct EpiCmp { h16* HC; const float* bias;
    __device__ __forceinline__ void operator()(int um, int un, const float* Ct) const {
        for (int idx = threadIdx.x; idx < 64 * 256; idx += NT) { const int r = idx >> 8, c = idx & 255; HC[(size_t)(um * 64 + r) * 256 + c] = (h16)gelu_tanh_f(Ct[r * CT_LD + c] + bias[c]); } }
};

__device__ __forceinline__ void n_ret_state(const h16* K0, const h16* VT, h16* SS) {
    const int tid = threadIdx.x, d = tid & 255, half = tid >> 8;
    for (int it = blockIdx.x; it < 8 * 128; it += gridDim.x) {
        const int bh = it >> 7, vq = it & 127, b = bh >> 2, h = bh & 3, c0 = vq * 4 + half * 2;
        const float gam = 1.f - exp2f(-5.f - (float)h);
        const h16* kp = K0 + (size_t)(b * T) * 1024 + h * 256 + d; const h16* vp = VT + ((size_t)b * 2048 + h * 512 + c0) * T;
        float s0 = 0.f, s1 = 0.f;
        for (int jb = 0; jb < (NSUP - 1) * SUP; jb += 8) {
            float kv[8], v0[8], v1[8];
#pragma unroll
            for (int e = 0; e < 8; ++e) { kv[e] = (float)kp[(size_t)(jb + e) * 1024]; v0[e] = (float)vp[jb + e]; v1[e] = (float)vp[(size_t)T + jb + e]; }
#pragma unroll
            for (int e = 0; e < 8; ++e) { s0 = gam * s0 + kv[e] * v0[e]; s1 = gam * s1 + kv[e] * v1[e]; }
            if (((jb + 8) & (SUP - 1)) == 0) { const int ms = (jb + 8) / SUP - 1; h16* sp = SS + (((size_t)bh * (NSUP - 1) + ms) * 512 + c0) * 256 + d; sp[0] = (h16)s0; sp[256] = (h16)s1; }
        }
    }
}
__device__ __forceinline__ void n_ret_out(const h16* Q0, const h16* K0, const h16* VT, const h16* G0, const h16* SS, const float* gn, h16* Y, float* lds) {
    const int tid = threadIdx.x, lane = tid & 63, wave = tid >> 6;
    float* qs = lds + wave * 768; float* sc = qs + 256;
    const int gw = blockIdx.x * 8 + wave, NGW = gridDim.x * 8;
    for (int it = gw; it < M * 4; it += NGW) {
        const int m = ((it >> 5) << 3) | (it & 7), h = (it >> 3) & 3, b = m >> 13, t = m & (T - 1), tl = t & (SUP - 1), s0 = t - tl, ms = t / SUP, bh = b * 4 + h;
        const float lgh = ret_lg(h);
        for (int i = lane; i < 256; i += 64) qs[i] = (float)Q0[(size_t)m * 1024 + h * 256 + i];
        LDS_FENCE();
        for (int jj = lane; jj <= tl; jj += 64) {
            const h16* kr = K0 + (size_t)(b * T + s0 + jj) * 1024 + h * 256; float dot = 0.f;
#pragma unroll 2
            for (int d = 0; d < 256; d += 8) { const h16x8 kv = *(const h16x8*)(kr + d);
#pragma unroll
                for (int e = 0; e < 8; ++e) dot += (float)kv[e] * qs[d + e]; }
            sc[jj] = dot * __expf(lgh * (float)(tl - jj));
        }
        LDS_FENCE();
        float o[8];
#pragma unroll
        for (int e = 0; e < 8; ++e) o[e] = 0.f;
        const h16* vb = VT + ((size_t)b * 2048 + h * 512 + lane * 8) * T + s0;
        for (int jj = 0; jj <= tl; ++jj) { const float s = sc[jj];
#pragma unroll
            for (int e = 0; e < 8; ++e) o[e] += s * (float)vb[(size_t)e * T + jj]; }
        if (ms > 0) {
            const h16* sp = SS + (((size_t)bh * (NSUP - 1) + ms - 1) * 512 + lane * 8) * 256; const float qd = __expf(lgh * (float)(tl + 1));
            float cr[8];
#pragma unroll
            for (int e = 0; e < 8; ++e) cr[e] = 0.f;
#pragma unroll 1
            for (int d = 0; d < 256; d += 8) {
#pragma unroll
                for (int e = 0; e < 8; ++e) { const h16x8 sv = *(const h16x8*)(sp + e * 256 + d);
#pragma unroll
                    for (int f = 0; f < 8; ++f) cr[e] += (float)sv[f] * qs[d + f]; } }
#pragma unroll
            for (int e = 0; e < 8; ++e) o[e] += qd * cr[e];
        }
        float s1 = 0.f;
#pragma unroll
        for (int e = 0; e < 8; ++e) s1 += o[e];
        const float mu = wave_sum(s1) * (1.f / DV); float s2 = 0.f;
#pragma unroll
        for (int e = 0; e < 8; ++e) { o[e] -= mu; s2 += o[e] * o[e]; }
        const float rstd = rsqrtf(wave_sum(s2) * (1.f / DV) + EPS);
        const h16x8 gv = *(const h16x8*)(G0 + (size_t)m * 2048 + h * 512 + lane * 8); h16x8 yo;
#pragma unroll
        for (int e = 0; e < 8; ++e) yo[e] = (h16)(silu_f((float)gv[e]) * o[e] * rstd * gn[h * 512 + lane * 8 + e]);
        *(h16x8*)(Y + (size_t)m * 2048 + h * 512 + lane * 8) = yo;
        LDS_FENCE();
    }
}

__device__ __forceinline__ void dots4(const h16* krow, const float* qs, float (&dt)[4]) {
#pragma unroll
    for (int r = 0; r < 4; ++r) dt[r] = 0.f;
#pragma unroll
    for (int c = 0; c < 8; ++c) { const h16x8 kv = *(const h16x8*)(krow + 8 * c);
#pragma unroll
        for (int r = 0; r < 4; ++r)
#pragma unroll
            for (int e = 0; e < 8; ++e) dt[r] += (float)kv[e] * qs[r * 64 + 8 * c + e]; }
}
__device__ __forceinline__ void softmax4(float* sc, int n, int lane) {
    for (int r = 0; r < 4; ++r) {
        float mx = -INFINITY; for (int i = lane; i < n; i += 64) mx = fmaxf(mx, sc[r * 1024 + i]);
        mx = wave_max(mx); float sum = 0.f;
        for (int i = lane; i < n; i += 64) { const float e = __expf(sc[r * 1024 + i] - mx); sc[r * 1024 + i] = e; sum += e; }
        sum = wave_sum(sum); const float inv = 1.f / sum;
        for (int i = lane; i < n; i += 64) sc[r * 1024 + i] *= inv;
    }
    LDS_FENCE();
}
__device__ __forceinline__ int select_blocks(float imp0, float imp1, int cur, int* sel, int lane) {
    int nsel = 0;
    if (lane == 0) { sel[0] = 0; }
    nsel = 1;
    if (cur >= 1) { if (lane == 0) sel[nsel] = cur; ++nsel; }
    if (cur >= 2) { if (lane == 0) sel[nsel] = cur - 1; ++nsel; }
    const int sA = lane, sB = lane + 64;
    float v0 = (sA <= cur && sA != 0 && sA != cur && sA != cur - 1) ? imp0 : -INFINITY;
    float v1 = (sB <= cur && sB != 0 && sB != cur && sB != cur - 1) ? imp1 : -INFINITY;
    while (nsel < 16) {
        const float mx = wave_max(fmaxf(v0, v1));
        if (mx == -INFINITY) break;
        const unsigned long long b0 = __ballot(v0 == mx);
        int s;
        if (b0) { const int l = __ffsll((long long)b0) - 1; s = l; if (lane == l) v0 = -INFINITY; }
        else { const unsigned long long b1 = __ballot(v1 == mx); const int l = __ffsll((long long)b1) - 1; s = l + 64; if (lane == l) v1 = -INFINITY; }
        if (lane == 0) sel[nsel] = s;
        ++nsel;
    }
    LDS_FENCE();
    return nsel;
}
__device__ __forceinline__ void n_nsa_attn(const h16* QN, const h16* KV6, const h16* CK, const h16* CV, const float* GATES, h16* O1, float* lds) {
    const int tid = threadIdx.x, lane = tid & 63, wave = tid >> 6;
    float* qs = lds + wave * 4480; float* sc = qs + 256; int* sel = (int*)(sc + 4096);
    const h16 *KS = KV6 + 2 * (size_t)(8 * T * 64), *KW = KV6 + 3 * (size_t)(8 * T * 64), *VST = KV6 + 4 * (size_t)(8 * T * 64), *VWT = KV6 + 5 * (size_t)(8 * T * 64);
    const int gw = blockIdx.x * 8 + wave, NGW = gridDim.x * 8;
    for (int it = gw; it < M * 4; it += NGW) {
        const int m = it >> 2, g = it & 3, b = m >> 13, t = m & (T - 1), bg = b * 4 + g;
        for (int i = lane; i < 256; i += 64) qs[i] = (float)QN[(size_t)m * 1024 + g * 256 + i];
        LDS_FENCE();
        const int nv = (t >= 31) ? ((t - 31) >> 4) + 1 : 0;
        float oc[4] = {0.f, 0.f, 0.f, 0.f};
        if (nv > 0) {
            for (int n = lane; n < nv; n += 64) { float dt[4]; dots4(CK + ((size_t)bg * NCP + n) * 64, qs, dt);
#pragma unroll
                for (int r = 0; r < 4; ++r) sc[r * 1024 + n] = dt[r]; }
            LDS_FENCE();
            softmax4(sc, nv, lane);
            for (int n = 0; n < nv; ++n) { const float vv = (float)CV[((size_t)bg * 64 + lane) * 512 + n];
#pragma unroll
                for (int r = 0; r < 4; ++r) oc[r] += sc[r * 1024 + n] * vv; }
        }
        float imp[2];
#pragma unroll
        for (int q = 0; q < 2; ++q) { const int s = lane + 64 * q; float a = 0.f;
#pragma unroll
            for (int e = -1; e < 4; ++e) { const int n = 4 * s + e; if (n >= 0 && n < nv) { const float p = sc[n] + sc[1024 + n] + sc[2048 + n] + sc[3072 + n]; a += (e == -1 || e == 3) ? p : 2.f * p; } }
            imp[q] = a; }
        LDS_FENCE();
        const int cur = t >> 6;
        const int nsel = select_blocks(imp[0], imp[1], cur, sel, lane);
        float os[4] = {0.f, 0.f, 0.f, 0.f};
        for (int i2 = 0; i2 < nsel; ++i2) { const int tok = sel[i2] * 64 + lane; float dt[4]; dots4(KS + ((size_t)bg * T + tok) * 64, qs, dt);
#pragma unroll
            for (int r = 0; r < 4; ++r) sc[r * 1024 + i2 * 64 + lane] = (tok <= t) ? dt[r] : -INFINITY; }
        LDS_FENCE();
        softmax4(sc, nsel * 64, lane);
        for (int kk = 0; kk < nsel * 64; ++kk) { const int tok = sel[kk >> 6] * 64 + (kk & 63); const float vv = (float)VST[((size_t)bg * 64 + lane) * T + tok];
#pragma unroll
            for (int r = 0; r < 4; ++r) os[r] += sc[r * 1024 + kk] * vv; }
        LDS_FENCE();
        float ow[4] = {0.f, 0.f, 0.f, 0.f};
        const int nw = (t + 1 < 512) ? t + 1 : 512, t0 = t - nw + 1;
        for (int i = lane; i < nw; i += 64) { float dt[4]; dots4(KW + ((size_t)bg * T + t0 + i) * 64, qs, dt);
#pragma unroll
            for (int r = 0; r < 4; ++r) sc[r * 1024 + i] = dt[r]; }
        LDS_FENCE();
        softmax4(sc, nw, lane);
        for (int i = 0; i < nw; ++i) { const float vv = (float)VWT[((size_t)bg * 64 + lane) * T + t0 + i];
#pragma unroll
            for (int r = 0; r < 4; ++r) ow[r] += sc[r * 1024 + i] * vv; }
        LDS_FENCE();
#pragma unroll
        for (int r = 0; r < 4; ++r) { const float* gp = GATES + (size_t)m * 48 + (g * 4 + r) * 3;
            O1[(size_t)m * 1024 + (g * 4 + r) * 64 + lane] = (h16)(gp[0] * oc[r] + gp[1] * os[r] + gp[2] * ow[r]); }
    }
}

#define LAS __attribute__((address_space(3)))
#define XB_TMO      128
#define XB_XCNT(j)  (256  + 64 * (j))
#define XB_XSUB(j)  (1280 + 64 * (j))
#define XB_XGEN(j)  (2304 + 64 * (j))
#define XB_TOP      3328
#define XB_TOPGEN   3392
#define XCD_BAR_WORDS 3456
#define XB_SPIN_CAP (1u << 18)
__device__ __forceinline__ unsigned xb_ld(unsigned* p)              { return __hip_atomic_load(p, __ATOMIC_RELAXED, __HIP_MEMORY_SCOPE_AGENT); }
__device__ __forceinline__ unsigned xb_add(unsigned* p, unsigned v) { return __hip_atomic_fetch_add(p, v, __ATOMIC_RELAXED, __HIP_MEMORY_SCOPE_AGENT); }
__device__ __forceinline__ unsigned xb_xcc_id() { return (unsigned)__builtin_amdgcn_s_getreg((3 << 11) | 20) & 0xFu; }
#define XB_SPIN(cond, bar) do { unsigned _sp = 0; while (cond) { __builtin_amdgcn_s_sleep(1); \
    if ((++_sp & 255u) == 0u) { if (xb_ld(&(bar)[XB_TMO])) break; if (_sp > XB_SPIN_CAP) { atomicAdd(&(bar)[XB_TMO], 1u); break; } } } } while (0)
struct XcdBarrier { unsigned* bar; unsigned x; volatile LAS unsigned* st; };
__device__ __forceinline__ XcdBarrier xcd_barrier_post(unsigned* bar, volatile LAS unsigned* st) {
    XcdBarrier b; b.bar = bar; b.x = xb_xcc_id(); b.st = st;
    if (threadIdx.x == 0) (void)xb_add(&bar[XB_XCNT(b.x)], 1u);
    return b;
}
__device__ __forceinline__ void xcd_barrier_complete(unsigned* bar, unsigned x, unsigned& nloc, unsigned& nx) {
    const unsigned G = gridDim.x * gridDim.y * gridDim.z;
    unsigned sum, cnt, mine, sp = 0u;
    for (;;) {
        sum = 0u; cnt = 0u; mine = 0u;
#pragma unroll
        for (unsigned j = 0; j < 16; ++j) { const unsigned c = xb_ld(&bar[XB_XCNT(j)]); sum += c; cnt += (c > 0u) ? 1u : 0u; mine = (j == x) ? c : mine; }
        if (sum == G) break;
        __builtin_amdgcn_s_sleep(1);
        if ((++sp & 255u) == 0u) { if (xb_ld(&bar[XB_TMO])) break; if (sp > XB_SPIN_CAP) { atomicAdd(&bar[XB_TMO], 1u); break; } }
    }
    nloc = mine > 0u ? mine : 1u; nx = cnt > 0u ? cnt : 1u;
}
__device__ __forceinline__ void xcd_barrier(const XcdBarrier& b) {
    asm volatile("s_waitcnt vmcnt(0)" ::: "memory");
    __syncthreads();
    if (threadIdx.x == 0) {
        unsigned* bar = b.bar;
        __builtin_amdgcn_s_waitcnt(0);
        unsigned nloc = b.st[0], nx = b.st[1];
        if (nloc == 0u) { xcd_barrier_complete(bar, b.x, nloc, nx); b.st[0] = nloc; b.st[1] = nx; }
        const unsigned old = xb_add(&bar[XB_XSUB(b.x)], 1u);
        const unsigned gen = old / nloc;
        if (old + 1u == (gen + 1u) * nloc) {
            __builtin_amdgcn_fence(__ATOMIC_RELEASE, "agent");
            asm volatile("s_waitcnt vmcnt(0)" ::: "memory");
            const unsigned og = xb_add(&bar[XB_TOP], 1u);
            const unsigned tg = og / nx;
            if (og + 1u == (tg + 1u) * nx) xb_add(&bar[XB_TOPGEN], 1u);
            else XB_SPIN(xb_ld(&bar[XB_TOPGEN]) == tg, bar);
            __builtin_amdgcn_fence(__ATOMIC_ACQUIRE, "agent");
            xb_add(&bar[XB_XGEN(b.x)], 1u);
            asm volatile("s_waitcnt vmcnt(0)" ::: "memory");
        } else {
            XB_SPIN(xb_ld(&bar[XB_XGEN(b.x)]) == gen, bar);
            __builtin_amdgcn_fence(__ATOMIC_ACQUIRE, "agent");
            asm volatile("s_waitcnt vmcnt(0)" ::: "memory");
        }
    }
    __syncthreads();
}

namespace pg8 {
typedef float f32x4 __attribute__((ext_vector_type(4)));
typedef unsigned u32x4 __attribute__((ext_vector_type(4)));
constexpr int BM = 256, BK = 64, HALF = 128, HTB = HALF * BK * 2, STAGE_BYTES = 8 * HTB, NXCD = 8, WGM = 8;
__host__ __device__ __forceinline__ int lds_byte(int r, int c) { const int st = (r >> 4) * 2 + (c >> 5), rr = r & 15, cc = c & 31, ob = rr * 64 + cc * 2; return st * 1024 + (ob ^ (((ob >> 9) & 1) << 5)); }
__host__ __device__ __forceinline__ void stage_rc(int b, int& R, int& C) { const int st = b / 1024, sb = b % 1024, swz = sb ^ (((sb >> 9) & 1) << 5); R = (st >> 1) * 16 + swz / 64; C = (st & 1) * 32 + (swz % 64) / 2; }
__host__ __device__ __forceinline__ int perm32(int rho) { const int n = rho >> 4, i = rho & 15; return 8 * (i >> 2) + 4 * n + (i & 3); }
struct Unit { int pm, pn; };
struct Gemm { const h16* A; const h16* Bt; int M, N, K, lda; int ldb; long a_pn_bytes, b_pn_bytes; };
struct StaticOrder {
    int nM, nN, nwg, G, c;
    __host__ __device__ void init(int M, int N, int G_, int c_) { nM = M / BM; nN = N / BM; nwg = nM * nN; G = G_; c = c_; }
    __host__ __device__ bool next(int i, Unit& u) const {
        const long L = (long)i * G + c; if (L >= nwg) return false;
        int wgid = (int)L; { const int q = nwg / NXCD, r = nwg % NXCD, xcd = wgid % NXCD, off = wgid / NXCD; wgid = (xcd < r ? xcd * (q + 1) : r * (q + 1) + (xcd - r) * q) + off; }
        const int nig = WGM * nN, gid = wgid / nig, fm = gid * WGM, gsz = (nM - fm) < WGM ? (nM - fm) : WGM;
        u.pm = fm + ((wgid % nig) % gsz); u.pn = (wgid % nig) / gsz; return true;
    }
};
template <class Epi, class Sched, bool ALIGN_EPI, bool SP2, bool SWAP = false>
__device__ __forceinline__ void gemm_phase(LAS unsigned char* lds, const Gemm g, const Sched& S, const Epi& E) {
    const int tid = threadIdx.x, wid = __builtin_amdgcn_readfirstlane(tid >> 6), lane = tid & 63, wr = wid >> 2, wc = wid & 3, fr = lane & 15, fq = lane >> 4;
    const int K = g.K, nt = K / BK, lda = g.lda, ldb = g.ldb;
    unsigned voffA[2], voffB[2];
#pragma unroll
    for (int i = 0; i < 2; ++i) { int R, C; stage_rc(tid * 16 + i * 8192, R, C); const int Rb = Epi::PERM ? ((R & ~31) + perm32(R & 31)) : R;
        voffA[i] = (unsigned)(R * lda + C) * 2u; voffB[i] = (unsigned)(Rb * ldb + C) * 2u; }
    const size_t kstep = (size_t)(BK * 2);
    const size_t hstepA = (size_t)HALF * lda * 2, hstepB = (size_t)HALF * ldb * 2;
    const size_t tstepA = 2 * hstepA; const long apn = g.a_pn_bytes, bpn = g.b_pn_bytes;
    const unsigned ldsw = (unsigned)wid * 1024u;
    const int aoff = lds_byte(wr * 64 + fr, fq * 8), boff = lds_byte(wc * 32 + fr, fq * 8);
#define PG8_SA(b, h) (((b) * 2 + (h)) * HTB)
#define PG8_SB(b, h) ((4 + (b) * 2 + (h)) * HTB)
#define PG8_STAGE(bufoff, gbase, voff) do { _Pragma("unroll") for (int _i = 0; _i < 2; ++_i) \
        __builtin_amdgcn_global_load_lds((const unsigned*)((const char*)(gbase) + (voff)[_i]), (LAS unsigned*)(lds + (bufoff) + ldsw + _i * 8192), 16, 0, 0); } while (0)
#define PG8_LDA(dst, b, h) do { _Pragma("unroll") for (int m = 0; m < 4; ++m) _Pragma("unroll") for (int k = 0; k < 2; ++k) dst[m][k] = *(const LAS h16x8*)(lds + PG8_SA(b, h) + aoff + m * 2048 + k * 1024); } while (0)
#define PG8_LDB(dst, b, h) do { _Pragma("unroll") for (int n = 0; n < 2; ++n) _Pragma("unroll") for (int k = 0; k < 2; ++k) dst[n][k] = *(const LAS h16x8*)(lds + PG8_SB(b, h) + boff + n * 2048 + k * 1024); } while (0)
#define PG8_MMA(ai, bj, At, Bt) do { __builtin_amdgcn_s_setprio(1); _Pragma("unroll") for (int m = 0; m < 4; ++m) _Pragma("unroll") for (int n = 0; n < 2; ++n) _Pragma("unroll") for (int k = 0; k < 2; ++k) \
        acc[ai][bj][m][n] = SWAP ? __builtin_amdgcn_mfma_f32_16x16x32_f16(At[m][k], Bt[n][k], acc[ai][bj][m][n], 0, 0, 0) : __builtin_amdgcn_mfma_f32_16x16x32_f16(Bt[n][k], At[m][k], acc[ai][bj][m][n], 0, 0, 0); __builtin_amdgcn_s_setprio(0); } while (0)
#define PG8_WAIT_V(n) asm volatile("s_waitcnt vmcnt(" #n ")" ::: "memory")
#define PG8_WAIT_L(n) asm volatile("s_waitcnt lgkmcnt(" #n ")" ::: "memory")
#define PG8_BAR __builtin_amdgcn_s_barrier()
#define PG8_SCHED __builtin_amdgcn_sched_barrier(0)
    Unit cur, nxt; int ui = 0;
    if (!S.next(0, cur)) return;
    f32x4 acc[2][2][4][2];
#pragma unroll
    for (int a = 0; a < 2; ++a)
#pragma unroll
        for (int b = 0; b < 2; ++b)
#pragma unroll
            for (int m = 0; m < 4; ++m)
#pragma unroll
                for (int n = 0; n < 2; ++n) acc[a][b][m][n] = (f32x4){0.f, 0.f, 0.f, 0.f};
    h16x8 At[4][2], B0[2][2], B1[2][2];
    const char* cA = (const char*)g.A + (size_t)cur.pm * tstepA + (long)cur.pn * apn; const char* cB = (const char*)g.Bt + (long)cur.pn * bpn;
    if constexpr (SP2) {
        PG8_STAGE(PG8_SB(0, 0), cB, voffB); PG8_STAGE(PG8_SB(0, 1), cB + hstepB, voffB); PG8_STAGE(PG8_SA(0, 0), cA, voffA); PG8_STAGE(PG8_SA(0, 1), cA + hstepA, voffA);
        if (wr == 1) PG8_BAR;
        PG8_WAIT_V(2); PG8_BAR;
        PG8_STAGE(PG8_SB(1, 0), cB + kstep, voffB); PG8_STAGE(PG8_SA(1, 0), cA + kstep, voffA); PG8_STAGE(PG8_SB(1, 1), cB + hstepB + kstep, voffB);
        PG8_WAIT_V(6); PG8_BAR;
    } else {
        PG8_STAGE(PG8_SB(0, 0), cB, voffB); PG8_STAGE(PG8_SA(0, 0), cA, voffA); PG8_STAGE(PG8_SB(0, 1), cB + hstepB, voffB); PG8_STAGE(PG8_SA(0, 1), cA + hstepA, voffA);
        if (wr == 1) PG8_BAR;
        PG8_WAIT_V(4); PG8_BAR;
        PG8_STAGE(PG8_SB(1, 0), cB + kstep, voffB); PG8_STAGE(PG8_SA(1, 0), cA + kstep, voffA); PG8_STAGE(PG8_SB(1, 1), cB + hstepB + kstep, voffB);
        PG8_WAIT_V(6); PG8_BAR;
    }
    for (;;) {
        const bool has_next = S.next(ui + 1, nxt);
        const char* nA = has_next ? (const char*)g.A + (size_t)nxt.pm * tstepA + (long)nxt.pn * apn : cA; const char* nB = has_next ? (const char*)g.Bt + (long)nxt.pn * bpn : cB;
        for (int t = 0; t < nt; t += 2) {
            const bool last = (t == nt - 2);
            const char* a1 = cA + (size_t)(t + 1) * kstep;
            const char* a2 = last ? nA : cA + (size_t)(t + 2) * kstep; const char* b2 = last ? nB : cB + (size_t)(t + 2) * kstep;
            const char* a3 = a2 + kstep; const char* b3 = b2 + kstep;
            if constexpr (SP2) {
            PG8_LDB(B0, 0, 0); PG8_LDB(B1, 0, 1); PG8_SCHED; PG8_LDA(At, 0, 0); PG8_STAGE(PG8_SA(1, 1), a1 + hstepA, voffA);
            PG8_WAIT_V(8); PG8_WAIT_L(0); PG8_BAR; PG8_MMA(0, 0, At, B0); PG8_MMA(0, 1, At, B1); PG8_BAR; PG8_SCHED;
            PG8_LDA(At, 0, 1); PG8_STAGE(PG8_SB(0, 0), b2, voffB); PG8_STAGE(PG8_SB(0, 1), b2 + hstepB, voffB); PG8_STAGE(PG8_SA(0, 0), a2, voffA);
            PG8_WAIT_V(8); PG8_WAIT_L(0); PG8_BAR; PG8_MMA(1, 0, At, B0); PG8_MMA(1, 1, At, B1); PG8_BAR; PG8_SCHED;
            PG8_LDB(B0, 1, 0); PG8_LDB(B1, 1, 1); PG8_SCHED; PG8_LDA(At, 1, 0); PG8_STAGE(PG8_SA(0, 1), a2 + hstepA, voffA);
            PG8_WAIT_V(8); PG8_WAIT_L(0); PG8_BAR; PG8_MMA(0, 0, At, B0); PG8_MMA(0, 1, At, B1); PG8_BAR; PG8_SCHED;
            PG8_LDA(At, 1, 1); PG8_STAGE(PG8_SB(1, 0), b3, voffB); PG8_STAGE(PG8_SB(1, 1), b3 + hstepB, voffB); PG8_STAGE(PG8_SA(1, 0), a3, voffA);
            PG8_WAIT_V(8); PG8_WAIT_L(0); PG8_BAR; PG8_MMA(1, 0, At, B0); PG8_MMA(1, 1, At, B1); PG8_BAR; PG8_SCHED;
            } else {
            PG8_LDB(B0, 0, 0); PG8_SCHED; PG8_LDA(At, 0, 0); PG8_STAGE(PG8_SA(1, 1), a1 + hstepA, voffA);
            PG8_WAIT_L(8); PG8_BAR; PG8_WAIT_L(0); PG8_MMA(0, 0, At, B0); PG8_BAR; PG8_SCHED;
            PG8_LDB(B1, 0, 1); PG8_STAGE(PG8_SB(0, 0), b2, voffB);
            PG8_BAR; PG8_WAIT_L(0); PG8_MMA(0, 1, At, B1); PG8_BAR;
            PG8_LDA(At, 0, 1); PG8_STAGE(PG8_SA(0, 0), a2, voffA);
            PG8_BAR; PG8_WAIT_L(0); PG8_MMA(1, 0, At, B0); PG8_BAR; PG8_SCHED;
            PG8_STAGE(PG8_SB(0, 1), b2 + hstepB, voffB);
            PG8_WAIT_V(6); PG8_BAR; PG8_MMA(1, 1, At, B1); PG8_BAR;
            PG8_LDB(B0, 1, 0); PG8_SCHED; PG8_LDA(At, 1, 0); PG8_STAGE(PG8_SA(0, 1), a2 + hstepA, voffA);
            PG8_WAIT_L(8); PG8_BAR; PG8_WAIT_L(0); PG8_MMA(0, 0, At, B0); PG8_BAR; PG8_SCHED;
            PG8_LDB(B1, 1, 1); PG8_STAGE(PG8_SB(1, 0), b3, voffB);
            PG8_BAR; PG8_WAIT_L(0); PG8_MMA(0, 1, At, B1); PG8_BAR;
            PG8_LDA(At, 1, 1); PG8_STAGE(PG8_SA(1, 0), a3, voffA);
            PG8_BAR; PG8_WAIT_L(0); PG8_MMA(1, 0, At, B0); PG8_BAR; PG8_SCHED;
            PG8_STAGE(PG8_SB(1, 1), b3 + hstepB, voffB);
            PG8_WAIT_V(6); PG8_BAR; PG8_MMA(1, 1, At, B1); PG8_BAR;
            }
        }
        if constexpr (ALIGN_EPI) { if (wr == 0) PG8_BAR; }
        E(acc, cur, wr, wc, fr, fq);
        if (!has_next) break;
#pragma unroll
        for (int a = 0; a < 2; ++a)
#pragma unroll
            for (int b = 0; b < 2; ++b)
#pragma unroll
                for (int m = 0; m < 4; ++m)
#pragma unroll
                    for (int n = 0; n < 2; ++n) acc[a][b][m][n] = (f32x4){0.f, 0.f, 0.f, 0.f};
        cur = nxt; cA = nA; cB = nB; ++ui;
        if constexpr (ALIGN_EPI) { if (wr == 1) PG8_BAR; }
    }
    PG8_WAIT_V(0);
    if constexpr (!ALIGN_EPI) { if (wr == 0) PG8_BAR; }
    PG8_BAR;
#undef PG8_SA
#undef PG8_SB
#undef PG8_STAGE
#undef PG8_LDA
#undef PG8_LDB
#undef PG8_MMA
#undef PG8_WAIT_V
#undef PG8_WAIT_L
#undef PG8_BAR
#undef PG8_SCHED
}
__device__ __forceinline__ u32x4 pack8(const f32x4& a, const f32x4& b) {
    h16x8 o; o[0] = (h16)a[0]; o[1] = (h16)a[1]; o[2] = (h16)a[2]; o[3] = (h16)a[3]; o[4] = (h16)b[0]; o[5] = (h16)b[1]; o[6] = (h16)b[2]; o[7] = (h16)b[3];
    return __builtin_bit_cast(u32x4, o);
}
typedef f32x4 AccT[2][2][4][2];

struct EpiRetInF {
    static constexpr bool PERM = true;
    h16 *Q0, *K0, *KT, *G0; const float *RC, *RS;
    __device__ __forceinline__ void operator()(const AccT& acc, const Unit& u, int wr, int wc, int fr, int fq) const {
        const int row0 = u.pm * BM + wr * 64 + fr, c0 = wc * 32 + 8 * fq;
        if (u.pn < 8) {
            const bool isk = u.pn >= 4; const int hh = u.pn & 3; h16* dst = (isk ? K0 : Q0) + hh * 256; const float sc = isk ? 0.0625f : 1.f;
#pragma unroll
            for (int ai = 0; ai < 2; ++ai)
#pragma unroll
                for (int m = 0; m < 4; ++m) { const int row = row0 + ai * HALF + m * 16, t = row & (T - 1), b = row >> 13;
                    const f32x4 cs0 = *(const f32x4*)(RC + t * 128 + c0), cs1 = *(const f32x4*)(RC + t * 128 + c0 + 4), sn0 = *(const f32x4*)(RS + t * 128 + c0), sn1 = *(const f32x4*)(RS + t * 128 + c0 + 4);
                    const f32x4 x10 = acc[ai][0][m][0], x11 = acc[ai][0][m][1], x20 = acc[ai][1][m][0], x21 = acc[ai][1][m][1];
                    const f32x4 a0 = (x10 * cs0 - x20 * sn0) * sc, a1 = (x11 * cs1 - x21 * sn1) * sc, b0 = (x10 * sn0 + x20 * cs0) * sc, b1 = (x11 * sn1 + x21 * cs1) * sc;
                    h16* rp = dst + (size_t)row * 1024 + c0;
                    *(u32x4*)rp = pack8(a0, a1); *(u32x4*)(rp + 128) = pack8(b0, b1);
                    if (isk) { h16* kt = KT + ((size_t)(b * 4 + hh) * 256 + c0) * T + t;
#pragma unroll
                        for (int e = 0; e < 4; ++e) { kt[(size_t)e * T] = (h16)a0[e]; kt[(size_t)(e + 4) * T] = (h16)a1[e]; kt[(size_t)(e + 128) * T] = (h16)b0[e]; kt[(size_t)(e + 132) * T] = (h16)b1[e]; } } }
        } else {
            h16* dst = G0 + (u.pn - 8) * 256;
#pragma unroll
            for (int ai = 0; ai < 2; ++ai)
#pragma unroll
                for (int m = 0; m < 4; ++m) { h16* rp = dst + (size_t)(row0 + ai * HALF + m * 16) * 2048 + c0;
#pragma unroll
                    for (int bj = 0; bj < 2; ++bj) *(u32x4*)(rp + bj * HALF) = pack8(acc[ai][bj][m][0], acc[ai][bj][m][1]); }
        }
    }
};
struct EpiVT {
    static constexpr bool PERM = false;
    h16* dst; int ncols; size_t tile_stride;
    __device__ __forceinline__ void operator()(const AccT& acc, const Unit& u, int wr, int wc, int fr, int fq) const {
#pragma unroll
        for (int ai = 0; ai < 2; ++ai)
#pragma unroll
            for (int m = 0; m < 4; ++m) { const int tok = u.pm * BM + ai * HALF + wr * 64 + m * 16 + 4 * fq, b = tok >> 13, t = tok & (T - 1);
#pragma unroll
                for (int bj = 0; bj < 2; ++bj)
#pragma unroll
                    for (int n = 0; n < 2; ++n) { const int col = bj * HALF + wc * 32 + n * 16 + fr; const f32x4 v = acc[ai][bj][m][n];
                        h16x4 o; o[0] = (h16)v[0]; o[1] = (h16)v[1]; o[2] = (h16)v[2]; o[3] = (h16)v[3];
                        *(h16x4*)(dst + (size_t)u.pn * tile_stride + ((size_t)b * ncols + col) * T + t) = o; } }
    }
};
struct EpiF32F { static constexpr bool PERM = true; float* O; int ldc;
    __device__ __forceinline__ void operator()(const AccT& acc, const Unit& u, int wr, int wc, int fr, int fq) const {
        const int row0 = u.pm * BM + wr * 64 + fr, c0 = u.pn * BM + wc * 32 + 8 * fq;
#pragma unroll
        for (int ai = 0; ai < 2; ++ai)
#pragma unroll
            for (int m = 0; m < 4; ++m) { float* rp = O + (size_t)(row0 + ai * HALF + m * 16) * ldc + c0;
#pragma unroll
                for (int bj = 0; bj < 2; ++bj) { *(f32x4*)(rp + bj * HALF) = acc[ai][bj][m][0]; *(f32x4*)(rp + bj * HALF + 4) = acc[ai][bj][m][1]; } }
    }
};
struct EpiSlabF { static constexpr bool PERM = true; float* O; size_t slab;
    __device__ __forceinline__ void operator()(const AccT& acc, const Unit& u, int wr, int wc, int fr, int fq) const {
        const int row0 = u.pm * BM + wr * 64 + fr, c0 = wc * 32 + 8 * fq; float* ob = O + (size_t)u.pn * slab;
#pragma unroll
        for (int ai = 0; ai < 2; ++ai)
#pragma unroll
            for (int m = 0; m < 4; ++m) { float* rp = ob + (size_t)(row0 + ai * HALF + m * 16) * 256 + c0;
#pragma unroll
                for (int bj = 0; bj < 2; ++bj) { *(f32x4*)(rp + bj * HALF) = acc[ai][bj][m][0]; *(f32x4*)(rp + bj * HALF + 4) = acc[ai][bj][m][1]; } }
    }
};
struct EpiSwigluF { static constexpr bool PERM = true; h16* H;
    __device__ __forceinline__ void operator()(const AccT& acc, const Unit& u, int wr, int wc, int fr, int fq) const {
        const int row0 = u.pm * BM + wr * 64 + fr, c0 = u.pn * 128 + wc * 32 + 8 * fq;
#pragma unroll
        for (int ai = 0; ai < 2; ++ai)
#pragma unroll
            for (int m = 0; m < 4; ++m) { f32x4 o[2];
#pragma unroll
                for (int n = 0; n < 2; ++n)
#pragma unroll
                    for (int e = 0; e < 4; ++e) o[n][e] = silu_f(acc[ai][0][m][n][e]) * acc[ai][1][m][n][e];
                *(u32x4*)(H + (size_t)(row0 + ai * HALF + m * 16) * DFF + c0) = pack8(o[0], o[1]); }
    }
};
struct EpiKvqF {
    static constexpr bool PERM = true;
    h16* KV6; h16* QN; float* GATES; const float *NC, *NS;
    __device__ __forceinline__ void operator()(const AccT& acc, const Unit& u, int wr, int wc, int fr, int fq) const {
        const int row0 = u.pm * BM + wr * 64 + fr;
        const int pn = u.pn;
        if (pn == 8) {
            if (wc < 2) {
#pragma unroll
                for (int ai = 0; ai < 2; ++ai)
#pragma unroll
                    for (int m = 0; m < 4; ++m) { const int row = row0 + ai * HALF + m * 16; const int c = wc * 32 + 8 * fq;
                        if (c < 48) { f32x4 o0, o1;
#pragma unroll
                            for (int e = 0; e < 4; ++e) { o0[e] = sigmoid_f(acc[ai][0][m][0][e]); o1[e] = sigmoid_f(acc[ai][0][m][1][e]); }
                            *(f32x4*)(GATES + (size_t)row * 48 + c) = o0; *(f32x4*)(GATES + (size_t)row * 48 + c + 4) = o1; } }
            }
            return;
        }
        const bool rot = (pn != 1);
        const bool rlane = rot && ((wc & 1) == 0);
        const float sc = (pn >= 4) ? 0.125f : 1.f;
#pragma unroll
        for (int ai = 0; ai < 2; ++ai)
#pragma unroll
            for (int m = 0; m < 4; ++m) { const int row = row0 + ai * HALF + m * 16, t = row & (T - 1), b = row >> 13;
#pragma unroll
                for (int bj = 0; bj < 2; ++bj) { f32x4 v0 = acc[ai][bj][m][0], v1 = acc[ai][bj][m][1];
                    if (rlane) {
                        f32x4 p0, p1;
#pragma unroll
                        for (int e = 0; e < 4; ++e) { p0[e] = __shfl_xor(v0[e], 16); p1[e] = __shfl_xor(v1[e], 16); }
                        if (fq < 2) { const f32x4 cs0 = *(const f32x4*)(NC + t * 8), cs1 = *(const f32x4*)(NC + t * 8 + 4), sn0 = *(const f32x4*)(NS + t * 8), sn1 = *(const f32x4*)(NS + t * 8 + 4);
                            if (fq == 0) { v0 = v0 * cs0 - p0 * sn0; v1 = v1 * cs1 - p1 * sn1; } else { v0 = p0 * sn0 + v0 * cs0; v1 = p1 * sn1 + v1 * cs1; } }
                    }
                    v0 = v0 * sc; v1 = v1 * sc;
                    const int c = bj * HALF + wc * 32 + 8 * fq;
                    if (pn < 4) { const int g = c >> 6, d = c & 63; *(u32x4*)(KV6 + (size_t)pn * (8u * T * 64) + ((size_t)(b * 4 + g) * T + t) * 64 + d) = pack8(v0, v1); }
                    else *(u32x4*)(QN + (size_t)row * 1024 + (pn - 4) * 256 + c) = pack8(v0, v1); } }
    }
};
struct EpiCmpF { static constexpr bool PERM = true; h16* HC; const float* bias;
    __device__ __forceinline__ void operator()(const AccT& acc, const Unit& u, int wr, int wc, int fr, int fq) const {
        const int row0 = u.pm * BM + wr * 64 + fr;
#pragma unroll
        for (int bj = 0; bj < 2; ++bj) { const int c = bj * HALF + wc * 32 + 8 * fq; const f32x4 b0 = *(const f32x4*)(bias + c), b1 = *(const f32x4*)(bias + c + 4);
#pragma unroll
            for (int ai = 0; ai < 2; ++ai)
#pragma unroll
                for (int m = 0; m < 4; ++m) { f32x4 o0, o1;
#pragma unroll
                    for (int e = 0; e < 4; ++e) { o0[e] = gelu_tanh_f(acc[ai][bj][m][0][e] + b0[e]); o1[e] = gelu_tanh_f(acc[ai][bj][m][1][e] + b1[e]); }
                    *(u32x4*)(HC + (size_t)(row0 + ai * HALF + m * 16) * 256 + c) = pack8(o0, o1); } }
    }
};
}

#define MFMA16(a, b, c) __builtin_amdgcn_mfma_f32_16x16x32_f16((a), (b), (c), 0, 0, 0)
__device__ __forceinline__ void f_ret_state(const h16* KT, const h16* VT, h16* SS) {
    const int tid = threadIdx.x, lane = tid & 63, w = tid >> 6, fr = lane & 15, kg = lane >> 4;
    for (int it = blockIdx.x; it < 256; it += gridDim.x) {
        const int bh = it & 7, rem = it >> 3, dvt = rem >> 2, dkt = rem & 3, b = bh >> 2, h = bh & 3;
        const float lg = ret_lg(h), g32 = __expf(32.f * lg);
        const int dvr = dvt * 64 + (w >> 1) * 16, dkc = dkt * 64 + (w & 1) * 32;
        const h16* vrow = VT + ((size_t)b * 2048 + h * 512 + dvr + fr) * T + 8 * kg;
        const h16* krow0 = KT + ((size_t)bh * 256 + dkc + fr) * T + 8 * kg;
        const h16* krow1 = krow0 + (size_t)16 * T;
        h16x8 dec;
#pragma unroll
        for (int j = 0; j < 8; ++j) dec[j] = (h16)__expf(lg * (float)(31 - 8 * kg - j));
        f32x4 acc0 = {0.f, 0.f, 0.f, 0.f}, acc1 = {0.f, 0.f, 0.f, 0.f};
        h16x8 a0[4], p0[4], q0[4], a1[4], p1[4], q1[4];
#define RS_LOAD(A, P, Q, grp) { _Pragma("unroll") for (int s2 = 0; s2 < 4; ++s2) { const int tok = ((grp) * 4 + s2) * 32; A[s2] = *(const h16x8*)(vrow + tok); P[s2] = *(const h16x8*)(krow0 + tok); Q[s2] = *(const h16x8*)(krow1 + tok); } asm volatile("" ::: "memory"); }
#define RS_COMP(A, P, Q) { _Pragma("unroll") for (int s2 = 0; s2 < 4; ++s2) { const h16x8 a = A[s2] * dec; acc0 = acc0 * g32; acc1 = acc1 * g32; acc0 = MFMA16(a, P[s2], acc0); acc1 = MFMA16(a, Q[s2], acc1); } }
        RS_LOAD(a0, p0, q0, 0)
        constexpr int NGRP = (NSUP - 1) * 4;
        for (int gp = 0; gp < NGRP; gp += 2) {
            RS_LOAD(a1, p1, q1, gp + 1)
            RS_COMP(a0, p0, q0)
            if (gp + 2 < NGRP) RS_LOAD(a0, p0, q0, gp + 2)
            RS_COMP(a1, p1, q1)
            if ((gp & 3) == 2) { const int ms = gp >> 2;
                h16* sp = SS + (((size_t)bh * (NSUP - 1) + ms) * 512 + dvr + 4 * kg) * 256 + dkc + fr;
#pragma unroll
                for (int r = 0; r < 4; ++r) { sp[(size_t)r * 256] = (h16)acc0[r]; sp[(size_t)r * 256 + 16] = (h16)acc1[r]; } }
        }
#undef RS_LOAD
#undef RS_COMP
    }
}
__device__ __forceinline__ void f_ret_out(const h16* Q0, const h16* K0, const h16* VT, const h16* G0, const h16* SS, const float* gn, h16* Y, LAS unsigned char* lds) {
    const int tid = threadIdx.x, lane = tid & 63, w = __builtin_amdgcn_readfirstlane(tid >> 6), fr = lane & 15, kg = lane >> 4;
    LAS unsigned char* QL = lds; LAS unsigned char* KL = lds + 32768; LAS unsigned char* PL = lds + 65536; LAS float* RED = (LAS float*)(lds + 81920);
    for (int it = blockIdx.x; it < 1024; it += gridDim.x) {
        const int c = it & 255, ii = it >> 8, bh = c & 7, u = c >> 3, sup = u >> 1, half = u & 1;
        const int j = (ii < 2) ? (half * 2 + ii) : (7 - half * 2 - (ii - 2));
        const int b = bh >> 2, h = bh & 3, tok0 = sup * SUP + j * 64, m0 = b * T + tok0;
        const float lgh = ret_lg(h);
        h16x8 kreg[4];
#pragma unroll
        for (int i = 0; i < 4; ++i) { const int id = tid + 512 * i, row = id >> 5, cch = id & 31;
            const h16x8 v = *(const h16x8*)(Q0 + (size_t)(m0 + row) * 1024 + h * 256 + cch * 8);
            *(LAS h16x8*)(QL + row * 512 + ((cch ^ (row & 15)) << 4)) = v;
            kreg[i] = *(const h16x8*)(K0 + (size_t)(b * T + sup * SUP + row) * 1024 + h * 256 + cch * 8); }
        __syncthreads();
        f32x4 acc[4][4];
#pragma unroll
        for (int mt = 0; mt < 4; ++mt)
#pragma unroll
            for (int nt = 0; nt < 4; ++nt) acc[mt][nt] = (f32x4){0.f, 0.f, 0.f, 0.f};
        if (sup > 0) {
            const h16* sp = SS + (((size_t)bh * (NSUP - 1) + sup - 1) * 512 + 64 * w + fr) * 256 + 8 * kg;
#pragma unroll 2
            for (int ks = 0; ks < 8; ++ks) {
                h16x8 af[4], bf[4];
#pragma unroll
                for (int mt = 0; mt < 4; ++mt) af[mt] = *(const h16x8*)(sp + (size_t)mt * 16 * 256 + 32 * ks);
#pragma unroll
                for (int nt = 0; nt < 4; ++nt) { const int row = 16 * nt + fr; bf[nt] = *(const LAS h16x8*)(QL + row * 512 + (((4 * ks + kg) ^ (row & 15)) << 4)); }
#pragma unroll
                for (int mt = 0; mt < 4; ++mt)
#pragma unroll
                    for (int nt = 0; nt < 4; ++nt) acc[mt][nt] = MFMA16(af[mt], bf[nt], acc[mt][nt]);
            }
#pragma unroll
            for (int nt = 0; nt < 4; ++nt) { const float qd = __expf(lgh * (float)(j * 64 + 16 * nt + fr + 1));
#pragma unroll
                for (int mt = 0; mt < 4; ++mt) acc[mt][nt] = acc[mt][nt] * qd; }
        }
        const int kw = w & 3, tw = w >> 2;
        for (int kt = 0; kt <= j; ++kt) {
            const int key0 = sup * SUP + kt * 64;
#pragma unroll
            for (int i = 0; i < 4; ++i) { const int id = tid + 512 * i, row = id >> 5, cch = id & 31; *(LAS h16x8*)(KL + row * 512 + ((cch ^ (row & 15)) << 4)) = kreg[i]; }
            if (kt < j) {
#pragma unroll
                for (int i = 0; i < 4; ++i) { const int id = tid + 512 * i, row = id >> 5, cch = id & 31; kreg[i] = *(const h16x8*)(K0 + (size_t)(b * T + key0 + 64 + row) * 1024 + h * 256 + cch * 8); }
            }
            h16x8 av[4][2];
#pragma unroll
            for (int mt = 0; mt < 4; ++mt)
#pragma unroll
                for (int ks = 0; ks < 2; ++ks) av[mt][ks] = *(const h16x8*)(VT + ((size_t)b * 2048 + h * 512 + 64 * w + 16 * mt + fr) * T + key0 + 32 * ks + 8 * kg);
            __syncthreads();
            f32x4 s[2] = {{0.f, 0.f, 0.f, 0.f}, {0.f, 0.f, 0.f, 0.f}};
#pragma unroll
            for (int ks = 0; ks < 8; ++ks) {
                const int kr = 16 * kw + fr; const h16x8 a = *(const LAS h16x8*)(KL + kr * 512 + (((4 * ks + kg) ^ (kr & 15)) << 4));
#pragma unroll
                for (int n = 0; n < 2; ++n) { const int qr = 32 * tw + 16 * n + fr; const h16x8 bq = *(const LAS h16x8*)(QL + qr * 512 + (((4 * ks + kg) ^ (qr & 15)) << 4)); s[n] = MFMA16(a, bq, s[n]); }
            }
            LAS unsigned char* PB = PL + (kt & 1) * 8192;
#pragma unroll
            for (int n = 0; n < 2; ++n) { const int tl = 32 * tw + 16 * n + fr; h16x4 p;
#pragma unroll
                for (int r = 0; r < 4; ++r) { const int dlt = (tok0 + tl) - (key0 + 16 * kw + 4 * kg + r); p[r] = (h16)((dlt >= 0) ? s[n][r] * __expf(lgh * (float)dlt) : 0.f); }
                *(LAS h16x4*)(PB + tl * 128 + (((2 * kw + (kg >> 1)) ^ (tl & 7)) << 4) + (kg & 1) * 8) = p; }
            __syncthreads();
#pragma unroll
            for (int ks = 0; ks < 2; ++ks) {
                h16x8 bp[4];
#pragma unroll
                for (int nt = 0; nt < 4; ++nt) { const int tl = 16 * nt + fr; bp[nt] = *(const LAS h16x8*)(PB + tl * 128 + (((4 * ks + kg) ^ (tl & 7)) << 4)); }
#pragma unroll
                for (int mt = 0; mt < 4; ++mt)
#pragma unroll
                    for (int nt = 0; nt < 4; ++nt) acc[mt][nt] = MFMA16(av[mt][ks], bp[nt], acc[mt][nt]);
            }
        }
        float mean[4], rstd[4];
#pragma unroll
        for (int nt = 0; nt < 4; ++nt) { float s1 = 0.f, s2 = 0.f;
#pragma unroll
            for (int mt = 0; mt < 4; ++mt)
#pragma unroll
                for (int r = 0; r < 4; ++r) { const float x = acc[mt][nt][r]; s1 += x; s2 += x * x; }
            s1 += __shfl_xor(s1, 16); s1 += __shfl_xor(s1, 32); s2 += __shfl_xor(s2, 16); s2 += __shfl_xor(s2, 32);
            if (kg == 0) { RED[(w * 64 + 16 * nt + fr) * 2] = s1; RED[(w * 64 + 16 * nt + fr) * 2 + 1] = s2; } }
        __syncthreads();
#pragma unroll
        for (int nt = 0; nt < 4; ++nt) { float s1 = 0.f, s2 = 0.f;
#pragma unroll
            for (int ww = 0; ww < 8; ++ww) { s1 += RED[(ww * 64 + 16 * nt + fr) * 2]; s2 += RED[(ww * 64 + 16 * nt + fr) * 2 + 1]; }
            mean[nt] = s1 * (1.f / DV); rstd[nt] = rsqrtf(fmaxf(s2 * (1.f / DV) - mean[nt] * mean[nt], 0.f) + EPS); }
#pragma unroll
        for (int mt = 0; mt < 4; ++mt) { const int dv = 64 * w + 16 * mt + 4 * kg; const f32x4 gv = *(const f32x4*)(gn + h * 512 + dv);
#pragma unroll
            for (int nt = 0; nt < 4; ++nt) { const size_t off = (size_t)(m0 + 16 * nt + fr) * 2048 + h * 512 + dv; const h16x4 gg = *(const h16x4*)(G0 + off); h16x4 yo;
#pragma unroll
                for (int r = 0; r < 4; ++r) yo[r] = (h16)(silu_f((float)gg[r]) * (acc[mt][nt][r] - mean[nt]) * rstd[nt] * gv[r]);
                *(h16x4*)(Y + off) = yo; } }
        __syncthreads();
    }
}

typedef float f32x16 __attribute__((ext_vector_type(16)));
#define MFMA32(a, b, c) __builtin_amdgcn_mfma_f32_32x32x16_f16((a), (b), (c), 0, 0, 0)
namespace nsa {
constexpr int KB_OFF = 0, VB_OFF = 32768, SEL_OFF = 65536, OUT_OFF = 66560, OUT_ROW = 272, OUT_WAVE = 32 * OUT_ROW;
enum { M_WIN = 0, M_CMP1 = 1, M_CMP2 = 2, M_SEL = 3 };
__device__ __forceinline__ int crow(int reg, int hh) { return (reg & 3) + 8 * (reg >> 2) + 4 * hh; }
struct Ctx { int tq, nvq; unsigned sel0, sel1, sel2, sel3; float m, l; float cm, cinv, prev; };

typedef _Float16 h16x2_t __attribute__((ext_vector_type(2)));
typedef float f32x2_t __attribute__((ext_vector_type(2)));
__device__ __forceinline__ unsigned pk2h(float lo, float hi) { const f32x2_t v = {lo, hi}; return __builtin_bit_cast(unsigned, __builtin_convertvector(v, h16x2_t)); }
typedef unsigned u32x4_t __attribute__((ext_vector_type(4)));
constexpr float L2E = 1.4426950408889634f;
template <int MODE>
__device__ __forceinline__ void stream(LAS unsigned char* lds, const h16* Kg, const h16* Vg, int vlen, int tile_lo, int tile_hi, bool lowmask, int nvq0, const h16x8& qf0, const h16x8& qf1, const h16x8& qf2, const h16x8& qf3, Ctx& cx, f32x16& o0, f32x16& o1, LAS float* impw) {
    constexpr bool PV = (MODE != M_CMP1);
    const int tid = threadIdx.x, lane = tid & 63, col = lane & 31, hh = lane >> 5, wv = __builtin_amdgcn_readfirstlane(tid >> 6);
    const int srow = tid >> 3, slc = (tid & 7) ^ ((srow >> 1) & 7);
    const h16* kgp = Kg + (size_t)srow * 64 + slc * 8; const h16* vgp = Vg + (size_t)srow * vlen + slc * 8;
    const int xs = (col >> 1) & 7;
#define NSA_DMA(tile, slot) do { __builtin_amdgcn_global_load_lds((const unsigned*)(kgp + (size_t)(tile) * 4096), (LAS unsigned*)(lds + KB_OFF + (slot) * 8192 + wv * 1024), 16, 0, 0); \
        if (PV) __builtin_amdgcn_global_load_lds((const unsigned*)(vgp + (size_t)(tile) * 64), (LAS unsigned*)(lds + VB_OFF + (slot) * 8192 + wv * 1024), 16, 0, 0); } while (0)
    NSA_DMA(tile_lo, 0);
    if (tile_lo + 1 <= tile_hi) NSA_DMA(tile_lo + 1, 1);
    if (tile_lo + 2 <= tile_hi) NSA_DMA(tile_lo + 2, 2);
    for (int ti = tile_lo; ti <= tile_hi; ++ti) {
        const int buf = (ti - tile_lo) & 3;
        if (ti + 2 <= tile_hi) { if (PV) asm volatile("s_waitcnt vmcnt(4)" ::: "memory"); else asm volatile("s_waitcnt vmcnt(2)" ::: "memory"); }
        else if (ti + 1 <= tile_hi) { if (PV) asm volatile("s_waitcnt vmcnt(2)" ::: "memory"); else asm volatile("s_waitcnt vmcnt(1)" ::: "memory"); }
        else asm volatile("s_waitcnt vmcnt(0)" ::: "memory");
        __builtin_amdgcn_s_barrier(); asm volatile("" ::: "memory");
        if (ti + 3 <= tile_hi) NSA_DMA(ti + 3, (buf + 3) & 3);
        bool selj = true;
        if (MODE == M_SEL) { const unsigned wsel = (ti < 32) ? cx.sel0 : (ti < 64) ? cx.sel1 : (ti < 96) ? cx.sel2 : cx.sel3; selj = ((wsel >> (ti & 31)) & 1u) != 0u; }
        if (MODE != M_SEL || __any(selj)) {
            f32x16 s0, s1;
#pragma unroll
            for (int r = 0; r < 16; ++r) { s0[r] = 0.f; s1[r] = 0.f; }
            const LAS unsigned char* kb = lds + KB_OFF + buf * 8192 + col * 128;
#pragma unroll
            for (int ks = 0; ks < 4; ++ks) { const int co = ((2 * ks + hh) ^ xs) << 4;
                const h16x8 a0 = *(const LAS h16x8*)(kb + co), a1 = *(const LAS h16x8*)(kb + 32 * 128 + co);
                const h16x8 qq = (ks == 0) ? qf0 : (ks == 1) ? qf1 : (ks == 2) ? qf2 : qf3;
                s0 = MFMA32(a0, qq, s0); s1 = MFMA32(a1, qq, s1); }
            const int key0 = ti * 64;
            if (MODE == M_WIN) {
                if (lowmask && ti == tile_lo) {
#pragma unroll
                    for (int r = 0; r < 16; ++r) { const int k0 = key0 + crow(r, hh); if (k0 + 511 < cx.tq) s0[r] = -INFINITY; if (k0 + 32 + 511 < cx.tq) s1[r] = -INFINITY; } }
            }
            if ((MODE == M_WIN || MODE == M_SEL) && ti == tile_hi) {
#pragma unroll
                for (int r = 0; r < 16; ++r) { const int k0 = key0 + crow(r, hh); if (k0 > cx.tq) s0[r] = -INFINITY; if (k0 + 32 > cx.tq) s1[r] = -INFINITY; } }
            if ((MODE == M_CMP1 || MODE == M_CMP2) && key0 + 64 > nvq0) {
#pragma unroll
                for (int r = 0; r < 16; ++r) { const int k0 = key0 + crow(r, hh); if (k0 >= cx.nvq) s0[r] = -INFINITY; if (k0 + 32 >= cx.nvq) s1[r] = -INFINITY; } }
            if (MODE == M_CMP2) {
                const float nm = -cx.cm * L2E;
#pragma unroll
                for (int r = 0; r < 16; ++r) { s0[r] = __builtin_amdgcn_exp2f(fmaf(s0[r], L2E, nm)) * cx.cinv; s1[r] = __builtin_amdgcn_exp2f(fmaf(s1[r], L2E, nm)) * cx.cinv; }
            } else {
                float mx = -INFINITY;
#pragma unroll
                for (int r = 0; r < 16; ++r) mx = fmaxf(mx, fmaxf(s0[r], s1[r]));
                mx = fmaxf(mx, __shfl_xor(mx, 32));
                float mnew = fmaxf(cx.m, mx);
                if (MODE == M_SEL) mnew = selj ? mnew : cx.m;
                const float muse0 = (mnew == -INFINITY) ? 0.f : mnew;
                const float alpha = __builtin_amdgcn_exp2f((cx.m - muse0) * L2E);
                const float nm = (MODE == M_SEL && !selj) ? -INFINITY : -muse0 * L2E;
                float rs = 0.f;
#pragma unroll
                for (int r = 0; r < 16; ++r) { s0[r] = __builtin_amdgcn_exp2f(fmaf(s0[r], L2E, nm)); s1[r] = __builtin_amdgcn_exp2f(fmaf(s1[r], L2E, nm)); rs += s0[r] + s1[r]; }
                rs += __shfl_xor(rs, 32);
                cx.l = cx.l * alpha + rs; cx.m = mnew;
                if (PV) { if (__any(alpha != 1.f)) { o0 = o0 * alpha; o1 = o1 * alpha; } }
            }
            if (PV) {
                const LAS unsigned char* vb = lds + VB_OFF + buf * 8192 + col * 128 + 8 * hh;
#pragma unroll
                for (int mt = 0; mt < 2; ++mt)
#pragma unroll
                    for (int s2 = 0; s2 < 2; ++s2) {
                        u32x4_t pw;
#pragma unroll
                        for (int e = 0; e < 4; ++e) pw[e] = mt ? pk2h(s1[8 * s2 + 2 * e], s1[8 * s2 + 2 * e + 1]) : pk2h(s0[8 * s2 + 2 * e], s0[8 * s2 + 2 * e + 1]);
                        const h16x8 pb = __builtin_bit_cast(h16x8, pw);
                        const int c0 = ((4 * mt + 2 * s2) ^ xs) << 4, c1 = ((4 * mt + 2 * s2 + 1) ^ xs) << 4;
#pragma unroll
                        for (int dt = 0; dt < 2; ++dt) {
                            const h16x4 lo = *(const LAS h16x4*)(vb + dt * 32 * 128 + c0), hi = *(const LAS h16x4*)(vb + dt * 32 * 128 + c1);
                            const h16x8 av = __builtin_shufflevector(lo, hi, 0, 1, 2, 3, 4, 5, 6, 7);
                            if (dt == 0) o0 = MFMA32(av, pb, o0); else o1 = MFMA32(av, pb, o1); }
                    }
            }
            if (MODE == M_CMP2) {
#pragma unroll
                for (int mt = 0; mt < 2; ++mt)
#pragma unroll
                    for (int rg = 0; rg < 4; ++rg) {
                        const float p0 = mt ? s1[4 * rg] : s0[4 * rg], p1 = mt ? s1[4 * rg + 1] : s0[4 * rg + 1], p2 = mt ? s1[4 * rg + 2] : s0[4 * rg + 2], p3 = mt ? s1[4 * rg + 3] : s0[4 * rg + 3];
                        const float A = 2.f * (p0 + p1 + p2) + p3; const float y = __shfl_xor(p3, 32);
                        float v = A + (hh ? y : cx.prev); if (!hh) cx.prev = y;
                        v += __shfl_xor(v, 1); v += __shfl_xor(v, 2);
                        if ((col & 3) == 0) impw[(col >> 2) * 128 + 16 * ti + 8 * mt + 2 * rg + hh] = v;
                    }
            }
        }
    }
    asm volatile("s_waitcnt lgkmcnt(0)" ::: "memory"); __builtin_amdgcn_s_barrier(); asm volatile("" ::: "memory");
#undef NSA_DMA
}
__device__ __forceinline__ void topk8(const LAS float* impw, int cur, int lane, LAS unsigned* out) {
    const int qi = lane >> 3, sub = lane & 7;
    float v[16];
#pragma unroll
    for (int q4 = 0; q4 < 4; ++q4) { const f32x4 t4 = *(const LAS f32x4*)(impw + qi * 128 + sub * 16 + 4 * q4); v[4 * q4] = t4[0]; v[4 * q4 + 1] = t4[1]; v[4 * q4 + 2] = t4[2]; v[4 * q4 + 3] = t4[3]; }
#pragma unroll
    for (int e = 0; e < 16; ++e) { const int s = sub * 16 + e; const bool cand = (s <= cur) && (s != 0) && (s != cur) && (s != cur - 1); v[e] = cand ? v[e] : -INFINITY; }
    unsigned m0 = 1u, m1 = 0u, m2 = 0u, m3 = 0u; int nsel = 1;
    if (cur >= 1) { const unsigned bit = 1u << (cur & 31); if (cur < 32) m0 |= bit; else if (cur < 64) m1 |= bit; else if (cur < 96) m2 |= bit; else m3 |= bit; ++nsel; }
    if (cur >= 2) { const int c1 = cur - 1; const unsigned bit = 1u << (c1 & 31); if (c1 < 32) m0 |= bit; else if (c1 < 64) m1 |= bit; else if (c1 < 96) m2 |= bit; else m3 |= bit; ++nsel; }
    for (; nsel < 16; ++nsel) {
        float bv = v[0]; int be = 0;
#pragma unroll
        for (int e = 1; e < 16; ++e) { if (v[e] > bv) { bv = v[e]; be = e; } }
        int bs = sub * 16 + be;
#pragma unroll
        for (int o = 1; o < 8; o <<= 1) { const float ov = __shfl_xor(bv, o); const int os = __shfl_xor(bs, o); if (ov > bv || (ov == bv && os < bs)) { bv = ov; bs = os; } }
        if (__all(bv == -INFINITY)) break;
        if (bv != -INFINITY) { const unsigned bit = 1u << (bs & 31); if (bs < 32) m0 |= bit; else if (bs < 64) m1 |= bit; else if (bs < 96) m2 |= bit; else m3 |= bit; }
        const int le = bs - sub * 16;
#pragma unroll
        for (int e = 0; e < 16; ++e) v[e] = (e == le) ? -INFINITY : v[e];
    }
    if (sub == 0) { out[qi * 4] = m0; out[qi * 4 + 1] = m1; out[qi * 4 + 2] = m2; out[qi * 4 + 3] = m3; }
}
__device__ __forceinline__ void phase(const h16* QN, const h16* KV6, const h16* CK, const h16* CVT, const float* GATES, h16* O1, LAS unsigned char* lds) {
    const int tid = threadIdx.x, lane = tid & 63, w = __builtin_amdgcn_readfirstlane(tid >> 6), col = lane & 31, hh = lane >> 5, ql = col >> 2, r = col & 3;
    const size_t SL = (size_t)8 * T * 64;
    LAS float* impw = (LAS float*)(lds + OUT_OFF + w * OUT_WAVE);
    LAS unsigned* selw = (LAS unsigned*)(lds + SEL_OFF) + w * 32;
    for (int it = blockIdx.x; it < 1024; it += gridDim.x) {
        const int c = it & 255, ii = it >> 8, bg = c & 7, u = c >> 3;
        const int qt = (ii == 0) ? u : (ii == 1) ? 63 - u : (ii == 2) ? 64 + u : 127 - u;
        const int b = bg >> 2, g = bg & 3, t0 = qt * 64, mrow = b * T + t0 + 8 * w + ql;
        Ctx cx; cx.tq = t0 + 8 * w + ql; cx.nvq = (cx.tq >= 31) ? ((cx.tq - 31) >> 4) + 1 : 0; cx.prev = 0.f;
        const h16* qp = QN + (size_t)mrow * 1024 + (g * 4 + r) * 64 + 8 * hh;
        const h16x8 qf0 = *(const h16x8*)(qp), qf1 = *(const h16x8*)(qp + 16), qf2 = *(const h16x8*)(qp + 32), qf3 = *(const h16x8*)(qp + 48);
        const float* gp = GATES + (size_t)mrow * 48 + (g * 4 + r) * 3;
        const float g_c = gp[0], g_s = gp[1], g_w = gp[2];
        asm volatile("s_waitcnt vmcnt(0)" ::: "memory");
        f32x16 o0, o1;
        LAS unsigned char* outp = lds + OUT_OFF + w * OUT_WAVE + col * OUT_ROW + 16 * hh;
        const int nct = (4 * qt + 3 + 63) >> 6, nvq0 = (t0 >= 31) ? ((t0 - 31) >> 4) + 1 : 0;
        for (int rp_ = 0; rp_ < (MK_REP == 120 ? 2 : 1); ++rp_) {
        cx.prev = 0.f; cx.m = -INFINITY; cx.l = 0.f;
        stream<M_CMP1>(lds, CK + (size_t)bg * NCP * 64, CVT + (size_t)bg * 64 * NCP, NCP, 0, nct - 1, false, nvq0, qf0, qf1, qf2, qf3, cx, o0, o1, impw);
        cx.cm = (cx.m == -INFINITY) ? 0.f : cx.m; cx.cinv = (cx.l > 0.f) ? 1.f / cx.l : 0.f;
#pragma unroll
        for (int e = 0; e < 16; ++e) { o0[e] = 0.f; o1[e] = 0.f; }
        stream<M_CMP2>(lds, CK + (size_t)bg * NCP * 64, CVT + (size_t)bg * 64 * NCP, NCP, 0, nct - 1, false, nvq0, qf0, qf1, qf2, qf3, cx, o0, o1, impw);
        }
        asm volatile("s_waitcnt lgkmcnt(0)" ::: "memory");
        for (int rp_ = 0; rp_ < (MK_REP == 123 ? 2 : 1); ++rp_) topk8(impw, qt, lane, selw);
        asm volatile("s_waitcnt lgkmcnt(0)" ::: "memory");
        cx.sel0 = selw[ql * 4]; cx.sel1 = selw[ql * 4 + 1]; cx.sel2 = selw[ql * 4 + 2]; cx.sel3 = selw[ql * 4 + 3];
#pragma unroll
        for (int rg = 0; rg < 4; ++rg) { *(LAS f32x4*)(outp + rg * 32) = (f32x4){o0[4 * rg], o0[4 * rg + 1], o0[4 * rg + 2], o0[4 * rg + 3]} * g_c; *(LAS f32x4*)(outp + 128 + rg * 32) = (f32x4){o1[4 * rg], o1[4 * rg + 1], o1[4 * rg + 2], o1[4 * rg + 3]} * g_c; }
        for (int rp_ = 0; rp_ < (MK_REP == 121 ? 2 : 1); ++rp_) {
        cx.m = -INFINITY; cx.l = 0.f;
#pragma unroll
        for (int e = 0; e < 16; ++e) { o0[e] = 0.f; o1[e] = 0.f; }
        stream<M_WIN>(lds, KV6 + 3 * SL + (size_t)bg * T * 64, KV6 + 5 * SL + (size_t)bg * 64 * T, T, (qt >= 8) ? qt - 8 : 0, qt, qt >= 8, 0, qf0, qf1, qf2, qf3, cx, o0, o1, impw);
        }
        { const float f = g_w / cx.l;
#pragma unroll
          for (int rg = 0; rg < 4; ++rg) { *(LAS f32x4*)(outp + rg * 32) += (f32x4){o0[4 * rg], o0[4 * rg + 1], o0[4 * rg + 2], o0[4 * rg + 3]} * f; *(LAS f32x4*)(outp + 128 + rg * 32) += (f32x4){o1[4 * rg], o1[4 * rg + 1], o1[4 * rg + 2], o1[4 * rg + 3]} * f; } }
        for (int rp_ = 0; rp_ < (MK_REP == 122 ? 2 : 1); ++rp_) {
        cx.m = -INFINITY; cx.l = 0.f;
#pragma unroll
        for (int e = 0; e < 16; ++e) { o0[e] = 0.f; o1[e] = 0.f; }
        stream<M_SEL>(lds, KV6 + 2 * SL + (size_t)bg * T * 64, KV6 + 4 * SL + (size_t)bg * 64 * T, T, 0, qt, false, 0, qf0, qf1, qf2, qf3, cx, o0, o1, impw);
        }
        { const float f = g_s / cx.l;
          h16* op = O1 + (size_t)mrow * 1024 + (g * 4 + r) * 64 + 4 * hh;
#pragma unroll
          for (int rg = 0; rg < 4; ++rg) {
              const f32x4 a = *(const LAS f32x4*)(outp + rg * 32) + (f32x4){o0[4 * rg], o0[4 * rg + 1], o0[4 * rg + 2], o0[4 * rg + 3]} * f;
              const f32x4 bq = *(const LAS f32x4*)(outp + 128 + rg * 32) + (f32x4){o1[4 * rg], o1[4 * rg + 1], o1[4 * rg + 2], o1[4 * rg + 3]} * f;
              h16x4 o4; o4[0] = (h16)a[0]; o4[1] = (h16)a[1]; o4[2] = (h16)a[2]; o4[3] = (h16)a[3]; *(h16x4*)(op + 8 * rg) = o4;
              o4[0] = (h16)bq[0]; o4[1] = (h16)bq[1]; o4[2] = (h16)bq[2]; o4[3] = (h16)bq[3]; *(h16x4*)(op + 32 + 8 * rg) = o4; } }
    }
}
}

constexpr int MISC_OFF = LDS_BYTES - 64;
constexpr int CW_BAR = 4096;
constexpr size_t CTL_ZERO_BYTES = 64 * 1024;

template <int PH> __global__ void __launch_bounds__(NT, 2) mk(Args args) {
    extern __shared__ __attribute__((aligned(16))) unsigned char lds_raw[];
    float* lds = (float*)lds_raw;
    const int tid = threadIdx.x, lane = tid & 63, wave = tid >> 6;
    const int gw = blockIdx.x * 8 + wave, NGW = gridDim.x * 8, gt = blockIdx.x * NT + tid, NGT = gridDim.x * NT;
    unsigned char* ws = args.ws;
    const float* x = args.in[0]; const float* norms = args.in[1];
    float* RC = (float*)(ws + WS_RC); float* RS = (float*)(ws + WS_RS); float* NC = (float*)(ws + WS_NC); float* NS = (float*)(ws + WS_NS);
    float* BIASK = (float*)(ws + WS_BIASK); float* BIASV = (float*)(ws + WS_BIASV);
    h16* XN = (h16*)(ws + WS_XN); float* MB = (float*)(ws + WS_MB); h16* HID = (h16*)(ws + WS_HID);
    h16* WFI = (h16*)(ws + WS_WFI); h16* WFO = (h16*)(ws + WS_WFO);
    h16* Q0 = (h16*)(ws + WS_Q0); h16* K0 = (h16*)(ws + WS_K0); h16* VT = (h16*)(ws + WS_VT); h16* KT = (h16*)(ws + WS_KT); h16* G0 = (h16*)args.out; h16* SS = (h16*)(ws + WS_SS); h16* Y = (h16*)(ws + WS_Y);
    h16* KV6 = (h16*)(ws + WS_KC); h16* QN = (h16*)(ws + WS_QN); float* GATES = (float*)(ws + WS_GATES); float* SLAB = (float*)(ws + WS_SLAB); h16* CK = (h16*)(ws + WS_CK); h16* CV = (h16*)(ws + WS_CV); h16* O1 = (h16*)(ws + WS_O1);
    float* XR = args.out;
    float* scr = lds + wave * (64 * 33);
    const int lo = args.ph_lo, hi = args.ph_hi;
    XcdBarrier bar; bar.bar = nullptr; bar.x = 0; bar.st = nullptr;
    if (PH < 0) {
        volatile LAS unsigned* misc = (volatile LAS unsigned*)((LAS unsigned char*)lds_raw + MISC_OFF);
        if (tid < 2) misc[tid] = 0u;
        __syncthreads();
        bar = xcd_barrier_post((unsigned*)(ws + WS_CTL) + CW_BAR, misc);
    }
#define FGEMM(EpiT, Eobj, Aptr, lda_, Btptr, Mrows, N_, K_, cidx, ALIGN) { const pg8::Gemm g_{Aptr, Btptr, Mrows, N_, K_, lda_, K_, 0L, (long)256 * (K_) * 2}; pg8::StaticOrder S_; S_.init(Mrows, N_, (int)gridDim.x, (int)(cidx)); \
        const EpiT E_ = Eobj; pg8::gemm_phase<EpiT, pg8::StaticOrder, ALIGN, true>((LAS unsigned char*)lds_raw, g_, S_, E_); }
#define FGEMM_SW(EpiT, Eobj, Aptr, lda_, Btptr, Mrows, N_, K_, cidx, ALIGN) { const pg8::Gemm g_{Aptr, Btptr, Mrows, N_, K_, lda_, K_, 0L, (long)256 * (K_) * 2}; pg8::StaticOrder S_; S_.init(Mrows, N_, (int)gridDim.x, (int)(cidx)); \
        const EpiT E_ = Eobj; pg8::gemm_phase<EpiT, pg8::StaticOrder, ALIGN, true, true>((LAS unsigned char*)lds_raw, g_, S_, E_); }
#define SEAM(k) { if (PH < 0 && IN(k) && IN((k) + 1)) xcd_barrier(bar); }
#define IN(k) (PH < 0 ? (lo <= (k) && (k) < hi) : (PH == (k)))

    if (IN(0)) {
        const int NI = 16 * 192 + 32 * 32;
        for (int it = gw; it < NI; it += NGW) { int r = it;
            WT_JOB(r, args.in[2], 1024, 6144, (h16*)(ws + WS_WA), norms + 0 * 1024, 3, 0);
            WT_JOB(r, args.in[4], 2048, 1024, (h16*)(ws + WS_WRO), nullptr, 0, 0); }
        for (int i = gt; i < T * 128; i += NGT) { const int t = i >> 7, j = i & 127; const float fr = (float)(1.0 / pow(10000.0, (double)((float)j / 127.0f))); float c, s; sincos_acc((float)t * fr, c, s); RC[i] = c; RS[i] = s; }
        for (int i = gt; i < T * 8; i += NGT) { const int t = i >> 3, j = i & 7; const float fr = (float)pow(500000.0, -(double)(2 * j) / 16.0); float c, s; sincos_acc((float)t * fr, c, s); NC[i] = c; NS[i] = s; }
        for (int m = gw; m < M; m += NGW) xn_row(x + (size_t)m * D, XN + (size_t)m * D, lane);
    }
    if (MK_REP == 0 && IN(0)) {
        const int NI = 16 * 192 + 32 * 32;
        for (int it = gw; it < NI; it += NGW) { int r = it;
            WT_JOB(r, args.in[2], 1024, 6144, (h16*)(ws + WS_WA), norms + 0 * 1024, 3, 0);
            WT_JOB(r, args.in[4], 2048, 1024, (h16*)(ws + WS_WRO), nullptr, 0, 0); }
        for (int i = gt; i < T * 128; i += NGT) { const int t = i >> 7, j = i & 127; const float fr = (float)(1.0 / pow(10000.0, (double)((float)j / 127.0f))); float c, s; sincos_acc((float)t * fr, c, s); RC[i] = c; RS[i] = s; }
        for (int i = gt; i < T * 8; i += NGT) { const int t = i >> 3, j = i & 7; const float fr = (float)pow(500000.0, -(double)(2 * j) / 16.0); float c, s; sincos_acc((float)t * fr, c, s); NC[i] = c; NS[i] = s; }
        for (int m = gw; m < M; m += NGW) xn_row(x + (size_t)m * D, XN + (size_t)m * D, lane);
    }
    SEAM(0)
    if (IN(1)) { FGEMM(pg8::EpiRetInF, (pg8::EpiRetInF{Q0, K0, KT, G0, RC, RS}), XN, 1024, (const h16*)(ws + WS_WA), M, 4096, 1024, blockIdx.x, true)
                 FGEMM_SW(pg8::EpiVT, (pg8::EpiVT{VT, 2048, (size_t)256 * T}), XN, 1024, (const h16*)(ws + WS_WA) + (size_t)4096 * 1024, M, 2048, 1024, blockIdx.x, true) }
    if (MK_REP == 1 && IN(1)) { FGEMM(pg8::EpiRetInF, (pg8::EpiRetInF{Q0, K0, KT, G0, RC, RS}), XN, 1024, (const h16*)(ws + WS_WA), M, 4096, 1024, blockIdx.x, true)
                 FGEMM_SW(pg8::EpiVT, (pg8::EpiVT{VT, 2048, (size_t)256 * T}), XN, 1024, (const h16*)(ws + WS_WA) + (size_t)4096 * 1024, M, 2048, 1024, blockIdx.x, true) }
    SEAM(1)
    if (IN(2)) f_ret_state(KT, VT, SS);
    if (MK_REP == 2 && IN(2)) f_ret_state(KT, VT, SS);
    SEAM(2)
    if (IN(3)) f_ret_out(Q0, K0, VT, G0, SS, args.in[3], Y, (LAS unsigned char*)lds_raw);
    if (MK_REP == 3 && IN(3)) f_ret_out(Q0, K0, VT, G0, SS, args.in[3], Y, (LAS unsigned char*)lds_raw);
    SEAM(3)
    if (IN(4)) FGEMM(pg8::EpiF32F, (pg8::EpiF32F{MB, 1024}), Y, 2048, (const h16*)(ws + WS_WRO), M, 1024, 2048, blockIdx.x, false)
    if (MK_REP == 4 && IN(4)) FGEMM(pg8::EpiF32F, (pg8::EpiF32F{MB, 1024}), Y, 2048, (const h16*)(ws + WS_WRO), M, 1024, 2048, blockIdx.x, false)
#define PH_NORM_A(L, xin) {     \
            for (int m = gw; m < M; m += NGW) res_norm_row((xin) + (size_t)m * D, MB + (size_t)m * D, norms + ((L) * 4 + 1) * 1024, XR + (size_t)m * D, XN + (size_t)m * D, lane); \
            const int NI = 16 * 176 + 44 * 32; \
            for (int it = gw; it < NI; it += NGW) { int r = it; \
                WT_JOB(r, args.in[15] + (size_t)(L) * 1024 * 5632, 1024, 5632, WFI, norms + ((L) * 4 + 2) * 1024, 1, 0); \
                WT_JOB(r, args.in[16] + (size_t)(L) * 2816 * 1024, 2816, 1024, WFO, nullptr, 0, 0); } }
#define PH_FFN_IN() FGEMM(pg8::EpiSwigluF, (pg8::EpiSwigluF{HID}), XN, 1024, WFI, M, 5632, 1024, blockIdx.x, true)
#define PH_FFN_OUT() FGEMM(pg8::EpiF32F, (pg8::EpiF32F{MB, 1024}), HID, DFF, WFO, M, 1024, DFF, blockIdx.x, false)
    SEAM(4)
    if (IN(5)) PH_NORM_A(0, x)
    if (MK_REP == 5 && IN(5)) PH_NORM_A(0, x)
    SEAM(5)
    if (IN(6)) PH_FFN_IN()
    if (MK_REP == 6 && IN(6)) PH_FFN_IN()
    SEAM(6)
    if (IN(7)) PH_FFN_OUT()
    if (MK_REP == 7 && IN(7)) PH_FFN_OUT()
    SEAM(7)
    if (IN(8)) {
        for (int m = gw; m < M; m += NGW) res_norm_row(XR + (size_t)m * D, MB + (size_t)m * D, norms + 3 * 1024, XR + (size_t)m * D, XN + (size_t)m * D, lane);
        const int NI = 16 * 48 + 16 * 34 + 16 * 32 + 2 * 32 * 8;
        for (int it = gw; it < NI; it += NGW) { int r = it;
            WT_JOB(r, args.in[8], 1024, 1536, (h16*)(ws + WS_WKVQ), args.in[7], 4, 0);
            WT_JOB(r, args.in[5], 1024, 1072, (h16*)(ws + WS_WKVQ), norms + 4 * 1024, 0, 1024);
            WT_JOB(r, args.in[6], 1024, 1024, (h16*)(ws + WS_WNO), nullptr, 0, 0);
            WT_JOB(r, args.in[11], 2048, 256, (h16*)(ws + WS_WC1K), nullptr, 0, 0);
            WT_JOB(r, args.in[13], 2048, 256, (h16*)(ws + WS_WC1V), nullptr, 0, 0); }
        { h16* z = (h16*)(ws + WS_WKVQ) + (size_t)2096 * 1024; for (int i = gt; i < 208 * 1024; i += NGT) z[i] = (h16)0.f; }
        for (int o = gw; o < 512; o += NGW) {
            const int which = o >> 8, c = o & 255; const float* pos = args.in[which ? 10 : 9]; const float* w1 = args.in[which ? 13 : 11]; float a = 0.f;
            for (int k = lane; k < 2048; k += 64) a += pos[k] * w1[(size_t)k * 256 + c];
            a = wave_sum(a); if (lane == 0) (which ? BIASV : BIASK)[c] = a; }
    }
    if (MK_REP == 8 && IN(8)) {
        for (int m = gw; m < M; m += NGW) res_norm_row(XR + (size_t)m * D, MB + (size_t)m * D, norms + 3 * 1024, XR + (size_t)m * D, XN + (size_t)m * D, lane);
        const int NI = 16 * 48 + 16 * 34 + 16 * 32 + 2 * 32 * 8;
        for (int it = gw; it < NI; it += NGW) { int r = it;
            WT_JOB(r, args.in[8], 1024, 1536, (h16*)(ws + WS_WKVQ), args.in[7], 4, 0);
            WT_JOB(r, args.in[5], 1024, 1072, (h16*)(ws + WS_WKVQ), norms + 4 * 1024, 0, 1024);
            WT_JOB(r, args.in[6], 1024, 1024, (h16*)(ws + WS_WNO), nullptr, 0, 0);
            WT_JOB(r, args.in[11], 2048, 256, (h16*)(ws + WS_WC1K), nullptr, 0, 0);
            WT_JOB(r, args.in[13], 2048, 256, (h16*)(ws + WS_WC1V), nullptr, 0, 0); }
        { h16* z = (h16*)(ws + WS_WKVQ) + (size_t)2096 * 1024; for (int i = gt; i < 208 * 1024; i += NGT) z[i] = (h16)0.f; }
        for (int o = gw; o < 512; o += NGW) {
            const int which = o >> 8, c = o & 255; const float* pos = args.in[which ? 10 : 9]; const float* w1 = args.in[which ? 13 : 11]; float a = 0.f;
            for (int k = lane; k < 2048; k += 64) a += pos[k] * w1[(size_t)k * 256 + c];
            a = wave_sum(a); if (lane == 0) (which ? BIASV : BIASK)[c] = a; }
    }
    SEAM(8)
    if (IN(9)) { FGEMM(pg8::EpiKvqF, (pg8::EpiKvqF{KV6, QN, GATES, NC, NS}), XN, 1024, (const h16*)(ws + WS_WKVQ), M, 2304, 1024, blockIdx.x, true)
                 FGEMM_SW(pg8::EpiVT, (pg8::EpiVT{KV6 + (size_t)4 * (8u * T * 64), 256, (size_t)512 * T}), XN, 1024, (const h16*)(ws + WS_WKVQ) + (size_t)2304 * 1024, M, 512, 1024, (blockIdx.x + 128) & 255, true) }
    if (MK_REP == 9 && IN(9)) { FGEMM(pg8::EpiKvqF, (pg8::EpiKvqF{KV6, QN, GATES, NC, NS}), XN, 1024, (const h16*)(ws + WS_WKVQ), M, 2304, 1024, blockIdx.x, true)
                 FGEMM_SW(pg8::EpiVT, (pg8::EpiVT{KV6 + (size_t)4 * (8u * T * 64), 256, (size_t)512 * T}), XN, 1024, (const h16*)(ws + WS_WKVQ) + (size_t)2304 * 1024, M, 512, 1024, (blockIdx.x + 128) & 255, true) }
    SEAM(9)
    if (IN(10)) {
        { const pg8::Gemm g_{KV6, (const h16*)(ws + WS_WC1K), 4096, 2048, 256, 1024, 2048, 512L, 512L}; pg8::StaticOrder S_; S_.init(4096, 2048, (int)gridDim.x, (int)blockIdx.x);
          const pg8::EpiSlabF E_{SLAB, (size_t)4096 * 256}; pg8::gemm_phase<pg8::EpiSlabF, pg8::StaticOrder, false, true>((LAS unsigned char*)lds_raw, g_, S_, E_); }
        { const pg8::Gemm g_{KV6 + (size_t)8 * T * 64, (const h16*)(ws + WS_WC1V), 4096, 2048, 256, 1024, 2048, 512L, 512L}; pg8::StaticOrder S_; S_.init(4096, 2048, (int)gridDim.x, (int)((blockIdx.x + 128) & 255));
          const pg8::EpiSlabF E_{SLAB + (size_t)8 * 4096 * 256, (size_t)4096 * 256}; pg8::gemm_phase<pg8::EpiSlabF, pg8::StaticOrder, false, true>((LAS unsigned char*)lds_raw, g_, S_, E_); }
    }
    SEAM(10)
    if (IN(11)) {
        for (int it = blockIdx.x; it < 256; it += gridDim.x) {
            const int which = it >> 7, r0 = (it & 127) * 32; const float* sl = SLAB + (size_t)which * 8 * 4096 * 256; const float* bias = which ? BIASV : BIASK; const float* w2 = args.in[which ? 14 : 12];
            for (int idx = tid; idx < 32 * 64; idx += NT) { const int r = idx >> 6, c4 = (idx & 63) * 4; f32x4 a = *(const f32x4*)(bias + c4);
#pragma unroll
                for (int kp = 0; kp < 8; ++kp) a = a + *(const f32x4*)(sl + ((size_t)kp * 4096 + r0 + r) * 256 + c4);
                f32x4 hq; hq[0] = gelu_tanh_f(a[0]); hq[1] = gelu_tanh_f(a[1]); hq[2] = gelu_tanh_f(a[2]); hq[3] = gelu_tanh_f(a[3]);
                *(f32x4*)(lds + r * 260 + c4) = hq; }
            __syncthreads();
            { const int r = tid >> 4, d4 = (tid & 15) * 4; f32x4 a = {0.f, 0.f, 0.f, 0.f};
#pragma unroll 8
              for (int c = 0; c < 256; ++c) a = a + *(const f32x4*)(w2 + c * 64 + d4) * lds[r * 260 + c];
              const int row = r0 + r, n = row & 511, bgi = row >> 9;
              if (n == 511) a = (f32x4){0.f, 0.f, 0.f, 0.f};
              if (which) {
#pragma unroll
                  for (int e = 0; e < 4; ++e) CV[((size_t)bgi * 64 + d4 + e) * 512 + n] = (h16)a[e];
              } else { h16x4 o4; o4[0] = (h16)a[0]; o4[1] = (h16)a[1]; o4[2] = (h16)a[2]; o4[3] = (h16)a[3]; *(h16x4*)(CK + (size_t)row * 64 + d4) = o4; } }
            __syncthreads();
        }
    }
    SEAM(11)
    if (IN(12)) nsa::phase(QN, KV6, CK, CV, GATES, O1, (LAS unsigned char*)lds_raw);
    if (MK_REP == 12 && IN(12)) nsa::phase(QN, KV6, CK, CV, GATES, O1, (LAS unsigned char*)lds_raw);
    SEAM(12)
    if (IN(13)) FGEMM(pg8::EpiF32F, (pg8::EpiF32F{MB, 1024}), O1, 1024, (const h16*)(ws + WS_WNO), M, 1024, 1024, blockIdx.x, false)
    if (MK_REP == 13 && IN(13)) FGEMM(pg8::EpiF32F, (pg8::EpiF32F{MB, 1024}), O1, 1024, (const h16*)(ws + WS_WNO), M, 1024, 1024, blockIdx.x, false)
    SEAM(13)
    if (IN(14)) PH_NORM_A(1, XR)
    if (MK_REP == 14 && IN(14)) PH_NORM_A(1, XR)
    SEAM(14)
    if (IN(15)) PH_FFN_IN()
    if (MK_REP == 15 && IN(15)) PH_FFN_IN()
    SEAM(15)
    if (IN(16)) PH_FFN_OUT()
    if (MK_REP == 16 && IN(16)) PH_FFN_OUT()
    SEAM(16)
    if (IN(17)) { for (int m = gw; m < M; m += NGW) res_norm_row(XR + (size_t)m * D, MB + (size_t)m * D, norms + 7 * 1024, XR + (size_t)m * D, nullptr, lane); }
    if (MK_REP == 17 && IN(17)) { for (int m = gw; m < M; m += NGW) res_norm_row(XR + (size_t)m * D, MB + (size_t)m * D, norms + 7 * 1024, XR + (size_t)m * D, nullptr, lane); }
#undef IN
}

extern "C" void kernel_launch(void* const* d_in, const int* in_sizes, int n_in, void* d_out, int out_size, void* d_ws, size_t ws_size, hipStream_t stream) {
    static int grid = 0;
    if (grid == 0) {
        if (n_in != 17 || out_size != M * D || ws_size < WS_END) { fprintf(stderr, "kernel_launch: unexpected problem (n_in %d out %d ws %zu)\n", n_in, out_size, ws_size); grid = -1; return; }
        int dev = 0, cus = 0;
        (void)hipGetDevice(&dev); (void)hipDeviceGetAttribute(&cus, hipDeviceAttributeMultiprocessorCount, dev);
#define SETATTR(p) if (hipFuncSetAttribute((const void*)mk<p>, hipFuncAttributeMaxDynamicSharedMemorySize, LDS_BYTES) != hipSuccess) { fprintf(stderr, "kernel_launch: hipFuncSetAttribute failed\n"); grid = -1; return; }
        SETATTR(-1) SETATTR(0) SETATTR(1) SETATTR(2) SETATTR(3) SETATTR(4) SETATTR(5) SETATTR(6) SETATTR(7) SETATTR(8) SETATTR(9)
        SETATTR(10) SETATTR(11) SETATTR(12) SETATTR(13) SETATTR(14) SETATTR(15) SETATTR(16) SETATTR(17)
        (void)hipGetLastError();
        grid = cus > 0 ? cus : 256;
    }
    if (grid < 0) return;
    Args a{};
    for (int i = 0; i < 17; ++i) a.in[i] = (const float*)d_in[i];
    a.out = (float*)d_out; a.ws = (unsigned char*)d_ws;
#if MK_ONE_LAUNCH
    if (hipMemsetAsync((char*)d_ws + WS_CTL, 0, CTL_ZERO_BYTES, stream) != hipSuccess) { fprintf(stderr, "kernel_launch: memset failed\n"); return; }
    a.ph_lo = 0; a.ph_hi = NPHASE; hipLaunchKernelGGL(mk<-1>, dim3(grid), dim3(NT), LDS_BYTES, stream, a);
    return;
#endif
#define LAUNCH_PH(p) { a.ph_lo = p; a.ph_hi = p + 1; hipLaunchKernelGGL(mk<p>, dim3(grid), dim3(NT), LDS_BYTES, stream, a); }
    LAUNCH_PH(0) LAUNCH_PH(1) LAUNCH_PH(2) LAUNCH_PH(3) LAUNCH_PH(4) LAUNCH_PH(5) LAUNCH_PH(6) LAUNCH_PH(7) LAUNCH_PH(8) LAUNCH_PH(9)
    LAUNCH_PH(10) LAUNCH_PH(11) LAUNCH_PH(12) LAUNCH_PH(13) LAUNCH_PH(14) LAUNCH_PH(15) LAUNCH_PH(16) LAUNCH_PH(17)
}
```
